# Optimizing an MI355X kernel written in HIP

```python
import math
import jax, jax.numpy as jnp
from jax import lax
import numpy as np

D_MODEL = 2048
BATCH = 4
SEQ = 2048
DEPTH = 4
DEC_BATCH = 128
DEC_SEQ = 8
PAST_LEN = 16384
PAGE_SIZE = 128

CONV_DIM = D_MODEL
CONV_WIDTH = 3
GLA_HEADS = 4
GLA_DK_TOT = D_MODEL // 2
GLA_DV_TOT = D_MODEL
GLA_DK = GLA_DK_TOT // GLA_HEADS
GLA_DV = GLA_DV_TOT // GLA_HEADS
GLA_RANK = 16
GLA_TAU = 16.0
GLA_CHUNK = 64
NORM_EPS = 1e-6
SPLITS = (D_MODEL, D_MODEL, CONV_DIM, CONV_DIM, CONV_DIM, CONV_DIM,
          GLA_DK_TOT, GLA_DK_TOT, GLA_DV_TOT, GLA_DV_TOT, GLA_RANK)
IN_WIDTH = 2 * D_MODEL + 4 * CONV_DIM + 2 * GLA_DK_TOT + 2 * GLA_DV_TOT + GLA_RANK

kernel_name = "hybrid_shortconv_gla_step"


def rmsnorm(x, g):
    x32 = x.astype(jnp.float32)
    y = x32 * lax.rsqrt(jnp.mean(x32 * x32, axis=-1, keepdims=True) + NORM_EPS)
    return (y * g.astype(jnp.float32)).astype(x.dtype)


def gla_chunked(q, k, v, log_a, s0):
    B, L, H, K = q.shape
    V = v.shape[-1]
    c = math.gcd(L, GLA_CHUNK)
    n = L // c

    def blocks(t):
        return jnp.moveaxis(t.astype(jnp.float32).reshape(B, n, c, H, t.shape[-1]), 1, 0)

    mask = jnp.tril(jnp.ones((c, c), dtype=bool))[None, :, :, None, None]

    def step(S, inp):
        qc, kc, vc, ac = inp
        b = jnp.cumsum(ac, axis=1)
        diff = b[:, :, None] - b[:, None, :]
        decay = jnp.exp(jnp.where(mask, diff, -jnp.inf))
        scores = jnp.sum(qc[:, :, None] * kc[:, None, :] * decay, axis=-1)
        o_intra = jnp.einsum('btsh,bshv->bthv', scores, vc)
        o_inter = jnp.einsum('bthk,bhkv->bthv', qc * jnp.exp(b), S)
        b_last = b[:, -1]
        k_dec = kc * jnp.exp(b_last[:, None] - b)
        S_new = jnp.exp(b_last)[..., None] * S + jnp.einsum('bshk,bshv->bhkv', k_dec, vc)
        return S_new, o_intra + o_inter

    S_fin, o = lax.scan(step, s0.astype(jnp.float32), (blocks(q), blocks(k), blocks(v), blocks(log_a)))
    o = jnp.moveaxis(o, 0, 1).reshape(B, L, H, V)
    return o, S_fin


def mixer_layer(x, conv_buf, gla_state, norm_g, w_in, conv_w, w_alpha2, b_alpha,
                gla_norm_g, w_branch_a, w_branch_b, w_out):
    B, L, _ = x.shape
    h = rmsnorm(x, norm_g)
    proj = jnp.einsum('bld,dp->blp', h, w_in)
    idx = np.cumsum(SPLITS)[:-1].tolist()
    ga, gb, cB, cC, cx, cg, q, k, v, gg, lr = jnp.split(proj, idx, axis=-1)

    u = cC * cx
    u_pad = jnp.concatenate([conv_buf.astype(u.dtype), u], axis=1)
    conv = u_pad[:, 0:L] * conv_w[0]
    for j in range(1, CONV_WIDTH):
        conv = conv + u_pad[:, j:j + L] * conv_w[j]
    za = cB * conv * jax.nn.silu(cg)
    branch_a = jnp.einsum('blc,cd->bld', za, w_branch_a)
    new_buf = u_pad[:, L:]

    qh = q.reshape(B, L, GLA_HEADS, GLA_DK) * (GLA_DK ** -0.5)
    kh = k.reshape(B, L, GLA_HEADS, GLA_DK)
    vh = v.reshape(B, L, GLA_HEADS, GLA_DV)
    a_logit = (jnp.einsum('blr,rk->blk', lr, w_alpha2) + b_alpha).astype(jnp.float32)
    log_a = (jax.nn.log_sigmoid(a_logit) / GLA_TAU).reshape(B, L, GLA_HEADS, GLA_DK)
    o, S_new = gla_chunked(qh, kh, vh, log_a, gla_state)
    o = rmsnorm(o, gla_norm_g).astype(x.dtype)
    zb = o.reshape(B, L, GLA_DV_TOT) * jax.nn.silu(gg)
    branch_b = jnp.einsum('blv,vd->bld', zb, w_branch_b)

    merged = jax.nn.sigmoid(ga) * branch_a + jax.nn.sigmoid(gb) * branch_b
    x = x + jnp.einsum('bld,de->ble', merged, w_out)
    return x, new_buf, S_new


def setup_inputs(seed: int = 0) -> dict:
    key = jax.random.key(seed)
    ks = jax.random.split(key, 16)
    f32 = jnp.float32
    x_prompt = jax.random.normal(ks[0], (BATCH, SEQ, D_MODEL), f32)
    x_sample = jax.random.normal(ks[1], (DEC_BATCH, DEC_SEQ, D_MODEL), f32)
    state_conv = jax.random.normal(ks[2], (DEPTH, DEC_BATCH, CONV_WIDTH - 1, CONV_DIM), f32)
    state_gla = 0.5 * jax.random.normal(ks[3], (DEPTH, DEC_BATCH, GLA_HEADS, GLA_DK, GLA_DV), f32)
    norm_g = 1.0 + 0.02 * jax.random.normal(ks[4], (DEPTH, D_MODEL), f32)
    w_in = jax.random.normal(ks[5], (DEPTH, D_MODEL, IN_WIDTH), f32) * D_MODEL ** -0.5
    conv_w = jax.random.normal(ks[6], (DEPTH, CONV_WIDTH, CONV_DIM), f32) * CONV_WIDTH ** -0.5
    w_alpha2 = jax.random.normal(ks[7], (DEPTH, GLA_RANK, GLA_DK_TOT), f32) * GLA_RANK ** -0.5
    b_alpha = 0.01 * jax.random.normal(ks[8], (DEPTH, GLA_DK_TOT), f32)
    gla_norm_g = 1.0 + 0.02 * jax.random.normal(ks[9], (DEPTH, GLA_DV), f32)
    w_branch_a = jax.random.normal(ks[10], (DEPTH, CONV_DIM, D_MODEL), f32) * CONV_DIM ** -0.5
    w_branch_b = jax.random.normal(ks[11], (DEPTH, GLA_DV_TOT, D_MODEL), f32) * GLA_DV_TOT ** -0.5
    w_out = jax.random.normal(ks[12], (DEPTH, D_MODEL, D_MODEL), f32) * D_MODEL ** -0.5
    final_norm_g = 1.0 + 0.02 * jax.random.normal(ks[13], (D_MODEL,), f32)
    return {"x_prompt": x_prompt, "x_sample": x_sample, "state_conv": state_conv,
            "state_gla": state_gla, "norm_g": norm_g, "w_in": w_in, "conv_w": conv_w,
            "w_alpha2": w_alpha2, "b_alpha": b_alpha, "gla_norm_g": gla_norm_g,
            "w_branch_a": w_branch_a, "w_branch_b": w_branch_b, "w_out": w_out,
            "final_norm_g": final_norm_g}


def reference(x_prompt, x_sample, state_conv, state_gla, norm_g, w_in, conv_w, w_alpha2,
              b_alpha, gla_norm_g, w_branch_a, w_branch_b, w_out, final_norm_g):
    xp = x_prompt
    xs = x_sample
    Bp = x_prompt.shape[0]
    conv_p, gla_p, conv_s, gla_s = [], [], [], []
    for l in range(DEPTH):
        params = (norm_g[l], w_in[l], conv_w[l], w_alpha2[l], b_alpha[l], gla_norm_g[l],
                  w_branch_a[l], w_branch_b[l], w_out[l])
        buf0 = jnp.zeros((Bp, CONV_WIDTH - 1, CONV_DIM), xp.dtype)
        s0 = jnp.zeros((Bp, GLA_HEADS, GLA_DK, GLA_DV), jnp.float32)
        xp, bp, sp = mixer_layer(xp, buf0, s0, *params)
        xs, bs, ss = mixer_layer(xs, state_conv[l], state_gla[l], *params)
        conv_p.append(bp)
        gla_p.append(sp)
        conv_s.append(bs)
        gla_s.append(ss)
    y_prompt = rmsnorm(xp, final_norm_g)
    y_sample = rmsnorm(xs, final_norm_g)
    return (y_prompt, y_sample, jnp.stack(conv_p), jnp.stack(gla_p), jnp.stack(conv_s), jnp.stack(gla_s))
```

```cpp
#include <hip/hip_runtime.h>
#include <cstdio>
#include <cstdint>
namespace pg8 {
#define PG8_LAS __attribute__((address_space(3)))
typedef unsigned short bf16_t;
typedef short bf16x8 __attribute__((ext_vector_type(8)));
typedef float f32x4 __attribute__((ext_vector_type(4)));
typedef unsigned u32x4 __attribute__((ext_vector_type(4)));
constexpr int BM = 256, BK = 64, HALF = 128, HTB = HALF * BK * 2  , STAGE_BYTES = 8 * HTB, NXCD = 8, WGM = 8;

__host__ __device__ __forceinline__ int lds_byte(int r, int c) { const int st = (r >> 4) * 2 + (c >> 5), rr = r & 15, cc = c & 31, ob = rr * 64 + cc * 2; return st * 1024 + (ob ^ (((ob >> 9) & 1) << 5)); }
__host__ __device__ __forceinline__ void stage_rc(int b, int& R, int& C) { const int st = b / 1024, sb = b % 1024, swz = sb ^ (((sb >> 9) & 1) << 5); R = (st >> 1) * 16 + swz / 64; C = (st & 1) * 32 + (swz % 64) / 2; }
__host__ __device__ __forceinline__ int perm32(int rho) { const int n = rho >> 4, i = rho & 15; return 8 * (i >> 2) + 4 * n + (i & 3); }

struct Unit { int pm, pn; };
struct Gemm { const bf16_t* A; const bf16_t* Bt; int M, N, K; };

struct StaticOrder {
    int nM, nN, nwg, G, c;
    __host__ __device__ void init(int M, int N, int G_, int c_) { nM = M / BM; nN = N / BM; nwg = nM * nN; G = G_; c = c_; }
    __host__ __device__ bool next(int i, Unit& u) const {
        const long L = (long)i * G + c; if (L >= nwg) return false;
        int wgid = (int)L; { const int q = nwg / NXCD, r = nwg % NXCD, xcd = wgid % NXCD, off = wgid / NXCD; wgid = (xcd < r ? xcd * (q + 1) : r * (q + 1) + (xcd - r) * q) + off; }
        const int nig = WGM * nN, gid = wgid / nig, fm = gid * WGM, gsz = (nM - fm) < WGM ? (nM - fm) : WGM;
        u.pm = fm + ((wgid % nig) % gsz); u.pn = (wgid % nig) / gsz; return true;
    }
    __device__ __forceinline__ void a_ready(const Unit&) const {}
    __device__ __forceinline__ void done(const Unit&) const {}
};
__device__ __forceinline__ unsigned cvt_pk_bf16(float lo, float hi) { unsigned r; asm volatile("v_cvt_pk_bf16_f32 %0, %1, %2" : "=v"(r) : "v"(lo), "v"(hi)); return r; }
constexpr int PW = 18432;
__device__ __forceinline__ float sigm(float x) { return __builtin_amdgcn_rcpf(1.0f + __builtin_amdgcn_exp2f(-1.44269504f * x)); }
__device__ __forceinline__ float bflo(unsigned w) { return __uint_as_float(w << 16); }
__device__ __forceinline__ float bfhi(unsigned w) { return __uint_as_float(w & 0xffff0000u); }
struct EpiProj {
    static constexpr bool PERM = true, AFTER_DRAIN = false;
    bf16_t* P; float* LR; const float* rstd;
    __device__ __forceinline__ void operator()(const f32x4 (&acc)[2][2][4][2], const Unit& u, int wr, int wc, int fr, int fq) const {
        const int row0 = u.pm * BM + wr * 64 + fr; const int pn = u.pn;
        const int mode = (pn < 16) ? 1 : (((pn >= 40 && pn < 48) || (pn >= 64 && pn < 72)) ? 2 : (pn == 72 ? 3 : 0));
        if (mode == 3) {
            if (wc == 0 && fq < 2) {
#pragma unroll
                for (int ai = 0; ai < 2; ++ai)
#pragma unroll
                    for (int m = 0; m < 4; ++m) { const int r = row0 + ai * HALF + m * 16; const float rs = rstd[r];
#pragma unroll
                        for (int n = 0; n < 2; ++n) *(f32x4*)(LR + (size_t)r * 16 + 8 * fq + 4 * n) = acc[ai][0][m][n] * rs; }
            }
            return;
        }
        const int col0 = pn * BM + wc * 32 + 8 * fq;
#pragma unroll
        for (int ai = 0; ai < 2; ++ai)
#pragma unroll
            for (int m = 0; m < 4; ++m) { const int r = row0 + ai * HALF + m * 16; const float rs = rstd[r]; bf16_t* rowp = P + (size_t)r * PW + col0;
#pragma unroll
                for (int bj = 0; bj < 2; ++bj) { f32x4 v0 = acc[ai][bj][m][0] * rs, v1 = acc[ai][bj][m][1] * rs;
                    if (mode == 1) {
#pragma unroll
                        for (int j = 0; j < 4; ++j) { v0[j] = sigm(v0[j]); v1[j] = sigm(v1[j]); } }
                    if (mode == 2) {
#pragma unroll
                        for (int j = 0; j < 4; ++j) { v0[j] = v0[j] * sigm(v0[j]); v1[j] = v1[j] * sigm(v1[j]); } }
                    u32x4 w; w.x = cvt_pk_bf16(v0[0], v0[1]); w.y = cvt_pk_bf16(v0[2], v0[3]); w.z = cvt_pk_bf16(v1[0], v1[1]); w.w = cvt_pk_bf16(v1[2], v1[3]);
                    *(u32x4*)(rowp + bj * HALF) = w; } }
    }
};
struct EpiBrA {
    static constexpr bool PERM = true, AFTER_DRAIN = false;
    float* T; const bf16_t* G;
    __device__ __forceinline__ void operator()(const f32x4 (&acc)[2][2][4][2], const Unit& u, int wr, int wc, int fr, int fq) const {
        const int row0 = u.pm * BM + wr * 64 + fr; const int col0 = u.pn * BM + wc * 32 + 8 * fq;
#pragma unroll
        for (int ai = 0; ai < 2; ++ai)
#pragma unroll
            for (int m = 0; m < 4; ++m) { const int r = row0 + ai * HALF + m * 16;
#pragma unroll
                for (int bj = 0; bj < 2; ++bj) { const int c = col0 + bj * HALF; const u32x4 g = *(const u32x4*)(G + (size_t)r * PW + c);
                    f32x4 v0 = acc[ai][bj][m][0], v1 = acc[ai][bj][m][1];
                    v0[0] *= bflo(g.x); v0[1] *= bfhi(g.x); v0[2] *= bflo(g.y); v0[3] *= bfhi(g.y); v1[0] *= bflo(g.z); v1[1] *= bfhi(g.z); v1[2] *= bflo(g.w); v1[3] *= bfhi(g.w);
                    *(f32x4*)(T + (size_t)r * 2048 + c) = v0; *(f32x4*)(T + (size_t)r * 2048 + c + 4) = v1; }
                asm volatile("" ::: "memory"); }
    }
};
struct EpiBrB {
    static constexpr bool PERM = true, AFTER_DRAIN = false;
    const float* T; const bf16_t* G; bf16_t* MG;
    __device__ __forceinline__ void operator()(const f32x4 (&acc)[2][2][4][2], const Unit& u, int wr, int wc, int fr, int fq) const {
        const int row0 = u.pm * BM + wr * 64 + fr; const int col0 = u.pn * BM + wc * 32 + 8 * fq;
#pragma unroll
        for (int ai = 0; ai < 2; ++ai)
#pragma unroll
            for (int m = 0; m < 4; ++m) { const int r = row0 + ai * HALF + m * 16;
#pragma unroll
                for (int bj = 0; bj < 2; ++bj) { const int c = col0 + bj * HALF; const u32x4 g = *(const u32x4*)(G + (size_t)r * PW + c);
                    const f32x4 t0 = *(const f32x4*)(T + (size_t)r * 2048 + c), t1 = *(const f32x4*)(T + (size_t)r * 2048 + c + 4);
                    f32x4 v0 = acc[ai][bj][m][0], v1 = acc[ai][bj][m][1];
                    v0[0] = t0[0] + v0[0] * bflo(g.x); v0[1] = t0[1] + v0[1] * bfhi(g.x); v0[2] = t0[2] + v0[2] * bflo(g.y); v0[3] = t0[3] + v0[3] * bfhi(g.y);
                    v1[0] = t1[0] + v1[0] * bflo(g.z); v1[1] = t1[1] + v1[1] * bfhi(g.z); v1[2] = t1[2] + v1[2] * bflo(g.w); v1[3] = t1[3] + v1[3] * bfhi(g.w);
                    u32x4 w; w.x = cvt_pk_bf16(v0[0], v0[1]); w.y = cvt_pk_bf16(v0[2], v0[3]); w.z = cvt_pk_bf16(v1[0], v1[1]); w.w = cvt_pk_bf16(v1[2], v1[3]);
                    *(u32x4*)(MG + (size_t)r * 2048 + c) = w; }
                asm volatile("" ::: "memory"); }
    }
};
struct EpiOut {
    static constexpr bool PERM = false, AFTER_DRAIN = false;
    float* X;
    __device__ __forceinline__ void operator()(const f32x4 (&acc)[2][2][4][2], const Unit& u, int wr, int wc, int fr, int fq) const {
        const int row0 = u.pm * BM + wr * 64 + fr, col0 = u.pn * BM + wc * 32 + 4 * fq;
#pragma unroll
        for (int ai = 0; ai < 2; ++ai)
#pragma unroll
            for (int m = 0; m < 4; ++m) { float* rowp = X + (size_t)(row0 + ai * HALF + m * 16) * 2048 + col0;
#pragma unroll
                for (int bj = 0; bj < 2; ++bj)
#pragma unroll
                    for (int n = 0; n < 2; ++n) { const f32x4 b = *(const f32x4*)(rowp + bj * HALF + n * 16); *(f32x4*)(rowp + bj * HALF + n * 16) = b + acc[ai][bj][m][n]; }
                asm volatile("" ::: "memory"); }
    }
};

template <class Epi, class Sched, bool ALIGN_EPI = false, bool SP2 = false>
__device__ __forceinline__ void gemm_phase(PG8_LAS unsigned char* lds, const Gemm g, const Sched& S, const Epi& E) {
    int tid_ = threadIdx.x; asm volatile("" : "+v"(tid_));
    const int tid = tid_, wid = __builtin_amdgcn_readfirstlane(tid >> 6), lane = tid & 63, wr = wid >> 2, wc = wid & 3, fr = lane & 15, fq = lane >> 4;
    const int K = g.K, nt = K / BK;
    unsigned voffA[2], voffB[2];
#pragma unroll
    for (int i = 0; i < 2; ++i) { int R, C; stage_rc(tid * 16 + i * 8192, R, C); const int Rb = Epi::PERM ? ((R & ~31) + perm32(R & 31)) : R;
        voffA[i] = (unsigned)(R * K + C) * 2u; voffB[i] = (unsigned)(Rb * K + C) * 2u; }
    const size_t kstep = (size_t)(BK * 2);
    const size_t hstep = (size_t)HALF * K * 2;
    const size_t tstep = 2 * hstep;
    const unsigned ldsw = (unsigned)wid * 1024u;
    const int aoff = lds_byte(wr * 64 + fr, fq * 8), boff = lds_byte(wc * 32 + fr, fq * 8);
#define PG8_SA(b, h) (((b) * 2 + (h)) * HTB)
#define PG8_SB(b, h) ((4 + (b) * 2 + (h)) * HTB)
#define PG8_STAGE(bufoff, gbase, voff) do { _Pragma("unroll") for (int _i = 0; _i < 2; ++_i) \
        __builtin_amdgcn_global_load_lds((const unsigned*)((const char*)(gbase) + (voff)[_i]), (PG8_LAS unsigned*)(lds + (bufoff) + ldsw + _i * 8192), 16, 0, 0); } while (0)
#define PG8_LDA(dst, b, h) do { _Pragma("unroll") for (int m = 0; m < 4; ++m) _Pragma("unroll") for (int k = 0; k < 2; ++k) dst[m][k] = *(const PG8_LAS bf16x8*)(lds + PG8_SA(b, h) + aoff + m * 2048 + k * 1024); } while (0)
#define PG8_LDB(dst, b, h) do { _Pragma("unroll") for (int n = 0; n < 2; ++n) _Pragma("unroll") for (int k = 0; k < 2; ++k) dst[n][k] = *(const PG8_LAS bf16x8*)(lds + PG8_SB(b, h) + boff + n * 2048 + k * 1024); } while (0)
#define PG8_MMA(ai, bj, At, Bt) do { __builtin_amdgcn_s_setprio(1); _Pragma("unroll") for (int m = 0; m < 4; ++m) _Pragma("unroll") for (int n = 0; n < 2; ++n) _Pragma("unroll") for (int k = 0; k < 2; ++k) \
        acc[ai][bj][m][n] = __builtin_amdgcn_mfma_f32_16x16x32_bf16(Bt[n][k], At[m][k], acc[ai][bj][m][n], 0, 0, 0); __builtin_amdgcn_s_setprio(0); } while (0)
#define PG8_WAIT_V(n) asm volatile("s_waitcnt vmcnt(" #n ")" ::: "memory")
#define PG8_WAIT_L(n) asm volatile("s_waitcnt lgkmcnt(" #n ")" ::: "memory")
#define PG8_BAR __builtin_amdgcn_s_barrier()
#define PG8_SCHED __builtin_amdgcn_sched_barrier(0)
    Unit cur, nxt; int ui = 0;
    if (!S.next(0, cur)) return;
    f32x4 acc[2][2][4][2];
#pragma unroll
    for (int a = 0; a < 2; ++a)
#pragma unroll
        for (int b = 0; b < 2; ++b)
#pragma unroll
            for (int m = 0; m < 4; ++m)
#pragma unroll
                for (int n = 0; n < 2; ++n) acc[a][b][m][n] = (f32x4){0.f, 0.f, 0.f, 0.f};
    bf16x8 At[4][2], B0[2][2], B1[2][2];
    const char* cA = (const char*)g.A + (size_t)cur.pm * tstep; const char* cB = (const char*)g.Bt + (size_t)cur.pn * tstep;
    S.a_ready(cur);
    if constexpr (SP2) {
        PG8_STAGE(PG8_SB(0, 0), cB, voffB); PG8_STAGE(PG8_SB(0, 1), cB + hstep, voffB); PG8_STAGE(PG8_SA(0, 0), cA, voffA); PG8_STAGE(PG8_SA(0, 1), cA + hstep, voffA);
        if (wr == 1) PG8_BAR;
        PG8_WAIT_V(2); PG8_BAR;
        PG8_STAGE(PG8_SB(1, 0), cB + kstep, voffB); PG8_STAGE(PG8_SA(1, 0), cA + kstep, voffA); PG8_STAGE(PG8_SB(1, 1), cB + hstep + kstep, voffB);
        PG8_WAIT_V(6); PG8_BAR;
    } else {
        PG8_STAGE(PG8_SB(0, 0), cB, voffB); PG8_STAGE(PG8_SA(0, 0), cA, voffA); PG8_STAGE(PG8_SB(0, 1), cB + hstep, voffB); PG8_STAGE(PG8_SA(0, 1), cA + hstep, voffA);
        if (wr == 1) PG8_BAR;
        PG8_WAIT_V(4); PG8_BAR;
        PG8_STAGE(PG8_SB(1, 0), cB + kstep, voffB); PG8_STAGE(PG8_SA(1, 0), cA + kstep, voffA); PG8_STAGE(PG8_SB(1, 1), cB + hstep + kstep, voffB);
        PG8_WAIT_V(6); PG8_BAR;
    }
    for (;;) {
        const bool has_next = S.next(ui + 1, nxt);
        const char* nA = has_next ? (const char*)g.A + (size_t)nxt.pm * tstep : cA; const char* nB = has_next ? (const char*)g.Bt + (size_t)nxt.pn * tstep : cB;
        for (int t = 0; t < nt; t += 2) {
            const bool last = (t == nt - 2);
            const char* a1 = cA + (size_t)(t + 1) * kstep;
            const char* a2 = last ? nA : cA + (size_t)(t + 2) * kstep; const char* b2 = last ? nB : cB + (size_t)(t + 2) * kstep;
            const char* a3 = a2 + kstep; const char* b3 = b2 + kstep;
            if (last && has_next) S.a_ready(nxt);
            if constexpr (SP2) {
            PG8_LDB(B0, 0, 0); PG8_LDB(B1, 0, 1); PG8_SCHED; PG8_LDA(At, 0, 0); PG8_STAGE(PG8_SA(1, 1), a1 + hstep, voffA);
            PG8_WAIT_V(8); PG8_WAIT_L(0); PG8_BAR; PG8_MMA(0, 0, At, B0); PG8_MMA(0, 1, At, B1); PG8_BAR; PG8_SCHED;
            PG8_LDA(At, 0, 1); PG8_STAGE(PG8_SB(0, 0), b2, voffB); PG8_STAGE(PG8_SB(0, 1), b2 + hstep, voffB); PG8_STAGE(PG8_SA(0, 0), a2, voffA);
            PG8_WAIT_V(8); PG8_WAIT_L(0); PG8_BAR; PG8_MMA(1, 0, At, B0); PG8_MMA(1, 1, At, B1); PG8_BAR; PG8_SCHED;
            PG8_LDB(B0, 1, 0); PG8_LDB(B1, 1, 1); PG8_SCHED; PG8_LDA(At, 1, 0); PG8_STAGE(PG8_SA(0, 1), a2 + hstep, voffA);
            PG8_WAIT_V(8); PG8_WAIT_L(0); PG8_BAR; PG8_MMA(0, 0, At, B0); PG8_MMA(0, 1, At, B1); PG8_BAR; PG8_SCHED;
            PG8_LDA(At, 1, 1); PG8_STAGE(PG8_SB(1, 0), b3, voffB); PG8_STAGE(PG8_SB(1, 1), b3 + hstep, voffB); PG8_STAGE(PG8_SA(1, 0), a3, voffA);
            PG8_WAIT_V(8); PG8_WAIT_L(0); PG8_BAR; PG8_MMA(1, 0, At, B0); PG8_MMA(1, 1, At, B1); PG8_BAR; PG8_SCHED;
            } else {
            PG8_LDB(B0, 0, 0); PG8_SCHED; PG8_LDA(At, 0, 0); PG8_STAGE(PG8_SA(1, 1), a1 + hstep, voffA);
            PG8_WAIT_L(8); PG8_BAR; PG8_WAIT_L(0); PG8_MMA(0, 0, At, B0); PG8_BAR; PG8_SCHED;
            PG8_LDB(B1, 0, 1); PG8_STAGE(PG8_SB(0, 0), b2, voffB);
            PG8_BAR; PG8_WAIT_L(0); PG8_MMA(0, 1, At, B1); PG8_BAR;
            PG8_LDA(At, 0, 1); PG8_STAGE(PG8_SA(0, 0), a2, voffA);
            PG8_BAR; PG8_WAIT_L(0); PG8_MMA(1, 0, At, B0); PG8_BAR; PG8_SCHED;
            PG8_STAGE(PG8_SB(0, 1), b2 + hstep, voffB);
            PG8_WAIT_V(6); PG8_BAR; PG8_MMA(1, 1, At, B1); PG8_BAR;
            PG8_LDB(B0, 1, 0); PG8_SCHED; PG8_LDA(At, 1, 0); PG8_STAGE(PG8_SA(0, 1), a2 + hstep, voffA);
            PG8_WAIT_L(8); PG8_BAR; PG8_WAIT_L(0); PG8_MMA(0, 0, At, B0); PG8_BAR; PG8_SCHED;
            PG8_LDB(B1, 1, 1); PG8_STAGE(PG8_SB(1, 0), b3, voffB);
            PG8_BAR; PG8_WAIT_L(0); PG8_MMA(0, 1, At, B1); PG8_BAR;
            PG8_LDA(At, 1, 1); PG8_STAGE(PG8_SA(1, 0), a3, voffA);
            PG8_BAR; PG8_WAIT_L(0); PG8_MMA(1, 0, At, B0); PG8_BAR; PG8_SCHED;
            PG8_STAGE(PG8_SB(1, 1), b3 + hstep, voffB);
            PG8_WAIT_V(6); PG8_BAR; PG8_MMA(1, 1, At, B1); PG8_BAR;
            }
        }
        if constexpr (ALIGN_EPI) { if (wr == 0) PG8_BAR; }
        if constexpr (!Epi::AFTER_DRAIN) { E(acc, cur, wr, wc, fr, fq); S.done(cur); }
        if (!has_next) break;
#pragma unroll
        for (int a = 0; a < 2; ++a)
#pragma unroll
            for (int b = 0; b < 2; ++b)
#pragma unroll
                for (int m = 0; m < 4; ++m)
#pragma unroll
                    for (int n = 0; n < 2; ++n) acc[a][b][m][n] = (f32x4){0.f, 0.f, 0.f, 0.f};
        cur = nxt; cA = nA; cB = nB; ++ui;
        if constexpr (ALIGN_EPI) { if (wr == 1) PG8_BAR; }
    }
    PG8_WAIT_V(0);
    if constexpr (!ALIGN_EPI) { if (wr == 0) PG8_BAR; }
    PG8_BAR;
    if constexpr (Epi::AFTER_DRAIN) { E.fused(acc, cur, wr, wc, fr, fq, lds, wid, lane); S.done(cur); }
#undef PG8_SA
#undef PG8_SB
#undef PG8_STAGE
#undef PG8_LDA
#undef PG8_LDB
#undef PG8_MMA
#undef PG8_WAIT_V
#undef PG8_WAIT_L
#undef PG8_BAR
#undef PG8_SCHED
}
}

constexpr int D = 2048, M = 9216, MP = 8192, DEPTH = 4, NWAVES = 8;
constexpr int INW = 18448, NPAD = 18688, PW = pg8::PW;
constexpr int C_GA = 0, C_GB = 2048, C_CB = 4096, C_CC = 6144, C_CX = 8192, C_CG = 10240, C_Q = 12288, C_K = 13312, C_V = 14336, C_GG = 16384;
constexpr float EPS = 1e-6f;
constexpr size_t O_Y = 0, O_CONVP = 18874368, O_GLAP = 18939904, O_CONVS = 27328512, O_GLAS = 29425664, O_END = 297861120;
constexpr size_t MiB = 1u << 20;
constexpr size_t WS_CTL = 0, CTL_ZERO_BYTES = 1 * MiB;
constexpr size_t WS_WIN = 2 * MiB, WIN_L = (size_t)NPAD * D * 2;
constexpr size_t WS_WA = 296 * MiB, WS_WB = 328 * MiB, WS_WO = 360 * MiB, W_L = (size_t)D * D * 2;
constexpr size_t WS_XF = 392 * MiB, WS_XB = 464 * MiB, WS_P = 500 * MiB, WS_ZA = 824 * MiB, WS_ZB = 860 * MiB, WS_MG = 896 * MiB;
constexpr size_t WS_O = 932 * MiB, WS_T = 1004 * MiB, WS_LR = 1076 * MiB, WS_RSTD = 1077 * MiB, WS_END = 1078 * MiB;
static_assert(WS_WIN + 4 * WIN_L <= WS_WA, "ws map");
constexpr int CW_BAR = 4096;
constexpr int RING_OFF = 0, RING_BYTES = 131072, LDSCTL_OFF = RING_BYTES, MISC_OFF = LDSCTL_OFF + 320, LDS_BYTES = 147456;

#define GAS __attribute__((address_space(1)))
#define LAS __attribute__((address_space(3)))
typedef unsigned short bf16;
typedef unsigned v4u __attribute__((ext_vector_type(4)));
typedef unsigned v2u __attribute__((ext_vector_type(2)));
typedef float f32x4 __attribute__((ext_vector_type(4)));
typedef GAS unsigned gu32;
#define RLX_AGENT __ATOMIC_RELAXED, __HIP_MEMORY_SCOPE_AGENT
#define LDS_WAIT() asm volatile("s_waitcnt lgkmcnt(0)" ::: "memory")
#define VM_WAIT() asm volatile("s_waitcnt vmcnt(0)" ::: "memory")
__device__ __forceinline__ unsigned f2bf(float f) { unsigned u = __builtin_bit_cast(unsigned, f); return (u + 0x7fffu + ((u >> 16) & 1u)) >> 16; }
__device__ __forceinline__ unsigned pk2(float lo, float hi) { return f2bf(lo) | (f2bf(hi) << 16); }
__device__ __forceinline__ float bflo(unsigned w) { return __uint_as_float(w << 16); }
__device__ __forceinline__ float bfhi(unsigned w) { return __uint_as_float(w & 0xffff0000u); }
__device__ __forceinline__ float bf1(bf16 b) { return __uint_as_float(((unsigned)b) << 16); }

#define XB_TMO      128
#define XB_XCNT(j)  (256  + 64 * (j))
#define XB_XSUB(j)  (1280 + 64 * (j))
#define XB_XGEN(j)  (2304 + 64 * (j))
#define XB_TOP      3328
#define XB_TOPGEN   3392
#define XCD_BAR_WORDS 3456
#define XB_SPIN_CAP (1u << 18)
__device__ __forceinline__ unsigned xb_ld(unsigned* p)              { return __hip_atomic_load(p, __ATOMIC_RELAXED, __HIP_MEMORY_SCOPE_AGENT); }
__device__ __forceinline__ unsigned xb_add(unsigned* p, unsigned v) { return __hip_atomic_fetch_add(p, v, __ATOMIC_RELAXED, __HIP_MEMORY_SCOPE_AGENT); }
__device__ __forceinline__ unsigned xb_xcc_id() { return (unsigned)__builtin_amdgcn_s_getreg((3 << 11) | 20) & 0xFu; }
#define XB_SPIN(cond, bar) do { unsigned _sp = 0; while (cond) { __builtin_amdgcn_s_sleep(1); \
    if ((++_sp & 255u) == 0u) { if (xb_ld(&(bar)[XB_TMO])) break; if (_sp > XB_SPIN_CAP) { atomicAdd(&(bar)[XB_TMO], 1u); break; } } } } while (0)
struct XcdBarrier { unsigned* bar; unsigned x; volatile LAS unsigned* st; };
__device__ __forceinline__ XcdBarrier xcd_barrier_post(unsigned* bar, volatile LAS unsigned* st) {
    XcdBarrier b; b.bar = bar; b.x = xb_xcc_id(); b.st = st;
    if (threadIdx.x == 0) (void)xb_add(&bar[XB_XCNT(b.x)], 1u);
    return b;
}
__device__ __forceinline__ void xcd_barrier_complete(unsigned* bar, unsigned x, unsigned& nloc, unsigned& nx) {
    const unsigned G = gridDim.x * gridDim.y * gridDim.z;
    unsigned sum, cnt, mine, sp = 0u;
    for (;;) {
        sum = 0u; cnt = 0u; mine = 0u;
#pragma unroll
        for (unsigned j = 0; j < 16; ++j) { const unsigned c = xb_ld(&bar[XB_XCNT(j)]); sum += c; cnt += (c > 0u) ? 1u : 0u; mine = (j == x) ? c : mine; }
        if (sum == G) break;
        __builtin_amdgcn_s_sleep(1);
        if ((++sp & 255u) == 0u) { if (xb_ld(&bar[XB_TMO])) break; if (sp > XB_SPIN_CAP) { atomicAdd(&bar[XB_TMO], 1u); break; } }
    }
    nloc = mine > 0u ? mine : 1u; nx = cnt > 0u ? cnt : 1u;
}
__device__ __forceinline__ void xcd_barrier(const XcdBarrier& b) {
    asm volatile("s_waitcnt vmcnt(0)" ::: "memory");
    __syncthreads();
    if (threadIdx.x == 0) {
        unsigned* bar = b.bar;
        __builtin_amdgcn_s_waitcnt(0);
        unsigned nloc = b.st[0], nx = b.st[1];
        if (nloc == 0u) { xcd_barrier_complete(bar, b.x, nloc, nx); b.st[0] = nloc; b.st[1] = nx; }
        const unsigned old = xb_add(&bar[XB_XSUB(b.x)], 1u);
        const unsigned gen = old / nloc;
        if (old + 1u == (gen + 1u) * nloc) {
            __builtin_amdgcn_fence(__ATOMIC_RELEASE, "agent");
            asm volatile("s_waitcnt vmcnt(0)" ::: "memory");
            const unsigned og = xb_add(&bar[XB_TOP], 1u);
            const unsigned tg = og / nx;
            if (og + 1u == (tg + 1u) * nx) xb_add(&bar[XB_TOPGEN], 1u);
            else XB_SPIN(xb_ld(&bar[XB_TOPGEN]) == tg, bar);
            __builtin_amdgcn_fence(__ATOMIC_ACQUIRE, "agent");
            xb_add(&bar[XB_XGEN(b.x)], 1u);
            asm volatile("s_waitcnt vmcnt(0)" ::: "memory");
        } else {
            XB_SPIN(xb_ld(&bar[XB_XGEN(b.x)]) == gen, bar);
            __builtin_amdgcn_fence(__ATOMIC_ACQUIRE, "agent");
            asm volatile("s_waitcnt vmcnt(0)" ::: "memory");
        }
    }
    __syncthreads();
}

struct Frame {
    LAS unsigned char* lds;
    int tid, lane, wave, vcu, G;
    float* out; unsigned char* ws;
};
__device__ __forceinline__ const float* inp(int k) { asm volatile("" : "+s"(k)); const unsigned long long* ka = (const unsigned long long*)__builtin_amdgcn_kernarg_segment_ptr(); return (const float*)ka[k]; }
enum { I_XP = 0, I_XS, I_SCONV, I_SGLA, I_NORMG, I_WIN, I_CONVW, I_WA2, I_BA, I_GNORMG, I_WBA, I_WBB, I_WO, I_FING };
__device__ __forceinline__ float wave_sum(float v) {
#pragma unroll
    for (int o = 1; o < 64; o <<= 1) v += __shfl_xor(v, o);
    return v;
}
__device__ __forceinline__ void tr_item(const float* W, int ldw, int nvalid, int K, bf16* WT, int nblk, const float* s, int smask, LAS float* scr, int item, int lane) {
    const int kb = item / nblk, nb = item % nblk, k0 = 64 * kb, n0 = 32 * nb;
    const int nn = lane & 31; const bool ok = (n0 + nn) < nvalid;
#pragma unroll 8
    for (int i = 0; i < 32; ++i) { const int kk = 2 * i + (lane >> 5); float v = 0.f; if (ok) v = W[(size_t)(k0 + kk) * ldw + n0 + nn]; if (s) v *= s[(k0 + kk) & smask]; scr[kk * 33 + nn] = v; }
    LDS_WAIT(); asm volatile("" ::: "memory");
    const int c = lane & 7;
#pragma unroll
    for (int j = 0; j < 4; ++j) { const int n = (lane >> 3) + 8 * j; const LAS float* p = scr + (8 * c) * 33 + n;
        v4u o; o.x = pk2(p[0 * 33], p[1 * 33]); o.y = pk2(p[2 * 33], p[3 * 33]); o.z = pk2(p[4 * 33], p[5 * 33]); o.w = pk2(p[6 * 33], p[7 * 33]);
        *(GAS v4u*)(WT + (size_t)(n0 + n) * K + k0 + 8 * c) = o; }
    LDS_WAIT(); asm volatile("" ::: "memory");
}
__device__ __forceinline__ void p_prologue(Frame& F) {
    LAS float* scr = (LAS float*)(F.lds + RING_OFF + F.wave * 16384);
    const int gw = F.vcu * NWAVES + F.wave, NGW = F.G * NWAVES;
    constexpr int I_IN = (D / 64) * (NPAD / 32), I_SQ = (D / 64) * (D / 32), I_L = I_IN + 3 * I_SQ;
    for (int it = gw; it < DEPTH * I_L; it += NGW) {
        const int l = it / I_L; int r = it % I_L;
        if (r < I_IN) { tr_item(inp(I_WIN) + (size_t)l * D * INW, INW, INW, D, (bf16*)(F.ws + WS_WIN + l * WIN_L), NPAD / 32, inp(I_NORMG) + l * D, 0xffff, scr, r, F.lane); continue; } r -= I_IN;
        if (r < I_SQ) { tr_item(inp(I_WBA) + (size_t)l * D * D, D, D, D, (bf16*)(F.ws + WS_WA + l * W_L), D / 32, nullptr, 0, scr, r, F.lane); continue; } r -= I_SQ;
        if (r < I_SQ) { tr_item(inp(I_WBB) + (size_t)l * D * D, D, D, D, (bf16*)(F.ws + WS_WB + l * W_L), D / 32, inp(I_GNORMG) + l * 512, 511, scr, r, F.lane); continue; } r -= I_SQ;
        tr_item(inp(I_WO) + (size_t)l * D * D, D, D, D, (bf16*)(F.ws + WS_WO + l * W_L), D / 32, nullptr, 0, scr, r, F.lane);
    }
}
__device__ __forceinline__ void p_xprep(Frame& F0, int l) {
    Frame F = F0; asm volatile("" : "+v"(F.tid), "+v"(F.lane));
    const int gw = F.vcu * NWAVES + F.wave, NGW = F.G * NWAVES;
    float* XF = (float*)(F.ws + WS_XF); bf16* XB = (bf16*)(F.ws + WS_XB); float* RS = (float*)(F.ws + WS_RSTD);
    for (int r = gw; r < M; r += NGW) {
        const float* src = (l == 0) ? (r < MP ? inp(I_XP) + (size_t)r * D : inp(I_XS) + (size_t)(r - MP) * D) : XF + (size_t)r * D;
        const GAS f32x4* s4 = (const GAS f32x4*)src + F.lane;
        f32x4 v[8]; float ss = 0.f;
#pragma unroll
        for (int j = 0; j < 8; ++j) { v[j] = s4[64 * j]; ss += (v[j].x * v[j].x + v[j].y * v[j].y) + (v[j].z * v[j].z + v[j].w * v[j].w); }
        const float rstd = 1.f / sqrtf(wave_sum(ss) * (1.f / D) + EPS);
        if (F.lane == 0) RS[r] = rstd;
        GAS unsigned long long* o8 = (GAS unsigned long long*)(XB + (size_t)r * D) + F.lane;
#pragma unroll
        for (int j = 0; j < 8; ++j) o8[64 * j] = (unsigned long long)pk2(v[j].x, v[j].y) | ((unsigned long long)pk2(v[j].z, v[j].w) << 32);
        if (l == 0) { GAS f32x4* d4 = (GAS f32x4*)(XF + (size_t)r * D) + F.lane;
#pragma unroll
            for (int j = 0; j < 8; ++j) d4[64 * j] = v[j]; }
    }
}
__device__ __forceinline__ void p_final(Frame& F0) {
    Frame F = F0; asm volatile("" : "+v"(F.tid), "+v"(F.lane));
    const int gw = F.vcu * NWAVES + F.wave, NGW = F.G * NWAVES;
    const float* XF = (const float*)(F.ws + WS_XF);
    for (int r = gw; r < M; r += NGW) {
        const GAS f32x4* s4 = (const GAS f32x4*)(XF + (size_t)r * D) + F.lane; const GAS f32x4* g4 = (const GAS f32x4*)inp(I_FING) + F.lane;
        f32x4 v[8]; float ss = 0.f;
#pragma unroll
        for (int j = 0; j < 8; ++j) { v[j] = s4[64 * j]; ss += (v[j].x * v[j].x + v[j].y * v[j].y) + (v[j].z * v[j].z + v[j].w * v[j].w); }
        const float rstd = 1.f / sqrtf(wave_sum(ss) * (1.f / D) + EPS);
        GAS f32x4* d4 = (GAS f32x4*)(F.out + O_Y + (size_t)r * D) + F.lane;
#pragma unroll
        for (int j = 0; j < 8; ++j) d4[64 * j] = v[j] * rstd * g4[64 * j];
    }
}
__device__ __forceinline__ void unpack8(const v4u w, float (&f)[8]) { f[0] = bflo(w.x); f[1] = bfhi(w.x); f[2] = bflo(w.y); f[3] = bfhi(w.y); f[4] = bflo(w.z); f[5] = bfhi(w.z); f[6] = bflo(w.w); f[7] = bfhi(w.w); }
__device__ __forceinline__ void p_conv(Frame& F0, int l) {
    Frame F = F0; asm volatile("" : "+v"(F.tid), "+v"(F.lane));
    const bf16* P = (const bf16*)(F.ws + WS_P); bf16* ZA = (bf16*)(F.ws + WS_ZA);
    for (int it = F.vcu * 512 + F.tid; it < (M / 8) * 256; it += F.G * 512) {
        const int rg = it >> 8, cg = it & 255, r0 = rg * 8, c0 = cg * 8;
        const bool prompt = r0 < MP; const int t0 = prompt ? (r0 & 2047) : 0; const int sb = prompt ? 0 : ((r0 - MP) >> 3), b = r0 >> 11;
        float w0[8], w1[8], w2[8], um2[8], um1[8];
        { const float* cw = inp(I_CONVW) + (size_t)l * 3 * D + c0;
#pragma unroll
          for (int e = 0; e < 8; ++e) { w0[e] = cw[e]; w1[e] = cw[D + e]; w2[e] = cw[2 * D + e]; } }
        if (t0 == 0) {
            if (prompt) {
#pragma unroll
                for (int e = 0; e < 8; ++e) { um2[e] = 0.f; um1[e] = 0.f; }
            } else { const float* sc = inp(I_SCONV) + ((size_t)(l * 128 + sb) * 2) * D + c0;
#pragma unroll
                for (int e = 0; e < 8; ++e) { um2[e] = sc[e]; um1[e] = sc[D + e]; } }
        } else {
            float a[8], c[8];
            unpack8(*(const GAS v4u*)(P + (size_t)(r0 - 2) * PW + C_CC + c0), a); unpack8(*(const GAS v4u*)(P + (size_t)(r0 - 2) * PW + C_CX + c0), c);
#pragma unroll
            for (int e = 0; e < 8; ++e) um2[e] = a[e] * c[e];
            unpack8(*(const GAS v4u*)(P + (size_t)(r0 - 1) * PW + C_CC + c0), a); unpack8(*(const GAS v4u*)(P + (size_t)(r0 - 1) * PW + C_CX + c0), c);
#pragma unroll
            for (int e = 0; e < 8; ++e) um1[e] = a[e] * c[e];
        }
#pragma unroll
        for (int i = 0; i < 8; ++i) {
            const bf16* pr = P + (size_t)(r0 + i) * PW + c0;
            float cb[8], cc[8], cx[8], sg[8], z[8];
            unpack8(*(const GAS v4u*)(pr + C_CB), cb); unpack8(*(const GAS v4u*)(pr + C_CC), cc); unpack8(*(const GAS v4u*)(pr + C_CX), cx); unpack8(*(const GAS v4u*)(pr + C_CG), sg);
#pragma unroll
            for (int e = 0; e < 8; ++e) { const float u = cc[e] * cx[e]; z[e] = cb[e] * (w0[e] * um2[e] + w1[e] * um1[e] + w2[e] * u) * sg[e]; um2[e] = um1[e]; um1[e] = u; }
            v4u o; o.x = pk2(z[0], z[1]); o.y = pk2(z[2], z[3]); o.z = pk2(z[4], z[5]); o.w = pk2(z[6], z[7]);
            *(GAS v4u*)(ZA + (size_t)(r0 + i) * D + c0) = o;
        }
        const bool last = prompt ? (t0 + 8 == 2048) : true;
        if (last) { float* dst = prompt ? F.out + O_CONVP + ((size_t)(l * 4 + b) * 2) * D + c0 : F.out + O_CONVS + ((size_t)(l * 128 + sb) * 2) * D + c0;
#pragma unroll
            for (int e = 0; e < 8; ++e) { dst[e] = um2[e]; dst[D + e] = um1[e]; } }
    }
}
__device__ __forceinline__ void p_gla_naive(Frame& F0, int l) {
    Frame F = F0; asm volatile("" : "+v"(F.tid), "+v"(F.lane));
    const bf16* P = (const bf16*)(F.ws + WS_P); const float* LR = (const float*)(F.ws + WS_LR); float* O = (float*)(F.ws + WS_O);
    LAS float* al = (LAS float*)(F.lds + RING_OFF); LAS float* kk = al + 256; LAS float* qq = kk + 256; LAS float* red = qq + 256;
    const int kq = F.tid >> 6, vc = F.tid & 63;
    for (int id = F.vcu; id < 128 + 4096; id += F.G) {
        const bool prompt = id < 128; const int j = prompt ? id : id - 128; const int sq = j >> 5, h = (j >> 3) & 3, vs = j & 7;
        const int L = prompt ? 2048 : 8, rbase = prompt ? sq * 2048 : MP + sq * 8;
        float S[32];
        if (prompt) {
#pragma unroll
            for (int i = 0; i < 32; ++i) S[i] = 0.f;
        } else { const float* s0 = inp(I_SGLA) + ((size_t)((l * 128 + sq) * 4 + h) * 256) * 512 + vs * 64 + vc;
#pragma unroll
            for (int i = 0; i < 32; ++i) S[i] = s0[(size_t)(kq * 32 + i) * 512]; }
        float w2[16], bias = 0.f;
        const float* w2p = inp(I_WA2);
        if (F.tid < 256) { bias = inp(I_BA)[l * 1024 + h * 256 + F.tid];
#pragma unroll
            for (int jj = 0; jj < 16; ++jj) w2[jj] = w2p[((size_t)l * 16 + jj) * 1024 + h * 256 + F.tid]; }
        else {
#pragma unroll
            for (int jj = 0; jj < 16; ++jj) w2[jj] = 0.f; }
        for (int t = 0; t < L; ++t) {
            const int r = rbase + t;
            if (F.tid < 256) { float a = bias;
#pragma unroll
                for (int jj = 0; jj < 16; ++jj) a += LR[(size_t)r * 16 + jj] * w2[jj];
                const float ls = fminf(a, 0.f) - log1pf(expf(-fabsf(a)));
                al[F.tid] = expf(ls * 0.0625f); kk[F.tid] = bf1(P[(size_t)r * PW + C_K + h * 256 + F.tid]); qq[F.tid] = bf1(P[(size_t)r * PW + C_Q + h * 256 + F.tid]) * 0.0625f; }
            const float v = bf1(P[(size_t)r * PW + C_V + h * 512 + vs * 64 + vc]);
            __syncthreads();
            float po = 0.f;
#pragma unroll
            for (int i = 0; i < 32; ++i) { const int k = kq * 32 + i; S[i] = al[k] * S[i] + kk[k] * v; po += qq[k] * S[i]; }
            red[kq * 64 + vc] = po;
            __syncthreads();
            if (F.tid < 64) { float o = 0.f;
#pragma unroll
                for (int q = 0; q < 8; ++q) o += red[q * 64 + F.tid];
                O[(size_t)r * D + h * 512 + vs * 64 + F.tid] = o; }
        }
        float* dst = (prompt ? F.out + O_GLAP + ((size_t)((l * 4 + sq) * 4 + h) * 256) * 512 : F.out + O_GLAS + ((size_t)((l * 128 + sq) * 4 + h) * 256) * 512) + vs * 64 + vc;
#pragma unroll
        for (int i = 0; i < 32; ++i) dst[(size_t)(kq * 32 + i) * 512] = S[i];
        __syncthreads();
    }
}
__device__ __forceinline__ void p_zb(Frame& F0) {
    Frame F = F0; asm volatile("" : "+v"(F.tid), "+v"(F.lane));
    const int gw = F.vcu * NWAVES + F.wave, NGW = F.G * NWAVES;
    const bf16* P = (const bf16*)(F.ws + WS_P); const float* O = (const float*)(F.ws + WS_O); bf16* ZB = (bf16*)(F.ws + WS_ZB);
    for (int r = gw; r < M; r += NGW) {
#pragma unroll
        for (int h = 0; h < 4; ++h) {
            const GAS f32x4* o4 = (const GAS f32x4*)(O + (size_t)r * D + h * 512) + F.lane;
            const f32x4 a = o4[0], b = o4[64];
            const float ss = (a.x * a.x + a.y * a.y) + (a.z * a.z + a.w * a.w) + (b.x * b.x + b.y * b.y) + (b.z * b.z + b.w * b.w);
            const float rs = 1.f / sqrtf(wave_sum(ss) * (1.f / 512.f) + EPS);
            const GAS v2u* g2 = (const GAS v2u*)(P + (size_t)r * PW + C_GG + h * 512) + F.lane;
            const v2u ga = g2[0], gb = g2[64];
            GAS v2u* z2 = (GAS v2u*)(ZB + (size_t)r * D + h * 512) + F.lane;
            v2u za, zb;
            za.x = pk2(a.x * rs * bflo(ga.x), a.y * rs * bfhi(ga.x)); za.y = pk2(a.z * rs * bflo(ga.y), a.w * rs * bfhi(ga.y));
            zb.x = pk2(b.x * rs * bflo(gb.x), b.y * rs * bfhi(gb.x)); zb.y = pk2(b.z * rs * bflo(gb.y), b.w * rs * bfhi(gb.y));
            z2[0] = za; z2[64] = zb;
        }
    }
}

struct Args { const float* in[14]; float* out; unsigned char* ws; int ph_lo, ph_hi; };
constexpr int N_PHASES = 1 + 6 * DEPTH;
__global__ void __launch_bounds__(NWAVES * 64, 2) fwd(Args args) {
    extern __shared__ __attribute__((aligned(16))) unsigned char lds[];
    Frame F;
    F.lds = (LAS unsigned char*)lds;
    F.tid = threadIdx.x; F.lane = F.tid & 63; F.wave = __builtin_amdgcn_readfirstlane(F.tid >> 6);
    F.G = gridDim.x; { const int bx = blockIdx.x; F.vcu = (F.G % 8 == 0) ? (bx % 8) * (F.G / 8) + bx / 8 : bx; }
    F.out = args.out; F.ws = args.ws;
    volatile LAS unsigned* MISC = (volatile LAS unsigned*)(F.lds + MISC_OFF);
    for (int u = F.tid; u < (LDS_BYTES - LDSCTL_OFF) / 4; u += NWAVES * 64) ((LAS unsigned*)(F.lds + LDSCTL_OFF))[u] = 0u;
    __syncthreads();
    const int lo = args.ph_lo, hi = args.ph_hi;
    XcdBarrier bar; bar.bar = (unsigned*)(F.ws + WS_CTL) + CW_BAR; bar.x = 0; bar.st = nullptr;
    if (hi - lo > 1) bar = xcd_barrier_post((unsigned*)(F.ws + WS_CTL) + CW_BAR, MISC + 8);
#define IN(k) (lo <= (k) && (k) < hi)
#define SEAM(k) do { if (IN(k) && IN((k) + 1)) xcd_barrier(bar); } while (0)
    bf16* XB = (bf16*)(F.ws + WS_XB); bf16* P = (bf16*)(F.ws + WS_P); bf16* ZA = (bf16*)(F.ws + WS_ZA); bf16* ZB = (bf16*)(F.ws + WS_ZB); bf16* MG = (bf16*)(F.ws + WS_MG);
    float* XF = (float*)(F.ws + WS_XF); float* T = (float*)(F.ws + WS_T); float* LR = (float*)(F.ws + WS_LR); float* RS = (float*)(F.ws + WS_RSTD);

    #ifndef NO_P0
    if (IN(0)) { p_prologue(F); p_xprep(F, 0); }
#endif
    SEAM(0);
#pragma unroll 1
    for (int l = 0; l < DEPTH; ++l) {
        const int pb = 1 + 6 * l;
#ifndef NO_PROJ
        if (IN(pb)) {
            pg8::Gemm g{XB, (const bf16*)(F.ws + WS_WIN + l * WIN_L), M, NPAD, D}; pg8::StaticOrder S; S.init(M, NPAD, F.G, (int)blockIdx.x);
            pg8::EpiProj E{P, LR, RS};
            pg8::gemm_phase<pg8::EpiProj, pg8::StaticOrder, true, true>(F.lds + RING_OFF, g, S, E);
        }
#endif
        SEAM(pb);
        if (IN(pb + 1)) {
#ifndef NO_CONV
            p_conv(F, l);
#endif
#ifndef NO_GLA
            p_gla_naive(F, l);
#endif
        } SEAM(pb + 1);
#ifndef NO_ZB
        if (IN(pb + 2)) { p_zb(F); }
#endif
        SEAM(pb + 2);
#ifndef NO_BR
        if (IN(pb + 3)) {
            pg8::StaticOrder S; S.init(M, D, F.G, (int)blockIdx.x);
            { pg8::Gemm g{ZA, (const bf16*)(F.ws + WS_WA + l * W_L), M, D, D}; pg8::EpiBrA E{T, P + C_GA};
              pg8::gemm_phase<pg8::EpiBrA, pg8::StaticOrder, true, true>(F.lds + RING_OFF, g, S, E); }
            { pg8::Gemm g{ZB, (const bf16*)(F.ws + WS_WB + l * W_L), M, D, D}; pg8::EpiBrB E{T, P + C_GB, MG};
              pg8::gemm_phase<pg8::EpiBrB, pg8::StaticOrder, true, true>(F.lds + RING_OFF, g, S, E); }
        }
#endif
        SEAM(pb + 3);
#ifndef NO_OUT
        if (IN(pb + 4)) {
            pg8::Gemm g{MG, (const bf16*)(F.ws + WS_WO + l * W_L), M, D, D}; pg8::StaticOrder S; S.init(M, D, F.G, (int)blockIdx.x);
            pg8::EpiOut E{XF};
            pg8::gemm_phase<pg8::EpiOut, pg8::StaticOrder, true, true>(F.lds + RING_OFF, g, S, E);
        }
#endif
        SEAM(pb + 4);
#ifndef NO_XN
        if (IN(pb + 5)) { if (l + 1 < DEPTH) p_xprep(F, l + 1); else p_final(F); }
#endif
        SEAM(pb + 5);
    }
#undef IN
#undef SEAM
}

#ifndef MK_SINGLE
#define MK_SINGLE 0
#endif
extern "C" void kernel_launch(void* const* d_in, const int* in_sizes, int n_in, void* d_out, int out_size, void* d_ws, size_t ws_size, hipStream_t stream) {
    static int grid = 0;
    if (grid == 0) {
        if (n_in != 14 || (size_t)out_size != O_END || ws_size < WS_END) { fprintf(stderr, "kernel_launch: unexpected shapes (n_in %d out %d ws %zu)\n", n_in, out_size, ws_size); grid = -1; return; }
        int dev = 0, cus = 0, per_cu = 0;
        if (hipGetDevice(&dev) != hipSuccess || hipDeviceGetAttribute(&cus, hipDeviceAttributeMultiprocessorCount, dev) != hipSuccess) { grid = -1; return; }
        if (hipFuncSetAttribute((const void*)fwd, hipFuncAttributeMaxDynamicSharedMemorySize, LDS_BYTES) != hipSuccess) { fprintf(stderr, "kernel_launch: hipFuncSetAttribute failed\n"); grid = -1; return; }
        if (hipOccupancyMaxActiveBlocksPerMultiprocessor(&per_cu, (const void*)fwd, NWAVES * 64, LDS_BYTES) != hipSuccess || per_cu < 1) fprintf(stderr, "kernel_launch: occupancy query reports %d\n", per_cu);
        (void)hipGetLastError();
        grid = cus;
    }
    if (grid < 0) return;
    if (hipMemsetAsync((char*)d_ws + WS_CTL, 0, CTL_ZERO_BYTES, stream) != hipSuccess) return;
    Args a{};
    for (int i = 0; i < 14; ++i) a.in[i] = (const float*)d_in[i];
    a.out = (float*)d_out; a.ws = (unsigned char*)d_ws;
#if MK_SINGLE
    a.ph_lo = 0; a.ph_hi = N_PHASES;
    hipLaunchKernelGGL(fwd, dim3(grid), dim3(NWAVES * 64), LDS_BYTES, stream, a);
#else
    for (int p = 0; p < N_PHASES; ++p) { a.ph_lo = p; a.ph_hi = p + 1; hipLaunchKernelGGL(fwd, dim3(grid), dim3(NWAVES * 64), LDS_BYTES, stream, a); }
#endif
}
```

```cpp
#include <hip/hip_runtime.h>
#include <cstdio>
#include <cstdint>
#define REP_PROJ 1
#define REP_PREP 1
#define REP_SCAN 1
#define REP_ZB 1
#define REP_BR 1
#define REP_XN 1
#define REP_PRO 1
#define REP_MINI 1
#define REP_OUT 1
namespace pg8 {
#define PG8_LAS __attribute__((address_space(3)))
typedef unsigned short bf16_t;
typedef short bf16x8 __attribute__((ext_vector_type(8)));
typedef float f32x4 __attribute__((ext_vector_type(4)));
typedef unsigned u32x4 __attribute__((ext_vector_type(4)));
constexpr int BM = 256, BK = 64, HALF = 128, HTB = HALF * BK * 2  , STAGE_BYTES = 8 * HTB, NXCD = 8, WGM = 8;

__host__ __device__ __forceinline__ int lds_byte(int r, int c) { const int st = (r >> 4) * 2 + (c >> 5), rr = r & 15, cc = c & 31, ob = rr * 64 + cc * 2; return st * 1024 + (ob ^ (((ob >> 9) & 1) << 5)); }
__host__ __device__ __forceinline__ void stage_rc(int b, int& R, int& C) { const int st = b / 1024, sb = b % 1024, swz = sb ^ (((sb >> 9) & 1) << 5); R = (st >> 1) * 16 + swz / 64; C = (st & 1) * 32 + (swz % 64) / 2; }
__host__ __device__ __forceinline__ int perm32(int rho) { const int n = rho >> 4, i = rho & 15; return 8 * (i >> 2) + 4 * n + (i & 3); }

struct Unit { int pm, pn, sel; };
struct Gemm { const bf16_t* A; const bf16_t* Bt; int M, N, K; const bf16_t* A2; const bf16_t* Bt2; };

struct StaticOrder {
    int nM, nN, nwg, G, c;
    __host__ __device__ void init(int M, int N, int G_, int c_) { nM = M / BM; nN = N / BM; nwg = nM * nN; G = G_; c = c_; }
    __host__ __device__ bool next(int i, Unit& u) const {
        const long L = (long)i * G + c; if (L >= nwg) return false;
        int wgid = (int)L; { const int q = nwg / NXCD, r = nwg % NXCD, xcd = wgid % NXCD, off = wgid / NXCD; wgid = (xcd < r ? xcd * (q + 1) : r * (q + 1) + (xcd - r) * q) + off; }
        const int nig = WGM * nN, gid = wgid / nig, fm = gid * WGM, gsz = (nM - fm) < WGM ? (nM - fm) : WGM;
        u.pm = fm + ((wgid % nig) % gsz); u.pn = (wgid % nig) / gsz; u.sel = 0; return true;
    }
    __device__ __forceinline__ void a_ready(const Unit&) const {}
    __device__ __forceinline__ void done(const Unit&) const {}
};
__device__ __forceinline__ unsigned cvt_pk_bf16(float lo, float hi) { unsigned r; asm volatile("v_cvt_pk_bf16_f32 %0, %1, %2" : "=v"(r) : "v"(lo), "v"(hi)); return r; }
constexpr int PW = 18432;
__device__ __forceinline__ float sigm(float x) { return __builtin_amdgcn_rcpf(1.0f + __builtin_amdgcn_exp2f(-1.44269504f * x)); }
__device__ __forceinline__ float bflo(unsigned w) { return __uint_as_float(w << 16); }
__device__ __forceinline__ float bfhi(unsigned w) { return __uint_as_float(w & 0xffff0000u); }
__device__ __forceinline__ u32x4 pack8(const f32x4 v0, const f32x4 v1) { u32x4 w; w.x = cvt_pk_bf16(v0[0], v0[1]); w.y = cvt_pk_bf16(v0[2], v0[3]); w.z = cvt_pk_bf16(v1[0], v1[1]); w.w = cvt_pk_bf16(v1[2], v1[3]); return w; }
struct EpiProj {
    static constexpr int DEPTH = 16; static constexpr bool MIDK = false, CONV = true, INPLACE = false, PAIR = false;
    bf16_t* P; float* LR; const unsigned long long* rsq;
    bf16_t* ZA; float* FIX; const float* convw; const float* sconv; float* ocp; float* ocs;
    static __device__ __forceinline__ f32x4 ror(const f32x4 x, int n) { f32x4 y;
#pragma unroll
        for (int j = 0; j < 4; ++j) y[j] = __int_as_float(n == 1 ? __builtin_amdgcn_update_dpp(0, __float_as_int(x[j]), 0x121, 0xf, 0xf, false) : __builtin_amdgcn_update_dpp(0, __float_as_int(x[j]), 0x122, 0xf, 0xf, false)); return y; }
    __device__ __forceinline__ void conv_unit(const f32x4 (&acc)[2][2][4][2], const Unit& u, int wr, int wc, int fr, int fq) const {
        const int ch0 = 64 * (u.pn - 16) + 16 * wc + 4 * fq; const bool sample = u.pm >= 32;
        const f32x4 w0 = *(const f32x4*)(convw + ch0), w1 = *(const f32x4*)(convw + 2048 + ch0), w2 = *(const f32x4*)(convw + 4096 + ch0);
        unsigned long long rq[2][4];
#pragma unroll
        for (int ai = 0; ai < 2; ++ai)
#pragma unroll
            for (int m = 0; m < 4; ++m) rq[ai][m] = rsq[u.pm * BM + ai * HALF + wr * 64 + m * 16 + fr];
#pragma unroll
        for (int ai = 0; ai < 2; ++ai) { const int br0 = u.pm * BM + ai * HALF + wr * 64, blk = br0 >> 6; const bool seqstart = (br0 & 2047) == 0, seqend = ((br0 + 64) & 2047) == 0;
            f32x4 uprev = {0.f, 0.f, 0.f, 0.f};
#pragma unroll
            for (int m = 0; m < 4; ++m) { const int r = br0 + m * 16 + fr;
                const float rstd = __builtin_amdgcn_rsqf((float)rq[ai][m] * (1.0f / 16777216.0f) * (1.0f / 2048.0f) + 1e-6f);
                const f32x4 cB = acc[ai][0][m][0] * rstd, cC = acc[ai][0][m][1] * rstd, cx = acc[ai][1][m][0] * rstd; f32x4 cg = acc[ai][1][m][1] * rstd;
#pragma unroll
                for (int j = 0; j < 4; ++j) cg[j] = cg[j] * sigm(cg[j]);
                const f32x4 uu = cC * cx, cbg = cB * cg, t1 = ror(uu, 1), t2 = ror(uu, 2);
                f32x4 u1, u2;
                if (!sample) { const f32x4 p1 = ror(uprev, 1), p2 = ror(uprev, 2);
#pragma unroll
                    for (int j = 0; j < 4; ++j) { u1[j] = fr >= 1 ? t1[j] : p1[j]; u2[j] = fr >= 2 ? t2[j] : p2[j]; }
                } else { const int t = fr & 7, sb = (r - 8192) >> 3; const f32x4 b0 = *(const f32x4*)(sconv + (size_t)sb * 4096 + ch0), b1 = *(const f32x4*)(sconv + (size_t)sb * 4096 + 2048 + ch0);
#pragma unroll
                    for (int j = 0; j < 4; ++j) { u1[j] = t >= 1 ? t1[j] : b1[j]; u2[j] = t >= 2 ? t2[j] : (t == 1 ? b1[j] : b0[j]); }
                    if (t >= 6) *(f32x4*)(ocs + (size_t)sb * 4096 + (t - 6) * 2048 + ch0) = uu; }
                const f32x4 z = cbg * (w0 * u2 + w1 * u1 + w2 * uu);
                if (!sample && m == 0 && fr < 2 && !seqstart) {
                    *(f32x4*)(FIX + ((size_t)(blk * 2 + fr)) * 2048 + ch0) = cbg; *(f32x4*)(FIX + (size_t)524288 + ((size_t)(blk * 2 + fr)) * 2048 + ch0) = uu;
                } else { typedef unsigned u32x2 __attribute__((ext_vector_type(2))); u32x2 w; w.x = cvt_pk_bf16(z[0], z[1]); w.y = cvt_pk_bf16(z[2], z[3]); *(u32x2*)(ZA + (size_t)r * 2048 + ch0) = w; }
                if (!sample && m == 3 && fr >= 14) { *(f32x4*)(FIX + (size_t)1048576 + ((size_t)(blk * 2 + fr - 14)) * 2048 + ch0) = uu;
                    if (seqend) *(f32x4*)(ocp + ((size_t)(br0 >> 11) * 2 + (fr - 14)) * 2048 + ch0) = uu; }
                uprev = uu; } }
    }
    struct Pre { float rs; };
    __device__ __forceinline__ Pre pre(int r, int) const { Pre p; p.rs = (float)rsq[r] * (1.0f / 16777216.0f); return p; }
    __device__ __forceinline__ void fin(int r, int c, f32x4 v0, f32x4 v1, const Pre& p) const {
        const int t = c >> 8; const float rstd = __builtin_amdgcn_rsqf(p.rs * (1.0f / 2048.0f) + 1e-6f); v0 = v0 * rstd; v1 = v1 * rstd;
        if (t >= 72) { const int cc = c - 72 * 256; if (cc < 16) { *(f32x4*)(LR + (size_t)r * 16 + cc) = v0; *(f32x4*)(LR + (size_t)r * 16 + cc + 4) = v1; } return; }
        const int mode = (t < 16) ? 1 : (((t >= 40 && t < 48) || t >= 64) ? 2 : 0);
        if (mode == 1) {
#pragma unroll
            for (int j = 0; j < 4; ++j) { v0[j] = sigm(v0[j]); v1[j] = sigm(v1[j]); } }
        if (mode == 2) {
#pragma unroll
            for (int j = 0; j < 4; ++j) { v0[j] = v0[j] * sigm(v0[j]); v1[j] = v1[j] * sigm(v1[j]); } }
        *(u32x4*)(P + (size_t)r * PW + c) = pack8(v0, v1);
    }
};
struct EpiBrA2 {
    static constexpr int DEPTH = 4; static constexpr bool MIDK = false, CONV = false, INPLACE = true, PAIR = false;
    const bf16_t* GA; const bf16_t* GB; const PG8_LAS float* RT;
    struct Pre { u32x4 a, b; };
    __device__ __forceinline__ Pre pre(int r, int c) const { Pre p; p.a = *(const u32x4*)(GA + (size_t)r * PW + c); p.b = *(const u32x4*)(GB + (size_t)r * PW + c); return p; }
    static __device__ __forceinline__ float fac(float ga, float gb, float i0) { return ga * __builtin_amdgcn_rcpf(fmaxf(gb, 1e-30f)) * i0; }
    __device__ __forceinline__ void fin_ip(int r, int, f32x4& v0, f32x4& v1, const Pre& p) const {
        const float i0 = RT[(r & 255) * 8 + 4];
        v0[0] *= fac(bflo(p.a.x), bflo(p.b.x), i0); v0[1] *= fac(bfhi(p.a.x), bfhi(p.b.x), i0); v0[2] *= fac(bflo(p.a.y), bflo(p.b.y), i0); v0[3] *= fac(bfhi(p.a.y), bfhi(p.b.y), i0);
        v1[0] *= fac(bflo(p.a.z), bflo(p.b.z), i0); v1[1] *= fac(bfhi(p.a.z), bfhi(p.b.z), i0); v1[2] *= fac(bflo(p.a.w), bflo(p.b.w), i0); v1[3] *= fac(bfhi(p.a.w), bfhi(p.b.w), i0);
    }
};
struct EpiBrB2 {
    static constexpr int DEPTH = 8; static constexpr bool MIDK = true, CONV = false, INPLACE = false, PAIR = false;
    const bf16_t* GB; bf16_t* MG; const PG8_LAS float* RT;
    struct Pre { u32x4 g; };
    __device__ __forceinline__ Pre pre(int r, int c) const { Pre p; p.g = *(const u32x4*)(GB + (size_t)r * PW + c); return p; }
    __device__ __forceinline__ void fin(int r, int c, f32x4 v0, f32x4 v1, const Pre& p) const {
        const float s3 = RT[(r & 255) * 8 + 3];
        v0[0] *= s3 * fmaxf(bflo(p.g.x), 1e-30f); v0[1] *= s3 * fmaxf(bfhi(p.g.x), 1e-30f); v0[2] *= s3 * fmaxf(bflo(p.g.y), 1e-30f); v0[3] *= s3 * fmaxf(bfhi(p.g.y), 1e-30f);
        v1[0] *= s3 * fmaxf(bflo(p.g.z), 1e-30f); v1[1] *= s3 * fmaxf(bfhi(p.g.z), 1e-30f); v1[2] *= s3 * fmaxf(bflo(p.g.w), 1e-30f); v1[3] *= s3 * fmaxf(bfhi(p.g.w), 1e-30f);
        *(u32x4*)(MG + (size_t)r * 2048 + c) = pack8(v0, v1);
    }
    __device__ __forceinline__ float ratio(int r, int seg) const { return RT[(r & 255) * 8 + seg]; }
};
struct EpiBr {
    static constexpr int DEPTH = 8; static constexpr bool MIDK = true, CONV = false, INPLACE = false, PAIR = true;
    EpiBrA2 a; EpiBrB2 b;
    __device__ __forceinline__ float ratio(int r, int seg) const { return b.ratio(r, seg); }
};
struct PairOrder {
    StaticOrder so;
    __device__ void init(int M, int N, int G_, int c_) { so.init(M, N, G_, c_); }
    __device__ bool next(int i, Unit& u) const { if (!so.next(i >> 1, u)) return false; u.sel = i & 1; return true; }
    __device__ __forceinline__ void a_ready(const Unit&) const {}
    __device__ __forceinline__ void done(const Unit&) const {}
};
struct EpiOut {
    static constexpr int DEPTH = 8; static constexpr bool MIDK = false, CONV = false, INPLACE = false, PAIR = false;
    bf16_t* XB; PG8_LAS unsigned long long* rowsum;
    struct Pre { u32x4 x; };
    __device__ __forceinline__ Pre pre(int r, int c) const { Pre p; p.x = *(const u32x4*)(XB + (size_t)r * 2048 + c); return p; }
    __device__ __forceinline__ void fin(int r, int c, f32x4 v0, f32x4 v1, const Pre& p) const {
        v0[0] += bflo(p.x.x); v0[1] += bfhi(p.x.x); v0[2] += bflo(p.x.y); v0[3] += bfhi(p.x.y); v1[0] += bflo(p.x.z); v1[1] += bfhi(p.x.z); v1[2] += bflo(p.x.w); v1[3] += bfhi(p.x.w);
        *(u32x4*)(XB + (size_t)r * 2048 + c) = pack8(v0, v1);
        const float ss = (v0[0] * v0[0] + v0[1] * v0[1]) + (v0[2] * v0[2] + v0[3] * v0[3]) + (v1[0] * v1[0] + v1[1] * v1[1]) + (v1[2] * v1[2] + v1[3] * v1[3]);
        (void)__hip_atomic_fetch_add(rowsum + (r & 255), (unsigned long long)(ss * 16777216.0f), __ATOMIC_RELAXED, __HIP_MEMORY_SCOPE_WORKGROUP);
    }
};
template <class Epi> __device__ __forceinline__ void epi_big(const Epi& E, f32x4 (&acc)[2][2][4][2], const Unit& u, int wr, int wc, int fr, int fq) {
    if constexpr (Epi::PAIR) { if (u.sel == 0) epi_big(E.a, acc, u, wr, wc, fr, fq); else epi_big(E.b, acc, u, wr, wc, fr, fq); return; } else {
    if constexpr (Epi::CONV) { if (u.pn >= 16 && u.pn < 48) { E.conv_unit(acc, u, wr, wc, fr, fq); return; } }
    const int row0 = u.pm * BM + wr * 64 + fr, col0 = u.pn * BM + wc * 32 + 8 * fq;
    constexpr int DP = Epi::DEPTH;
    typename Epi::Pre pq[DP];
#define EPI_R(i) (row0 + ((i) >> 3) * HALF + (((i) >> 1) & 3) * 16)
#define EPI_C(i) (col0 + ((i) & 1) * HALF)
#pragma unroll
    for (int i = 0; i < DP; ++i) pq[i] = E.pre(EPI_R(i), EPI_C(i));
#pragma unroll
    for (int idx = 0; idx < 16; ++idx) { const int ai = idx >> 3, m = (idx >> 1) & 3, bj = idx & 1;
        if constexpr (Epi::INPLACE) E.fin_ip(EPI_R(idx), EPI_C(idx), acc[ai][bj][m][0], acc[ai][bj][m][1], pq[idx % DP]); else E.fin(EPI_R(idx), EPI_C(idx), acc[ai][bj][m][0], acc[ai][bj][m][1], pq[idx % DP]);
        asm volatile("" ::: "memory");
        if (idx + DP < 16) pq[idx % DP] = E.pre(EPI_R(idx + DP), EPI_C(idx + DP)); }
#undef EPI_R
#undef EPI_C
    }
}
#define PG8_GAS __attribute__((address_space(1)))
constexpr int MINI_SLOT = 24576;
template <class Epi, bool ZERO0> __device__ __forceinline__ void mini_gemm_acc(PG8_LAS unsigned char* lds, const bf16_t* A, const bf16_t* Bt, int K, int row0, int col0, const Epi& E, f32x4 (&acc)[2][2]) {
    int tid_ = threadIdx.x; asm volatile("" : "+v"(tid_));
    const int tid = tid_, wid = __builtin_amdgcn_readfirstlane(tid >> 6), lane = tid & 63, r16 = lane & 15, quad = lane >> 4, wrow = wid >> 1, wcol = wid & 1;
    const PG8_GAS char* src[3];
#pragma unroll
    for (int i = 0; i < 2; ++i) { const int q = 64 * (wid + 8 * i) + lane, row = q >> 3, p = (q & 7) ^ ((row >> 1) & 7); src[i] = (const PG8_GAS char*)(A + (size_t)(row0 + row) * K + 8 * p); }
    { const int q = 64 * wid + lane, row = q >> 3, p = (q & 7) ^ ((row >> 1) & 7); src[2] = (const PG8_GAS char*)(Bt + (size_t)(col0 + (row & ~31) + perm32(row & 31)) * K + 8 * p); }
    const int nkt = K / 64;
    const int dst0 = wid * 1024 + lane * 16, dst1 = (wid + 8) * 1024 + lane * 16, dst2 = (16 + wid) * 1024 + lane * 16;
    if constexpr (ZERO0) {
#pragma unroll
    for (int i = 0; i < 2; ++i)
#pragma unroll
        for (int j = 0; j < 2; ++j) acc[i][j] = (f32x4){0.f, 0.f, 0.f, 0.f};
    }
    int aoff[2], boff[2];
#pragma unroll
    for (int t = 0; t < 2; ++t) { const int ra = 32 * wrow + 16 * t + r16, rb = 32 * wcol + 16 * t + r16; aoff[t] = ra * 128; boff[t] = 16384 + rb * 128; }
    const int sw = (r16 >> 1) & 7;
    constexpr int PD = 4;
    u32x4 q[PD][3];
#pragma unroll
    for (int p = 0; p < PD; ++p)
#pragma unroll
        for (int i = 0; i < 3; ++i) q[p][i] = *(const PG8_GAS u32x4*)(src[i] + (size_t)p * 128);
#pragma unroll 1
    for (int kt0 = 0; kt0 < nkt; kt0 += PD) {
#pragma unroll
        for (int p = 0; p < PD; ++p) { const int kt = kt0 + p;
            PG8_LAS unsigned char* sl = lds + (p & 1) * MINI_SLOT;
            *(PG8_LAS u32x4*)(sl + dst0) = q[p][0]; *(PG8_LAS u32x4*)(sl + dst1) = q[p][1]; *(PG8_LAS u32x4*)(sl + dst2) = q[p][2];
            { const int kk = kt + PD < nkt ? kt + PD : nkt - 1;
#pragma unroll
              for (int i = 0; i < 3; ++i) q[p][i] = *(const PG8_GAS u32x4*)(src[i] + (size_t)kk * 128); }
            asm volatile("s_waitcnt lgkmcnt(0)" ::: "memory"); __builtin_amdgcn_s_barrier(); asm volatile("" ::: "memory");
            if constexpr (Epi::MIDK) { if (p == 0 && (kt0 == 8 || kt0 == 16 || kt0 == 24)) { const int seg = (kt0 >> 3) - 1;
#pragma unroll
                for (int mt = 0; mt < 2; ++mt) { const float rho = E.ratio(row0 + 32 * wrow + 16 * mt + r16, seg); acc[mt][0] = acc[mt][0] * rho; acc[mt][1] = acc[mt][1] * rho; } } }
#pragma unroll
            for (int ks = 0; ks < 2; ++ks) { bf16x8 af[2], bfr[2];
#pragma unroll
                for (int t = 0; t < 2; ++t) { af[t] = *(const PG8_LAS bf16x8*)(sl + aoff[t] + (((4 * ks + quad) ^ sw) << 4)); bfr[t] = *(const PG8_LAS bf16x8*)(sl + boff[t] + (((4 * ks + quad) ^ sw) << 4)); }
#pragma unroll
                for (int mt = 0; mt < 2; ++mt)
#pragma unroll
                    for (int nt = 0; nt < 2; ++nt) acc[mt][nt] = __builtin_amdgcn_mfma_f32_16x16x32_bf16(bfr[nt], af[mt], acc[mt][nt], 0, 0, 0); }
        }
    }
    asm volatile("s_waitcnt lgkmcnt(0)" ::: "memory"); __builtin_amdgcn_s_barrier(); asm volatile("" ::: "memory");
    const int r = row0 + 32 * wrow + r16, c = col0 + 32 * wcol + 8 * quad;
    typename Epi::Pre p0 = E.pre(r, c), p1 = E.pre(r + 16, c);
    if constexpr (Epi::INPLACE) { E.fin_ip(r, c, acc[0][0], acc[0][1], p0); E.fin_ip(r + 16, c, acc[1][0], acc[1][1], p1); }
    else { E.fin(r, c, acc[0][0], acc[0][1], p0); E.fin(r + 16, c, acc[1][0], acc[1][1], p1); }
}
template <class Epi> __device__ __forceinline__ void mini_gemm(PG8_LAS unsigned char* lds, const bf16_t* A, const bf16_t* Bt, int K, int row0, int col0, const Epi& E) { f32x4 acc[2][2]; mini_gemm_acc<Epi, true>(lds, A, Bt, K, row0, col0, E, acc); }
struct ProjOrder {
    StaticOrder so; int G, c;
    __device__ void init(int G_, int c_) { so.init(8192, 18432, G_, c_); G = G_; c = c_; }
    __device__ bool next(int i, Unit& u) const {
        const long L = (long)i * G + c;
        if (L < 2304) return so.next(i, u);
        if (L < 2560) { const int j = (int)L - 2304; u.pm = 32 + (j & 3); u.pn = j >> 2; u.sel = 0; return true; }
        return false;
    }
    __device__ __forceinline__ void a_ready(const Unit&) const {}
    __device__ __forceinline__ void done(const Unit&) const {}
};
template <class Epi, class Sched, bool ALIGN_EPI, bool SP2, bool ZERO0>
__device__ __forceinline__ void gemm_phase_acc(PG8_LAS unsigned char* lds, const Gemm g, const Sched& S, const Epi& E, f32x4 (&acc)[2][2][4][2]) {
    int tid_ = threadIdx.x; asm volatile("" : "+v"(tid_));
    const int tid = tid_, wid = __builtin_amdgcn_readfirstlane(tid >> 6), lane = tid & 63, wr = wid >> 2, wc = wid & 3, fr = lane & 15, fq = lane >> 4;
    const int K = g.K, nt = K / BK;
    unsigned voffA[2], voffB[2];
#pragma unroll
    for (int i = 0; i < 2; ++i) { int R, C; stage_rc(tid * 16 + i * 8192, R, C); const int Rb = (R & ~31) + perm32(R & 31);
        voffA[i] = (unsigned)(R * K + C) * 2u; voffB[i] = (unsigned)(Rb * K + C) * 2u; }
    const size_t kstep = (size_t)(BK * 2);
    const size_t hstep = (size_t)HALF * K * 2;
    const size_t tstep = 2 * hstep;
    const unsigned ldsw = (unsigned)wid * 1024u;
    const int aoff = lds_byte(wr * 64 + fr, fq * 8), boff = lds_byte(wc * 32 + fr, fq * 8);
#define PG8_SA(b, h) (((b) * 2 + (h)) * HTB)
#define PG8_SB(b, h) ((4 + (b) * 2 + (h)) * HTB)
#define PG8_STAGE(bufoff, gbase, voff) do { _Pragma("unroll") for (int _i = 0; _i < 2; ++_i) \
        __builtin_amdgcn_global_load_lds((const unsigned*)((const char*)(gbase) + (voff)[_i]), (PG8_LAS unsigned*)(lds + (bufoff) + ldsw + _i * 8192), 16, 0, 0); } while (0)
#define PG8_LDA(dst, b, h) do { _Pragma("unroll") for (int m = 0; m < 4; ++m) _Pragma("unroll") for (int k = 0; k < 2; ++k) dst[m][k] = *(const PG8_LAS bf16x8*)(lds + PG8_SA(b, h) + aoff + m * 2048 + k * 1024); } while (0)
#define PG8_LDB(dst, b, h) do { _Pragma("unroll") for (int n = 0; n < 2; ++n) _Pragma("unroll") for (int k = 0; k < 2; ++k) dst[n][k] = *(const PG8_LAS bf16x8*)(lds + PG8_SB(b, h) + boff + n * 2048 + k * 1024); } while (0)
#define PG8_MMA(ai, bj, At, Bt) do { __builtin_amdgcn_s_setprio(1); _Pragma("unroll") for (int m = 0; m < 4; ++m) _Pragma("unroll") for (int n = 0; n < 2; ++n) _Pragma("unroll") for (int k = 0; k < 2; ++k) \
        acc[ai][bj][m][n] = __builtin_amdgcn_mfma_f32_16x16x32_bf16(Bt[n][k], At[m][k], acc[ai][bj][m][n], 0, 0, 0); __builtin_amdgcn_s_setprio(0); } while (0)
#define PG8_WAIT_V(n) asm volatile("s_waitcnt vmcnt(" #n ")" ::: "memory")
#define PG8_WAIT_L(n) asm volatile("s_waitcnt lgkmcnt(" #n ")" ::: "memory")
#define PG8_BAR __builtin_amdgcn_s_barrier()
#define PG8_SCHED __builtin_amdgcn_sched_barrier(0)
    Unit cur, nxt; int ui = 0;
    if (!S.next(0, cur)) return;
    if constexpr (ZERO0) {
#pragma unroll
    for (int a = 0; a < 2; ++a)
#pragma unroll
        for (int b = 0; b < 2; ++b)
#pragma unroll
            for (int m = 0; m < 4; ++m)
#pragma unroll
                for (int n = 0; n < 2; ++n) acc[a][b][m][n] = (f32x4){0.f, 0.f, 0.f, 0.f};
    }
    bf16x8 At[4][2], B0[2][2], B1[2][2];
    const char* cA = (const char*)(cur.sel ? g.A2 : g.A) + (size_t)cur.pm * tstep; const char* cB = (const char*)(cur.sel ? g.Bt2 : g.Bt) + (size_t)cur.pn * tstep;
    S.a_ready(cur);
    if constexpr (SP2) {
        PG8_STAGE(PG8_SB(0, 0), cB, voffB); PG8_STAGE(PG8_SB(0, 1), cB + hstep, voffB); PG8_STAGE(PG8_SA(0, 0), cA, voffA); PG8_STAGE(PG8_SA(0, 1), cA + hstep, voffA);
        if (wr == 1) PG8_BAR;
        PG8_WAIT_V(2); PG8_BAR;
        PG8_STAGE(PG8_SB(1, 0), cB + kstep, voffB); PG8_STAGE(PG8_SA(1, 0), cA + kstep, voffA); PG8_STAGE(PG8_SB(1, 1), cB + hstep + kstep, voffB);
        PG8_WAIT_V(6); PG8_BAR;
    } else {
        PG8_STAGE(PG8_SB(0, 0), cB, voffB); PG8_STAGE(PG8_SA(0, 0), cA, voffA); PG8_STAGE(PG8_SB(0, 1), cB + hstep, voffB); PG8_STAGE(PG8_SA(0, 1), cA + hstep, voffA);
        if (wr == 1) PG8_BAR;
        PG8_WAIT_V(4); PG8_BAR;
        PG8_STAGE(PG8_SB(1, 0), cB + kstep, voffB); PG8_STAGE(PG8_SA(1, 0), cA + kstep, voffA); PG8_STAGE(PG8_SB(1, 1), cB + hstep + kstep, voffB);
        PG8_WAIT_V(6); PG8_BAR;
    }
    for (;;) {
        const bool has_next = S.next(ui + 1, nxt);
        const char* nA = has_next ? (const char*)(nxt.sel ? g.A2 : g.A) + (size_t)nxt.pm * tstep : cA; const char* nB = has_next ? (const char*)(nxt.sel ? g.Bt2 : g.Bt) + (size_t)nxt.pn * tstep : cB;
        for (int t = 0; t < nt; t += 2) {
            if constexpr (Epi::MIDK) { if (cur.sel == 1 && (t == 8 || t == 16 || t == 24)) {
                const int seg = (t >> 3) - 1;
#pragma unroll
                for (int ai = 0; ai < 2; ++ai)
#pragma unroll
                    for (int m = 0; m < 4; ++m) { const float rho = E.ratio(ai * HALF + wr * 64 + m * 16 + fr, seg);
#pragma unroll
                        for (int bj = 0; bj < 2; ++bj)
#pragma unroll
                            for (int n = 0; n < 2; ++n) acc[ai][bj][m][n] = acc[ai][bj][m][n] * rho; } } }
            const bool last = (t == nt - 2);
            const char* a1 = cA + (size_t)(t + 1) * kstep;
            const char* a2 = last ? nA : cA + (size_t)(t + 2) * kstep; const char* b2 = last ? nB : cB + (size_t)(t + 2) * kstep;
            const char* a3 = a2 + kstep; const char* b3 = b2 + kstep;
            if (last && has_next) S.a_ready(nxt);
            if constexpr (SP2) {
            PG8_LDB(B0, 0, 0); PG8_LDB(B1, 0, 1); PG8_SCHED; PG8_LDA(At, 0, 0); PG8_STAGE(PG8_SA(1, 1), a1 + hstep, voffA);
            PG8_WAIT_V(8); PG8_WAIT_L(0); PG8_BAR; PG8_MMA(0, 0, At, B0); PG8_MMA(0, 1, At, B1); PG8_BAR; PG8_SCHED;
            PG8_LDA(At, 0, 1); PG8_STAGE(PG8_SB(0, 0), b2, voffB); PG8_STAGE(PG8_SB(0, 1), b2 + hstep, voffB); PG8_STAGE(PG8_SA(0, 0), a2, voffA);
            PG8_WAIT_V(8); PG8_WAIT_L(0); PG8_BAR; PG8_MMA(1, 0, At, B0); PG8_MMA(1, 1, At, B1); PG8_BAR; PG8_SCHED;
            PG8_LDB(B0, 1, 0); PG8_LDB(B1, 1, 1); PG8_SCHED; PG8_LDA(At, 1, 0); PG8_STAGE(PG8_SA(0, 1), a2 + hstep, voffA);
            PG8_WAIT_V(8); PG8_WAIT_L(0); PG8_BAR; PG8_MMA(0, 0, At, B0); PG8_MMA(0, 1, At, B1); PG8_BAR; PG8_SCHED;
            PG8_LDA(At, 1, 1); PG8_STAGE(PG8_SB(1, 0), b3, voffB); PG8_STAGE(PG8_SB(1, 1), b3 + hstep, voffB); PG8_STAGE(PG8_SA(1, 0), a3, voffA);
            PG8_WAIT_V(8); PG8_WAIT_L(0); PG8_BAR; PG8_MMA(1, 0, At, B0); PG8_MMA(1, 1, At, B1); PG8_BAR; PG8_SCHED;
            } else {
            PG8_LDB(B0, 0, 0); PG8_SCHED; PG8_LDA(At, 0, 0); PG8_STAGE(PG8_SA(1, 1), a1 + hstep, voffA);
            PG8_WAIT_L(8); PG8_BAR; PG8_WAIT_L(0); PG8_MMA(0, 0, At, B0); PG8_BAR; PG8_SCHED;
            PG8_LDB(B1, 0, 1); PG8_STAGE(PG8_SB(0, 0), b2, voffB);
            PG8_BAR; PG8_WAIT_L(0); PG8_MMA(0, 1, At, B1); PG8_BAR;
            PG8_LDA(At, 0, 1); PG8_STAGE(PG8_SA(0, 0), a2, voffA);
            PG8_BAR; PG8_WAIT_L(0); PG8_MMA(1, 0, At, B0); PG8_BAR; PG8_SCHED;
            PG8_STAGE(PG8_SB(0, 1), b2 + hstep, voffB);
            PG8_WAIT_V(6); PG8_BAR; PG8_MMA(1, 1, At, B1); PG8_BAR;
            PG8_LDB(B0, 1, 0); PG8_SCHED; PG8_LDA(At, 1, 0); PG8_STAGE(PG8_SA(0, 1), a2 + hstep, voffA);
            PG8_WAIT_L(8); PG8_BAR; PG8_WAIT_L(0); PG8_MMA(0, 0, At, B0); PG8_BAR; PG8_SCHED;
            PG8_LDB(B1, 1, 1); PG8_STAGE(PG8_SB(1, 0), b3, voffB);
            PG8_BAR; PG8_WAIT_L(0); PG8_MMA(0, 1, At, B1); PG8_BAR;
            PG8_LDA(At, 1, 1); PG8_STAGE(PG8_SA(1, 0), a3, voffA);
            PG8_BAR; PG8_WAIT_L(0); PG8_MMA(1, 0, At, B0); PG8_BAR; PG8_SCHED;
            PG8_STAGE(PG8_SB(1, 1), b3 + hstep, voffB);
            PG8_WAIT_V(6); PG8_BAR; PG8_MMA(1, 1, At, B1); PG8_BAR;
            }
        }
        if constexpr (ALIGN_EPI) { if (wr == 0) PG8_BAR; }
        epi_big(E, acc, cur, wr, wc, fr, fq); S.done(cur);
        if (!has_next) break;
        if (nxt.sel == 0) {
#pragma unroll
        for (int a = 0; a < 2; ++a)
#pragma unroll
            for (int b = 0; b < 2; ++b)
#pragma unroll
                for (int m = 0; m < 4; ++m)
#pragma unroll
                    for (int n = 0; n < 2; ++n) acc[a][b][m][n] = (f32x4){0.f, 0.f, 0.f, 0.f};
        }
        cur = nxt; cA = nA; cB = nB; ++ui;
        if constexpr (ALIGN_EPI) { if (wr == 1) PG8_BAR; }
    }
    PG8_WAIT_V(0);
    if constexpr (!ALIGN_EPI) { if (wr == 0) PG8_BAR; }
    PG8_BAR;
#undef PG8_SA
#undef PG8_SB
#undef PG8_STAGE
#undef PG8_LDA
#undef PG8_LDB
#undef PG8_MMA
#undef PG8_WAIT_V
#undef PG8_WAIT_L
#undef PG8_BAR
#undef PG8_SCHED
}
template <class Epi, class Sched, bool ALIGN_EPI = false, bool SP2 = false>
__device__ __forceinline__ void gemm_phase(PG8_LAS unsigned char* lds, const Gemm g, const Sched& S, const Epi& E) { f32x4 acc[2][2][4][2]; gemm_phase_acc<Epi, Sched, ALIGN_EPI, SP2, true>(lds, g, S, E, acc); }
}

constexpr int D = 2048, M = 9216, MP = 8192, DEPTH = 4, NWAVES = 8;
constexpr int INW = 18448, NPAD = 18496, PW = pg8::PW;
constexpr int C_GA = 0, C_GB = 2048, C_CB = 4096, C_CC = 6144, C_CX = 8192, C_CG = 10240, C_Q = 12288, C_K = 13312, C_V = 14336, C_GG = 16384;
constexpr float EPS = 1e-6f;
constexpr size_t O_Y = 0, O_CONVP = 18874368, O_GLAP = 18939904, O_CONVS = 27328512, O_GLAS = 29425664, O_END = 297861120;
constexpr size_t MiB = 1u << 20;
constexpr size_t WS_CTL = 0, CTL_ZERO_BYTES = 2 * MiB;
constexpr size_t WS_WIN = 2 * MiB, WIN_L = (size_t)NPAD * D * 2;
constexpr size_t WS_WA = 296 * MiB, WS_WB = 328 * MiB, WS_WO = 360 * MiB, W_L = (size_t)D * D * 2;
constexpr size_t WS_XF = 392 * MiB, WS_XB = 464 * MiB, WS_P = 500 * MiB, WS_ZA = 824 * MiB, WS_ZB = 860 * MiB, WS_MG = 896 * MiB;
constexpr size_t WS_O = 932 * MiB, WS_T = 1004 * MiB, WS_LR = 1076 * MiB, WS_RSTD = 1077 * MiB, WS_END = 1078 * MiB;
static_assert(WS_WIN + 4 * WIN_L <= WS_WA, "ws map");
constexpr int CW_BAR = 4096;
constexpr size_t WS_RSO = 524288;
constexpr size_t WS_RSQ = 65536;
constexpr int RING_OFF = 0, RING_BYTES = 131072, ROWSUM_OFF = 147456, LDSCTL_OFF = 149504, MISC_OFF = LDSCTL_OFF + 320, RT_OFF = 150528, LDS_BYTES = 158720;

#define GAS __attribute__((address_space(1)))
#define LAS __attribute__((address_space(3)))
typedef unsigned short bf16;
typedef unsigned v4u __attribute__((ext_vector_type(4)));
typedef unsigned v2u __attribute__((ext_vector_type(2)));
typedef float f32x4 __attribute__((ext_vector_type(4)));
typedef GAS unsigned gu32;
#define RLX_AGENT __ATOMIC_RELAXED, __HIP_MEMORY_SCOPE_AGENT
#define LDS_WAIT() asm volatile("s_waitcnt lgkmcnt(0)" ::: "memory")
#define VM_WAIT() asm volatile("s_waitcnt vmcnt(0)" ::: "memory")
__device__ __forceinline__ unsigned f2bf(float f) { unsigned u = __builtin_bit_cast(unsigned, f); return (u + 0x7fffu + ((u >> 16) & 1u)) >> 16; }
__device__ __forceinline__ unsigned pk2(float lo, float hi) { return f2bf(lo) | (f2bf(hi) << 16); }
__device__ __forceinline__ float bflo(unsigned w) { return __uint_as_float(w << 16); }
__device__ __forceinline__ float bfhi(unsigned w) { return __uint_as_float(w & 0xffff0000u); }
__device__ __forceinline__ float bf1(bf16 b) { return __uint_as_float(((unsigned)b) << 16); }

typedef short bf16x8 __attribute__((ext_vector_type(8)));
typedef float f32x2 __attribute__((ext_vector_type(2)));
typedef __bf16 bf16x2_t __attribute__((ext_vector_type(2)));
__device__ __forceinline__ unsigned pkbf(float a, float b) { f32x2 v = {a, b}; bf16x2_t r = __builtin_convertvector(v, bf16x2_t); return __builtin_bit_cast(unsigned, r); }
#define XB_TMO      128
#define XB_XCNT(j)  (256  + 64 * (j))
#define XB_XSUB(j)  (1280 + 64 * (j))
#define XB_XGEN(j)  (2304 + 64 * (j))
#define XB_TOP      3328
#define XB_TOPGEN   3392
#define XCD_BAR_WORDS 3456
#define XB_SPIN_CAP (1u << 18)
__device__ __forceinline__ unsigned xb_ld(unsigned* p)              { return __hip_atomic_load(p, __ATOMIC_RELAXED, __HIP_MEMORY_SCOPE_AGENT); }
__device__ __forceinline__ unsigned xb_add(unsigned* p, unsigned v) { return __hip_atomic_fetch_add(p, v, __ATOMIC_RELAXED, __HIP_MEMORY_SCOPE_AGENT); }
__device__ __forceinline__ unsigned xb_xcc_id() { return (unsigned)__builtin_amdgcn_s_getreg((3 << 11) | 20) & 0xFu; }
#define XB_SPIN(cond, bar) do { unsigned _sp = 0; while (cond) { __builtin_amdgcn_s_sleep(1); \
    if ((++_sp & 255u) == 0u) { if (xb_ld(&(bar)[XB_TMO])) break; if (_sp > XB_SPIN_CAP) { atomicAdd(&(bar)[XB_TMO], 1u); break; } } } } while (0)
struct XcdBarrier { unsigned* bar; unsigned x; volatile LAS unsigned* st; };
__device__ __forceinline__ XcdBarrier xcd_barrier_post(unsigned* bar, volatile LAS unsigned* st) {
    XcdBarrier b; b.bar = bar; b.x = xb_xcc_id(); b.st = st;
    if (threadIdx.x == 0) (void)xb_add(&bar[XB_XCNT(b.x)], 1u);
    return b;
}
__device__ __forceinline__ void xcd_barrier_complete(unsigned* bar, unsigned x, unsigned& nloc, unsigned& nx) {
    const unsigned G = gridDim.x * gridDim.y * gridDim.z;
    unsigned sum, cnt, mine, sp = 0u;
    for (;;) {
        sum = 0u; cnt = 0u; mine = 0u;
#pragma unroll
        for (unsigned j = 0; j < 16; ++j) { const unsigned c = xb_ld(&bar[XB_XCNT(j)]); sum += c; cnt += (c > 0u) ? 1u : 0u; mine = (j == x) ? c : mine; }
        if (sum == G) break;
        __builtin_amdgcn_s_sleep(1);
        if ((++sp & 255u) == 0u) { if (xb_ld(&bar[XB_TMO])) break; if (sp > XB_SPIN_CAP) { atomicAdd(&bar[XB_TMO], 1u); break; } }
    }
    nloc = mine > 0u ? mine : 1u; nx = cnt > 0u ? cnt : 1u;
}
__device__ __forceinline__ void xcd_barrier(const XcdBarrier& b) {
    asm volatile("s_waitcnt vmcnt(0)" ::: "memory");
    __syncthreads();
    if (threadIdx.x == 0) {
        unsigned* bar = b.bar;
        __builtin_amdgcn_s_waitcnt(0);
        unsigned nloc = b.st[0], nx = b.st[1];
        if (nloc == 0u) { xcd_barrier_complete(bar, b.x, nloc, nx); b.st[0] = nloc; b.st[1] = nx; }
        const unsigned old = xb_add(&bar[XB_XSUB(b.x)], 1u);
        const unsigned gen = old / nloc;
        if (old + 1u == (gen + 1u) * nloc) {
            __builtin_amdgcn_fence(__ATOMIC_RELEASE, "agent");
            asm volatile("s_waitcnt vmcnt(0)" ::: "memory");
            const unsigned og = xb_add(&bar[XB_TOP], 1u);
            const unsigned tg = og / nx;
            if (og + 1u == (tg + 1u) * nx) xb_add(&bar[XB_TOPGEN], 1u);
            else XB_SPIN(xb_ld(&bar[XB_TOPGEN]) == tg, bar);
            __builtin_amdgcn_fence(__ATOMIC_ACQUIRE, "agent");
            xb_add(&bar[XB_XGEN(b.x)], 1u);
            asm volatile("s_waitcnt vmcnt(0)" ::: "memory");
        } else {
            XB_SPIN(xb_ld(&bar[XB_XGEN(b.x)]) == gen, bar);
            __builtin_amdgcn_fence(__ATOMIC_ACQUIRE, "agent");
            asm volatile("s_waitcnt vmcnt(0)" ::: "memory");
        }
    }
    __syncthreads();
}

struct Frame {
    LAS unsigned char* lds;
    int tid, lane, wave, vcu, G;
};
__device__ __forceinline__ const float* inp(int k) { asm volatile("" : "+s"(k)); const unsigned long long* ka = (const unsigned long long*)__builtin_amdgcn_kernarg_segment_ptr(); return (const float*)(const GAS float*)ka[k]; }
__device__ __forceinline__ unsigned char* wsp() { return (unsigned char*)inp(15); }
__device__ __forceinline__ float* outp() { return (float*)inp(14); }
enum { I_XP = 0, I_XS, I_SCONV, I_SGLA, I_NORMG, I_WIN, I_CONVW, I_WA2, I_BA, I_GNORMG, I_WBA, I_WBB, I_WO, I_FING };
__device__ __forceinline__ float wave_sum(float v) {
#pragma unroll
    for (int o = 1; o < 64; o <<= 1) v += __shfl_xor(v, o);
    return v;
}
__device__ __forceinline__ void tr_item(const float* W, int ldw, int nvalid, int K, bf16* WT, int nblk, const float* s, int smask, int item, int lane, bool perm) {
    const int kb = item / nblk, nb = item % nblk, k0 = 64 * kb, n = 64 * nb + lane;
    int nd = n;
    if (perm && n >= 4096 && n < 12288) { const int sct = (n - 4096) >> 11, ch = (n - 4096) & 2047, c64 = ch & 63; nd = 4096 + (ch >> 6) * 256 + 128 * (sct >> 1) + 32 * (c64 >> 4) + 8 * ((c64 >> 2) & 3) + 4 * (sct & 1) + (c64 & 3); }
    float v[64];
    if (n < nvalid) { const float* p = W + (size_t)k0 * ldw + n;
#pragma unroll
        for (int i = 0; i < 64; ++i) v[i] = p[(size_t)i * ldw]; }
    else {
#pragma unroll
        for (int i = 0; i < 64; ++i) v[i] = 0.f; }
    if (s) {
#pragma unroll
        for (int i = 0; i < 64; ++i) v[i] *= s[(k0 + i) & smask]; }
    GAS v4u* d = (GAS v4u*)(WT + (size_t)nd * K + k0);
#pragma unroll
    for (int c = 0; c < 8; ++c) { v4u o; o.x = pkbf(v[8 * c], v[8 * c + 1]); o.y = pkbf(v[8 * c + 2], v[8 * c + 3]); o.z = pkbf(v[8 * c + 4], v[8 * c + 5]); o.w = pkbf(v[8 * c + 6], v[8 * c + 7]); d[c] = o; }
}
__device__ __forceinline__ void p_prologue(Frame& F0) {
    Frame F = F0; asm volatile("" : "+v"(F.tid), "+v"(F.lane));
    const int gw = F.vcu * NWAVES + F.wave, NGW = F.G * NWAVES;
    constexpr int I_IN = (D / 64) * (NPAD / 64), I_SQ = (D / 64) * (D / 64), I_L = I_IN + 3 * I_SQ;
    for (int it = gw; it < DEPTH * I_L; it += NGW) {
        const int l = it / I_L; int r = it % I_L;
        if (r < I_IN) { tr_item(inp(I_WIN) + (size_t)l * D * INW, INW, INW, D, (bf16*)(wsp() + WS_WIN + l * WIN_L), NPAD / 64, inp(I_NORMG) + l * D, 0xffff, r, F.lane, true); continue; } r -= I_IN;
        if (r < I_SQ) { tr_item(inp(I_WBA) + (size_t)l * D * D, D, D, D, (bf16*)(wsp() + WS_WA + l * W_L), D / 64, nullptr, 0, r, F.lane, false); continue; } r -= I_SQ;
        if (r < I_SQ) { tr_item(inp(I_WBB) + (size_t)l * D * D, D, D, D, (bf16*)(wsp() + WS_WB + l * W_L), D / 64, inp(I_GNORMG) + l * 512, 511, r, F.lane, false); continue; } r -= I_SQ;
        tr_item(inp(I_WO) + (size_t)l * D * D, D, D, D, (bf16*)(wsp() + WS_WO + l * W_L), D / 64, nullptr, 0, r, F.lane, false);
    }
}
__device__ __forceinline__ void p_xprep(Frame& F0, int l) {
    Frame F = F0; asm volatile("" : "+v"(F.tid), "+v"(F.lane));
    const int gw = F.vcu * NWAVES + F.wave, NGW = F.G * NWAVES;
    bf16* XB = (bf16*)(wsp() + WS_XB); unsigned long long* RS = (unsigned long long*)(wsp() + WS_RSQ);
    for (int r = gw; r < M; r += NGW) {
        const float* src = r < MP ? inp(I_XP) + (size_t)r * D : inp(I_XS) + (size_t)(r - MP) * D;
        const GAS f32x4* s4 = (const GAS f32x4*)src + F.lane;
        f32x4 v[8]; float ss = 0.f;
#pragma unroll
        for (int j = 0; j < 8; ++j) { v[j] = s4[64 * j]; ss += (v[j].x * v[j].x + v[j].y * v[j].y) + (v[j].z * v[j].z + v[j].w * v[j].w); }
        const float tot = wave_sum(ss);
        if (F.lane == 0) RS[r] = (unsigned long long)(tot * 16777216.0f);
        GAS unsigned long long* o8 = (GAS unsigned long long*)(XB + (size_t)r * D) + F.lane;
#pragma unroll
        for (int j = 0; j < 8; ++j) o8[64 * j] = (unsigned long long)pk2(v[j].x, v[j].y) | ((unsigned long long)pk2(v[j].z, v[j].w) << 32);
    }
}
__device__ __forceinline__ void p_final(Frame& F0) {
    Frame F = F0; asm volatile("" : "+v"(F.tid), "+v"(F.lane));
    const int gw = F.vcu * NWAVES + F.wave, NGW = F.G * NWAVES;
    const bf16* XB = (const bf16*)(wsp() + WS_XB);
    f32x4 gn[8];
    { const GAS f32x4* g4 = (const GAS f32x4*)inp(I_FING) + F.lane;
#pragma unroll
      for (int j = 0; j < 8; ++j) gn[j] = g4[64 * j]; }
    for (int r = gw; r < M; r += NGW) {
        const GAS v2u* s2 = (const GAS v2u*)(XB + (size_t)r * D) + F.lane;
        f32x4 v[8];
#pragma unroll
        for (int j = 0; j < 8; ++j) { const v2u w = s2[64 * j]; v[j] = (f32x4){bflo(w.x), bfhi(w.x), bflo(w.y), bfhi(w.y)}; }
        const float rstd = 1.f / sqrtf((float)((const unsigned long long*)(wsp() + WS_RSQ))[DEPTH * M + r] * (1.0f / 16777216.0f) * (1.f / D) + EPS);
        GAS f32x4* d4 = (GAS f32x4*)(outp() + O_Y + (size_t)r * D) + F.lane;
#pragma unroll
        for (int j = 0; j < 8; ++j) d4[64 * j] = v[j] * rstd * gn[j];
    }
}
__device__ __forceinline__ unsigned short bf1r(float a) { return (unsigned short)(pkbf(a, 0.f) & 0xffffu); }
__device__ __forceinline__ float logsig16(float a) { return (fminf(a, 0.f) - 0.69314718f * __builtin_amdgcn_logf(1.0f + __builtin_amdgcn_exp2f(-1.44269504f * fabsf(a)))) * 0.0625f; }
__device__ __forceinline__ float fexp(float x) { return __builtin_amdgcn_exp2f(1.44269504f * x); }
__device__ __forceinline__ int qt_off(int t, int p) { return t * 512 + (((p & 16) | ((p ^ t) & 15)) << 4); }
__device__ __forceinline__ int r8_off(int r, int p) { return r * 128 + ((p ^ ((r >> 1) & 7)) << 4); }
__device__ __forceinline__ int qt_pos(int k) { const int k32 = k & 31; return (k & ~31) + 8 * ((k32 & 15) >> 2) + 4 * (k32 >> 4) + (k32 & 3); }
constexpr size_t WS_QT = 1078 * MiB, WS_KD = 1094 * MiB, WS_AI = 1110 * MiB, WS_GM = 1114 * MiB, WS_VT = 1115 * MiB, WS_END2 = 1147 * MiB;
constexpr int QT_B = 32768, KD_B = 32768, AI_B = 8192, GM_B = 1024, VT_B = 65536, SCAN_BUF = QT_B + KD_B + AI_B + GM_B;

__device__ __forceinline__ void p_gla_prep(Frame& F0, int l) {
    Frame F = F0; asm volatile("" : "+v"(F.tid), "+v"(F.lane));
    const bf16* P = (const bf16*)(wsp() + WS_P); const float* LR = (const float*)(wsp() + WS_LR);
    LAS unsigned char* Qs = F.lds; LAS unsigned char* Ks = F.lds + 32768; LAS unsigned char* VTs = F.lds;
    LAS unsigned char* Qraw = F.lds + 65536; LAS unsigned char* Kraw = F.lds + 98304;
    LAS float* LRs = (LAS float*)(F.lds + 131072); LAS float* TOT = (LAS float*)(F.lds + 135168);
    const int k = F.tid & 255, half = F.tid >> 8;
    for (int item = F.vcu; item < 512; item += F.G) {
        const int b = item >> 7, c = (item >> 2) & 31, h = item & 3, r0 = b * 2048 + c * 64;
        v4u va[4], vb[4], qv[4], kv[4]; f32x4 lrv = {0.f, 0.f, 0.f, 0.f};
#pragma unroll
        for (int i = 0; i < 4; ++i) { const int id = i * 512 + F.tid, tp = id & 31, pc = id >> 5;
            va[i] = *(const GAS v4u*)(P + (size_t)(r0 + 2 * tp) * PW + C_V + h * 512 + 8 * pc); vb[i] = *(const GAS v4u*)(P + (size_t)(r0 + 2 * tp + 1) * PW + C_V + h * 512 + 8 * pc);
            const int t = id >> 5, p = id & 31;
            qv[i] = *(const GAS v4u*)(P + (size_t)(r0 + t) * PW + C_Q + h * 256 + 8 * p); kv[i] = *(const GAS v4u*)(P + (size_t)(r0 + t) * PW + C_K + h * 256 + 8 * p); }
        if (F.tid < 256) lrv = *(const GAS f32x4*)(LR + (size_t)r0 * 16 + 4 * F.tid);
        float w2[16]; const float bias = inp(I_BA)[l * 1024 + h * 256 + k];
        { const float* w2p = inp(I_WA2) + (size_t)l * 16 * 1024 + h * 256 + k;
#pragma unroll
          for (int j = 0; j < 16; ++j) w2[j] = w2p[j * 1024]; }
#pragma unroll
        for (int i = 0; i < 4; ++i) { const int id = i * 512 + F.tid, tp = id & 31, pc = id >> 5; const v4u a = va[i], bb = vb[i];
            LAS unsigned* d = (LAS unsigned*)(VTs + (8 * pc) * 128 + 4 * tp);
            d[0 * 32] = (a.x & 0xffffu) | (bb.x << 16); d[1 * 32] = (a.x >> 16) | (bb.x & 0xffff0000u); d[2 * 32] = (a.y & 0xffffu) | (bb.y << 16); d[3 * 32] = (a.y >> 16) | (bb.y & 0xffff0000u);
            d[4 * 32] = (a.z & 0xffffu) | (bb.z << 16); d[5 * 32] = (a.z >> 16) | (bb.z & 0xffff0000u); d[6 * 32] = (a.w & 0xffffu) | (bb.w << 16); d[7 * 32] = (a.w >> 16) | (bb.w & 0xffff0000u);
            *(LAS v4u*)(Qraw + id * 16) = qv[i]; *(LAS v4u*)(Kraw + id * 16) = kv[i]; }
        if (F.tid < 256) *(LAS f32x4*)(LRs + 4 * F.tid) = lrv;
        __syncthreads();
        { GAS v4u* dst = (GAS v4u*)(wsp() + WS_VT + (size_t)item * VT_B);
#pragma unroll
          for (int i = 0; i < 8; ++i) dst[i * 512 + F.tid] = *(const LAS v4u*)(VTs + (i * 512 + F.tid) * 16); }
        float bc[32]; float run = 0.f;
#pragma unroll
        for (int i = 0; i < 32; ++i) { const LAS f32x4* lr4 = (const LAS f32x4*)(LRs + (half * 32 + i) * 16); float a = bias;
#pragma unroll
            for (int j4 = 0; j4 < 4; ++j4) { const f32x4 x = lr4[j4]; a += x[0] * w2[4 * j4] + x[1] * w2[4 * j4 + 1] + x[2] * w2[4 * j4 + 2] + x[3] * w2[4 * j4 + 3]; }
            run += logsig16(a); bc[i] = run; }
        TOT[half * 256 + k] = run;
        __syncthreads();
        const float lo_tot = TOT[k], blast = lo_tot + TOT[256 + k], boff = half ? lo_tot : 0.f;
        if (half == 0) ((float*)(wsp() + WS_GM))[(size_t)item * 256 + k] = fexp(blast);
        const int pos = qt_pos(k), pp = pos >> 3, pe = (pos & 7) * 2;
        unsigned char* kdg = wsp() + WS_KD + (size_t)item * KD_B;
#pragma unroll
        for (int g = 0; g < 4; ++g) { unsigned kdw[4];
#pragma unroll
            for (int e = 0; e < 8; ++e) { const int i = g * 8 + e, t = half * 32 + i; const float bt = bc[i] + boff;
                const float qf = bf1(*(const LAS unsigned short*)(Qraw + t * 512 + k * 2)) * 0.0625f * fexp(bt), kf = bf1(*(const LAS unsigned short*)(Kraw + t * 512 + k * 2));
                const float kh = kf * fexp(-bt), kd = kf * fexp(blast - bt);
                *(LAS unsigned short*)(Qs + qt_off(t, pp) + pe) = bf1r(qf); *(LAS unsigned short*)(Ks + qt_off(t, pp) + pe) = bf1r(kh);
                if (e & 1) kdw[e >> 1] = (kdw[e >> 1] & 0xffffu) | ((unsigned)bf1r(kd) << 16); else kdw[e >> 1] = bf1r(kd); }
            v4u w; w.x = kdw[0]; w.y = kdw[1]; w.z = kdw[2]; w.w = kdw[3];
            *(GAS v4u*)(kdg + r8_off(k, half * 4 + g)) = w; }
        __syncthreads();
        { GAS v4u* dq = (GAS v4u*)(wsp() + WS_QT + (size_t)item * QT_B);
#pragma unroll
          for (int i = 0; i < 4; ++i) dq[i * 512 + F.tid] = *(const LAS v4u*)(Qs + (i * 512 + F.tid) * 16); }
        { const int r16 = F.lane & 15, quad = F.lane >> 4;
#pragma unroll
          for (int u = 0; u < 2; ++u) { const int id = F.wave * 2 + u, si = id >> 2, ti = id & 3;
              f32x4 acc = {0.f, 0.f, 0.f, 0.f};
              if (ti >= si) {
#pragma unroll
                  for (int ks = 0; ks < 8; ++ks) { const bf16x8 ka = *(const LAS bf16x8*)(Ks + qt_off(16 * si + r16, 4 * ks + quad)), qb = *(const LAS bf16x8*)(Qs + qt_off(16 * ti + r16, 4 * ks + quad));
                      acc = __builtin_amdgcn_mfma_f32_16x16x32_bf16(ka, qb, acc, 0, 0, 0); } }
              const int t = 16 * ti + r16, s0 = 16 * si + 4 * quad;
              v2u w; w.x = pkbf(s0 + 0 <= t ? acc[0] : 0.f, s0 + 1 <= t ? acc[1] : 0.f); w.y = pkbf(s0 + 2 <= t ? acc[2] : 0.f, s0 + 3 <= t ? acc[3] : 0.f);
              *(GAS v2u*)(wsp() + WS_AI + (size_t)item * AI_B + r8_off(t, 2 * si + (quad >> 1)) + (quad & 1) * 8) = w; } }
        __syncthreads();
    }
}
__device__ __forceinline__ void scan_stage(unsigned char* ws, LAS unsigned char* lds, int item, int c, int lw, int lane) {
    LAS unsigned char* buf = lds + (c & 1) * SCAN_BUF;
    const unsigned char* gq = ws + WS_QT + (size_t)item * QT_B; const unsigned char* gk = ws + WS_KD + (size_t)item * KD_B;
    const unsigned char* ga = ws + WS_AI + (size_t)item * AI_B; const unsigned char* gg = ws + WS_GM + (size_t)item * GM_B;
#pragma unroll
    for (int i = 0; i < 8; ++i) { const int wp = lw + 4 * i;
        __builtin_amdgcn_global_load_lds((const unsigned*)(gq + wp * 1024 + lane * 16), (LAS unsigned*)(buf + wp * 1024), 16, 0, 0);
        __builtin_amdgcn_global_load_lds((const unsigned*)(gk + wp * 1024 + lane * 16), (LAS unsigned*)(buf + QT_B + wp * 1024), 16, 0, 0); }
#pragma unroll
    for (int i = 0; i < 2; ++i) { const int wp = lw + 4 * i;
        __builtin_amdgcn_global_load_lds((const unsigned*)(ga + wp * 1024 + lane * 16), (LAS unsigned*)(buf + QT_B + KD_B + wp * 1024), 16, 0, 0); }
    if (lw == 0) __builtin_amdgcn_global_load_lds((const unsigned*)(gg + lane * 16), (LAS unsigned*)(buf + QT_B + KD_B + AI_B), 16, 0, 0);
}
__device__ __forceinline__ void p_gla_scan(Frame& F0, int l) {
    Frame F = F0; asm volatile("" : "+v"(F.tid), "+v"(F.lane));
    if (F.vcu >= 128) return;
    const int b = F.vcu >> 5, h = (F.vcu >> 3) & 3, vq = F.vcu & 7;
    bf16* ZBp = (bf16*)(wsp() + WS_ZB); const bf16* Pp = (const bf16*)(wsp() + WS_P); unsigned long long* RSO = (unsigned long long*)(wsp() + WS_RSO) + (size_t)l * M * 4;
    const int r16 = F.lane & 15, quad = F.lane >> 4, w = F.wave;
    const int vcol0 = vq * 64 + (w & 3) * 16;
    f32x4 S[16];
#pragma unroll
    for (int i = 0; i < 16; ++i) S[i] = (f32x4){0.f, 0.f, 0.f, 0.f};
    if (w >= 4) {
        scan_stage(wsp(), F.lds, (b * 32 + 0) * 4 + h, 0, w - 4, F.lane);
#pragma unroll 1
        for (int c = 0; c < 32; ++c) {
            asm volatile("s_waitcnt vmcnt(0)" ::: "memory");
            asm volatile("" ::: "memory"); __builtin_amdgcn_s_barrier(); asm volatile("" ::: "memory");
            if (c + 1 < 32) scan_stage(wsp(), F.lds, (b * 32 + c + 1) * 4 + h, c + 1, w - 4, F.lane);
        }
        asm volatile("s_waitcnt vmcnt(0)" ::: "memory");
        __syncthreads();
        return;
    }
    bf16x8 vf[2], vn[2];
    { const unsigned char* gv = wsp() + WS_VT + (size_t)((b * 32 + 0) * 4 + h) * VT_B + (vcol0 + r16) * 128 + quad * 16; vf[0] = *(const GAS bf16x8*)gv; vf[1] = *(const GAS bf16x8*)(gv + 64); }
    v4u gq[2], gqn[2];
    { const int r0 = b * 2048;
#pragma unroll
      for (int m = 0; m < 2; ++m) gq[m] = *(const GAS v4u*)(Pp + (size_t)(r0 + 16 * (2 * m + (quad & 1)) + r16) * PW + C_GG + h * 512 + vcol0 + 4 * (quad & 2)); }
    __builtin_amdgcn_s_setprio(3);
    auto chunk = [&](const int c, bf16x8 (&vcur)[2], bf16x8 (&vnxt)[2], v4u (&gcur)[2], v4u (&gnxt)[2]) __attribute__((always_inline)) {
        asm volatile("" ::: "memory"); __builtin_amdgcn_s_barrier(); asm volatile("" ::: "memory");
        const LAS unsigned char* buf = F.lds + (c & 1) * SCAN_BUF;
        const LAS unsigned char* Qb = buf; const LAS unsigned char* Kb = buf + QT_B; const LAS unsigned char* Ab = buf + QT_B + KD_B; const LAS unsigned char* Gb = buf + QT_B + KD_B + AI_B;
        f32x4 acc[4];
#pragma unroll
        for (int ti = 0; ti < 4; ++ti) acc[ti] = (f32x4){0.f, 0.f, 0.f, 0.f};
        bf16x8 rb[3][4];
#define SCAN_LDG(g, d) { _Pragma("unroll") for (int ti = 0; ti < 4; ++ti) d[ti] = (g) < 8 ? *(const LAS bf16x8*)(Qb + qt_off(16 * ti + r16, 4 * (g) + quad)) : *(const LAS bf16x8*)(Ab + r8_off(16 * ti + r16, 4 * ((g) - 8) + quad)); }
        SCAN_LDG(0, rb[0]) SCAN_LDG(1, rb[1])
#pragma unroll
        for (int g = 0; g < 10; ++g) {
            if (g + 2 < 10) SCAN_LDG(g + 2, rb[(g + 2) % 3])
            bf16x8 sa;
            if (g < 8) { v4u sp; sp.x = pkbf(S[2 * g][0], S[2 * g][1]); sp.y = pkbf(S[2 * g][2], S[2 * g][3]); sp.z = pkbf(S[2 * g + 1][0], S[2 * g + 1][1]); sp.w = pkbf(S[2 * g + 1][2], S[2 * g + 1][3]); sa = __builtin_bit_cast(bf16x8, sp); }
            else sa = vcur[g - 8];
            __builtin_amdgcn_sched_barrier(0);
#pragma unroll
            for (int ti = 0; ti < 4; ++ti) acc[ti] = __builtin_amdgcn_mfma_f32_16x16x32_bf16(sa, rb[g % 3][ti], acc[ti], 0, 0, 0);
            __builtin_amdgcn_sched_barrier(0);
        }
#undef SCAN_LDG
        { const int cn = c + 1 < 32 ? c + 1 : c, r0 = b * 2048 + cn * 64;
#pragma unroll
          for (int m = 0; m < 2; ++m) gnxt[m] = *(const GAS v4u*)(Pp + (size_t)(r0 + 16 * (2 * m + (quad & 1)) + r16) * PW + C_GG + h * 512 + vcol0 + 4 * (quad & 2));
          const unsigned char* gv = wsp() + WS_VT + (size_t)((b * 32 + cn) * 4 + h) * VT_B + (vcol0 + r16) * 128 + quad * 16; vnxt[0] = *(const GAS bf16x8*)gv; vnxt[1] = *(const GAS bf16x8*)(gv + 64); }
        f32x4 gb[2][2]; bf16x8 kb[2][2][2];
#define SCAN_LD3(p, s) { _Pragma("unroll") for (int e = 0; e < 2; ++e) { gb[s][e] = *(const LAS f32x4*)(Gb + (16 * (2 * (p) + e) + 4 * quad) * 4); \
            _Pragma("unroll") for (int ks = 0; ks < 2; ++ks) kb[s][e][ks] = *(const LAS bf16x8*)(Kb + r8_off(16 * (2 * (p) + e) + r16, 4 * ks + quad)); } }
        SCAN_LD3(0, 0)
        __builtin_amdgcn_sched_barrier(0);
        { const int r0 = b * 2048 + c * 64;
          const bool odd = quad & 1; float ss[4]; v2u wv[4];
#pragma unroll
          for (int m = 0; m < 2; ++m) { const v4u ld = gcur[m]; v2u own, snd, rcv;
              own.x = odd ? ld.z : ld.x; own.y = odd ? ld.w : ld.y; snd.x = odd ? ld.x : ld.z; snd.y = odd ? ld.y : ld.w;
              rcv.x = (unsigned)__shfl_xor((int)snd.x, 16); rcv.y = (unsigned)__shfl_xor((int)snd.y, 16);
              const v2u ga = odd ? rcv : own, gb2 = odd ? own : rcv;
              { const f32x4 a = acc[2 * m];     wv[2 * m].x     = pkbf(a[0] * bflo(ga.x),  a[1] * bfhi(ga.x));  wv[2 * m].y     = pkbf(a[2] * bflo(ga.y),  a[3] * bfhi(ga.y));  ss[2 * m]     = (a[0] * a[0] + a[1] * a[1]) + (a[2] * a[2] + a[3] * a[3]); }
              { const f32x4 a = acc[2 * m + 1]; wv[2 * m + 1].x = pkbf(a[0] * bflo(gb2.x), a[1] * bfhi(gb2.x)); wv[2 * m + 1].y = pkbf(a[2] * bflo(gb2.y), a[3] * bfhi(gb2.y)); ss[2 * m + 1] = (a[0] * a[0] + a[1] * a[1]) + (a[2] * a[2] + a[3] * a[3]); } }
#pragma unroll
          for (int m = 0; m < 2; ++m) { const v2u mine = odd ? wv[2 * m + 1] : wv[2 * m], snd = odd ? wv[2 * m] : wv[2 * m + 1]; v2u rcv;
              rcv.x = (unsigned)__shfl_xor((int)snd.x, 16); rcv.y = (unsigned)__shfl_xor((int)snd.y, 16);
              v4u o4; o4.x = odd ? rcv.x : mine.x; o4.y = odd ? rcv.y : mine.y; o4.z = odd ? mine.x : rcv.x; o4.w = odd ? mine.y : rcv.y;
              *(GAS v4u*)(ZBp + (size_t)(r0 + 16 * (2 * m + (quad & 1)) + r16) * D + h * 512 + vcol0 + 4 * (quad & 2)) = o4; }
#pragma unroll
          for (int ti = 0; ti < 4; ++ti) ss[ti] += __shfl_xor(ss[ti], 16);
#pragma unroll
          for (int ti = 0; ti < 4; ++ti) ss[ti] += __shfl_xor(ss[ti], 32);
          { const float sq = quad == 0 ? ss[0] : quad == 1 ? ss[1] : quad == 2 ? ss[2] : ss[3];
            atomicAdd(RSO + (size_t)h * M + r0 + 16 * quad + r16, (unsigned long long)(sq * 16777216.0f)); } }
        __builtin_amdgcn_sched_barrier(0);
#pragma unroll
        for (int p = 0; p < 8; ++p) {
            if (p + 1 < 8) SCAN_LD3(p + 1, (p + 1) & 1)
            __builtin_amdgcn_sched_barrier(0);
            S[2 * p] = S[2 * p] * gb[p & 1][0]; S[2 * p + 1] = S[2 * p + 1] * gb[p & 1][1];
#pragma unroll
            for (int ks = 0; ks < 2; ++ks)
#pragma unroll
                for (int e = 0; e < 2; ++e) S[2 * p + e] = __builtin_amdgcn_mfma_f32_16x16x32_bf16(kb[p & 1][e][ks], vcur[ks], S[2 * p + e], 0, 0, 0);
            __builtin_amdgcn_sched_barrier(0);
        }
#undef SCAN_LD3
    };
#pragma unroll 1
    for (int c2 = 0; c2 < 32; c2 += 2) { chunk(c2, vf, vn, gq, gqn); chunk(c2 + 1, vn, vf, gqn, gq); }
    __builtin_amdgcn_s_setprio(0);
    { float* dst = outp() + O_GLAP + ((size_t)((l * 4 + b) * 4 + h) * 256) * 512 + vcol0 + r16;
#pragma unroll
        for (int i = 0; i < 16; ++i)
#pragma unroll
            for (int j = 0; j < 4; ++j) dst[(size_t)(16 * i + 4 * quad + j) * 512] = S[i][j]; }
    __syncthreads();
}
constexpr int CW_Q0 = 8192;
__device__ __forceinline__ void p_gla_sample(Frame& F0, int l, int rep) {
    Frame F = F0; asm volatile("" : "+v"(F.tid), "+v"(F.lane));
    const bf16* P = (const bf16*)(wsp() + WS_P); const float* LR = (const float*)(wsp() + WS_LR);
    LAS float* QK = (LAS float*)F.lds;
    LAS float* QH = (LAS float*)(F.lds + 20480);
    LAS float* KH = (LAS float*)(F.lds + 28672);
    LAS float* VS = (LAS float*)(F.lds + 36864);
    LAS float* AS = (LAS float*)(F.lds + 53248);
    LAS float* LRs = (LAS float*)(F.lds + 53504);
    LAS float* TOT = (LAS float*)(F.lds + 54016);
    LAS int* QW = (LAS int*)(F.lds + 56064);
    LAS float* OR = (LAS float*)(F.lds + 57344);
    unsigned* qhead = (unsigned*)(wsp() + WS_CTL) + CW_Q0 + 64 * (l + 4 * rep);
    const int k = F.tid & 255, half = F.tid >> 8;
    for (;;) {
        if (F.tid == 0) QW[0] = (int)__hip_atomic_fetch_add(qhead, 1u, __ATOMIC_RELAXED, __HIP_MEMORY_SCOPE_AGENT);
        __syncthreads();
        const int unit = QW[0];
        if (unit >= 1024) break;
        const int sb = unit >> 3, h = (unit >> 1) & 3, vh = unit & 1, r0 = MP + sb * 8;
        f32x4 lrv = {0.f, 0.f, 0.f, 0.f}; if (F.tid < 32) lrv = *(const GAS f32x4*)(LR + (size_t)r0 * 16 + 4 * F.tid);
        bf16 vraw[4], qraw[4], kraw[4];
#pragma unroll
        for (int i = 0; i < 4; ++i) { const int e = i * 512 + F.tid; vraw[i] = P[(size_t)(r0 + (e >> 8)) * PW + C_V + h * 512 + vh * 256 + (e & 255)];
            qraw[i] = P[(size_t)(r0 + half * 4 + i) * PW + C_Q + h * 256 + k]; kraw[i] = P[(size_t)(r0 + half * 4 + i) * PW + C_K + h * 256 + k]; }
        float w2[16]; const float bias = inp(I_BA)[l * 1024 + h * 256 + k];
        { const float* w2p = inp(I_WA2) + (size_t)l * 16 * 1024 + h * 256 + k;
#pragma unroll
          for (int j = 0; j < 16; ++j) w2[j] = w2p[j * 1024]; }
        if (F.tid < 32) *(LAS f32x4*)(LRs + 4 * F.tid) = lrv;
#pragma unroll
        for (int i = 0; i < 4; ++i) VS[i * 512 + F.tid] = bf1(vraw[i]);
        __syncthreads();
        float bc[4]; float run = 0.f;
#pragma unroll
        for (int i = 0; i < 4; ++i) { const LAS f32x4* lr4 = (const LAS f32x4*)(LRs + (half * 4 + i) * 16); float a = bias;
#pragma unroll
            for (int j4 = 0; j4 < 4; ++j4) { const f32x4 x = lr4[j4]; a += x[0] * w2[4 * j4] + x[1] * w2[4 * j4 + 1] + x[2] * w2[4 * j4 + 2] + x[3] * w2[4 * j4 + 3]; }
            run += logsig16(a); bc[i] = run; }
        TOT[half * 256 + k] = run;
        __syncthreads();
        const float lo_tot = TOT[k], blast = lo_tot + TOT[256 + k], boff = half ? lo_tot : 0.f;
        if (half == 0) QK[k * 20 + 16] = fexp(blast);
#pragma unroll
        for (int i = 0; i < 4; ++i) { const int t = half * 4 + i; const float bt = bc[i] + boff;
            const float qv = bf1(qraw[i]) * 0.0625f * fexp(bt), kv = bf1(kraw[i]);
            QK[k * 20 + t] = qv; QK[k * 20 + 8 + t] = kv * fexp(blast - bt); QH[t * 256 + k] = qv; KH[t * 256 + k] = kv * fexp(-bt); }
        __syncthreads();
        { const int e = F.tid >> 3, part = F.tid & 7, t = e >> 3, sq = e & 7; float a = 0.f;
#pragma unroll
          for (int i = 0; i < 32; ++i) a += QH[t * 256 + part * 32 + i] * KH[sq * 256 + part * 32 + i];
          a += __shfl_xor(a, 1); a += __shfl_xor(a, 2); a += __shfl_xor(a, 4);
          if (part == 0) AS[e] = (sq <= t) ? a : 0.f; }
        const int vq4 = F.tid & 63, kr = F.tid >> 6;
        f32x4 vv[8], oa[8];
#pragma unroll
        for (int t = 0; t < 8; ++t) { vv[t] = *(const LAS f32x4*)(VS + t * 256 + 4 * vq4); oa[t] = (f32x4){0.f, 0.f, 0.f, 0.f}; }
        const float* s0p = inp(I_SGLA) + ((size_t)((l * 128 + sb) * 4 + h) * 256 + kr) * 512 + vh * 256 + 4 * vq4;
        float* s1p = outp() + O_GLAS + ((size_t)((l * 128 + sb) * 4 + h) * 256 + kr) * 512 + vh * 256 + 4 * vq4;
        f32x4 cur[8], nxt[8];
#pragma unroll
        for (int u = 0; u < 8; ++u) cur[u] = __builtin_nontemporal_load((const f32x4*)(s0p + (size_t)(8 * u) * 512));
        for (int g = 0; g < 4; ++g) {
            if (g < 3) {
#pragma unroll
                for (int u = 0; u < 8; ++u) nxt[u] = __builtin_nontemporal_load((const f32x4*)(s0p + (size_t)(8 * (8 * (g + 1) + u)) * 512)); }
#pragma unroll
            for (int u = 0; u < 8; ++u) { const int kk = 8 * (8 * g + u) + kr; const f32x4 s0 = cur[u];
                const LAS f32x4* q4 = (const LAS f32x4*)(QK + kk * 20); const f32x4 qa = q4[0], qb = q4[1], ka = q4[2], kb = q4[3]; const float gm = QK[kk * 20 + 16];
                f32x4 sn = s0 * gm;
#pragma unroll
                for (int t = 0; t < 4; ++t) { oa[t] += s0 * qa[t]; oa[4 + t] += s0 * qb[t]; sn += vv[t] * ka[t]; sn += vv[4 + t] * kb[t]; }
                __builtin_nontemporal_store(sn, (f32x4*)(s1p + (size_t)(8 * (8 * g + u)) * 512)); }
#pragma unroll
            for (int u = 0; u < 8; ++u) cur[u] = nxt[u];
        }
#pragma unroll
        for (int t = 0; t < 8; ++t) *(LAS f32x4*)(OR + (kr * 8 + t) * 256 + 4 * vq4) = oa[t];
        __syncthreads();
#pragma unroll
        for (int i = 0; i < 4; ++i) { const int e = i * 512 + F.tid, t = e >> 8, vc = e & 255; float o = 0.f;
#pragma unroll
            for (int q = 0; q < 8; ++q) o += OR[(q * 8 + t) * 256 + vc];
#pragma unroll
            for (int sq = 0; sq < 8; ++sq) o += AS[t * 8 + sq] * VS[sq * 256 + vc];
            const float sg = bf1(P[(size_t)(r0 + t) * PW + C_GG + h * 512 + vh * 256 + vc]);
            ((bf16*)(wsp() + WS_ZB))[(size_t)(r0 + t) * D + h * 512 + vh * 256 + vc] = bf1r(o * sg);
            const float ss = wave_sum(o * o);
            if (F.lane == 0) atomicAdd((unsigned long long*)(wsp() + WS_RSO) + ((size_t)l * 4 + h) * M + r0 + t, (unsigned long long)(ss * 16777216.0f)); }
        __syncthreads();
    }
}
constexpr size_t WS_FIX = 1147 * MiB;
__device__ __forceinline__ void p_convfix(Frame& F0, int l) {
    Frame F = F0; asm volatile("" : "+v"(F.tid), "+v"(F.lane));
    const float* FX = (const float*)(wsp() + WS_FIX); bf16* ZA = (bf16*)(wsp() + WS_ZA); const float* cw = inp(I_CONVW) + (size_t)l * 3 * D;
    for (int it = F.vcu * 512 + F.tid; it < 128 * 2048; it += F.G * 512) { const int blk = it >> 11, ch = it & 2047;
        if ((blk & 31) == 0) continue;
        const float c0 = FX[(size_t)(blk * 2) * 2048 + ch], c1 = FX[(size_t)(blk * 2 + 1) * 2048 + ch];
        const float h0 = FX[524288 + (size_t)(blk * 2) * 2048 + ch], h1 = FX[524288 + (size_t)(blk * 2 + 1) * 2048 + ch];
        const float t0 = FX[1048576 + (size_t)((blk - 1) * 2) * 2048 + ch], t1 = FX[1048576 + (size_t)((blk - 1) * 2 + 1) * 2048 + ch];
        const float w0 = cw[ch], w1 = cw[D + ch], w2 = cw[2 * D + ch];
        ZA[(size_t)(blk * 64) * D + ch] = bf1r(c0 * (w0 * t0 + w1 * t1 + w2 * h0));
        ZA[(size_t)(blk * 64 + 1) * D + ch] = bf1r(c1 * (w0 * t1 + w1 * h0 + w2 * h1)); }
}
__device__ __forceinline__ void rt_row(LAS float* RT, const unsigned long long* RSO, int row) {
    const GAS unsigned long long* p = (const GAS unsigned long long*)(RSO + row);
    const float q0 = (float)p[0] * (1.f / 16777216.f), q1 = (float)p[M] * (1.f / 16777216.f), q2 = (float)p[2 * M] * (1.f / 16777216.f), q3 = (float)p[3 * M] * (1.f / 16777216.f);
    const float s0 = 1.f / sqrtf(q0 * (1.f / 512.f) + EPS), s1 = 1.f / sqrtf(q1 * (1.f / 512.f) + EPS), s2 = 1.f / sqrtf(q2 * (1.f / 512.f) + EPS), s3 = 1.f / sqrtf(q3 * (1.f / 512.f) + EPS);
    *(LAS f32x4*)(RT + (row & 255) * 8) = (f32x4){s0 / s1, s1 / s2, s2 / s3, s3}; *(LAS f32x4*)(RT + (row & 255) * 8 + 4) = (f32x4){1.f / s0, 0.f, 0.f, 0.f};
}
struct Args { const float* in[14]; float* out; unsigned char* ws; int ph_lo, ph_hi; };
constexpr int N_PHASES = 2 + 5 * DEPTH;
__global__ void __launch_bounds__(NWAVES * 64, 2) fwd(Args args) {
    extern __shared__ __attribute__((aligned(16))) unsigned char lds[];
    Frame F;
    F.lds = (LAS unsigned char*)lds;
    F.tid = threadIdx.x; F.lane = F.tid & 63; F.wave = __builtin_amdgcn_readfirstlane(F.tid >> 6);
    F.G = gridDim.x; { const int bx = blockIdx.x; F.vcu = (F.G % 8 == 0) ? (bx % 8) * (F.G / 8) + bx / 8 : bx; }
    volatile LAS unsigned* MISC = (volatile LAS unsigned*)(F.lds + MISC_OFF);
    for (int u = F.tid; u < (LDS_BYTES - LDSCTL_OFF) / 4; u += NWAVES * 64) ((LAS unsigned*)(F.lds + LDSCTL_OFF))[u] = 0u;
    __syncthreads();
    const int lo = args.ph_lo, hi = args.ph_hi;
    XcdBarrier bar; bar.bar = (unsigned*)(wsp() + WS_CTL) + CW_BAR; bar.x = 0; bar.st = nullptr;
    if (hi - lo > 1) bar = xcd_barrier_post((unsigned*)(wsp() + WS_CTL) + CW_BAR, MISC + 8);
#define IN(k) (lo <= (k) && (k) < hi)
#define SEAM(k) do { if (IN(k) && IN((k) + 1)) xcd_barrier(bar); } while (0)

    #ifndef NO_P0
    if (IN(0)) { for (int rep = 0; rep < REP_PRO; ++rep) p_prologue(F); p_xprep(F, 0); }
#endif
    SEAM(0);
#pragma unroll 1
    for (int l = 0; l < DEPTH; ++l) {
        const int pb = 1 + 5 * l;
#ifndef NO_PROJ
        if (IN(pb)) {
            unsigned char* const ws = wsp(); bf16* XB = (bf16*)(ws + WS_XB); bf16* P = (bf16*)(ws + WS_P); float* LR = (float*)(ws + WS_LR); const unsigned long long* RS = (const unsigned long long*)(ws + WS_RSQ) + (size_t)l * M;
            const bf16* Wt = (const bf16*)(ws + WS_WIN + l * WIN_L);
            pg8::Gemm g{XB, Wt, M, PW, D}; pg8::ProjOrder S; S.init(F.G, (int)blockIdx.x);
            pg8::EpiProj E{P, LR, RS, (bf16*)(ws + WS_ZA), (float*)(ws + WS_FIX), inp(I_CONVW) + (size_t)l * 3 * D, inp(I_SCONV) + (size_t)l * 128 * 2 * D, outp() + O_CONVP + (size_t)l * 4 * 2 * D, outp() + O_CONVS + (size_t)l * 128 * 2 * D};
            for (int rep = 0; rep < REP_PROJ; ++rep) {
            pg8::gemm_phase<pg8::EpiProj, pg8::ProjOrder, true, true>(F.lds + RING_OFF, g, S, E);
            for (int su = (int)blockIdx.x; su < 256 + M / 128; su += F.G) {
                if (su < 256) pg8::mini_gemm(F.lds + RING_OFF, XB, Wt, D, MP + (su >> 5) * 128, C_GG + (su & 31) * 64, E); else pg8::mini_gemm(F.lds + RING_OFF, XB, Wt, D, (su - 256) * 128, PW, E); }
            }
        }
#endif
        SEAM(pb);
        if (IN(pb + 1)) {
#ifndef NO_CONV
            for (int rep = 0; rep < REP_PREP; ++rep) p_convfix(F, l);
#endif
#ifndef NO_GLA
            for (int rep = 0; rep < REP_PREP; ++rep) p_gla_prep(F, l);
#endif
        } SEAM(pb + 1);
        if (IN(pb + 2)) {
#ifndef NO_GLA
            for (int rep = 0; rep < REP_SCAN; ++rep) { p_gla_scan(F, l); p_gla_sample(F, l, rep); }
#endif
        } SEAM(pb + 2);
#ifndef NO_BR
        if (IN(pb + 3)) {
            unsigned char* const ws = wsp(); bf16* P = (bf16*)(ws + WS_P); bf16* ZA = (bf16*)(ws + WS_ZA); bf16* ZB = (bf16*)(ws + WS_ZB); bf16* MG = (bf16*)(ws + WS_MG);
            const bf16* WtA = (const bf16*)(ws + WS_WA + l * W_L); const bf16* WtB = (const bf16*)(ws + WS_WB + l * W_L);
            LAS float* RT = (LAS float*)(F.lds + RT_OFF); const unsigned long long* RSO = (const unsigned long long*)(ws + WS_RSO) + (size_t)l * M * 4;
            pg8::StaticOrder S; S.init(MP, D, F.G, (int)blockIdx.x);
            pg8::EpiBrA2 EA{P + C_GA, P + C_GB, RT}; pg8::EpiBrB2 EB{P + C_GB, MG, RT};
            { pg8::Unit u0; if (S.next(0, u0) && F.tid < 256) rt_row(RT, RSO, u0.pm * 256 + F.tid); __syncthreads(); }
            { pg8::Gemm g{ZA, WtA, MP, D, D, ZB, WtB}; pg8::PairOrder S2; S2.init(MP, D, F.G, (int)blockIdx.x); pg8::EpiBr EE{EA, EB};
              pg8::gemm_phase<pg8::EpiBr, pg8::PairOrder, true, true>(F.lds + RING_OFF, g, S2, EE); }
            for (int su = (int)blockIdx.x; su < 256; su += F.G) { __syncthreads(); if (F.tid < 128) rt_row(RT, RSO, MP + (su >> 5) * 128 + F.tid); __syncthreads();
                f32x4 a2[2][2];
                pg8::mini_gemm_acc<pg8::EpiBrA2, true>(F.lds + RING_OFF, ZA, WtA, D, MP + (su >> 5) * 128, (su & 31) * 64, EA, a2);
                pg8::mini_gemm_acc<pg8::EpiBrB2, false>(F.lds + RING_OFF, ZB, WtB, D, MP + (su >> 5) * 128, (su & 31) * 64, EB, a2); }
        }
#endif
        SEAM(pb + 3);
#ifndef NO_OUT
        if (IN(pb + 4)) {
            unsigned char* const ws = wsp(); bf16* MG = (bf16*)(ws + WS_MG);
            const bf16* Wt = (const bf16*)(ws + WS_WO + l * W_L); pg8::Gemm g{MG, Wt, MP, D, D}; pg8::StaticOrder S; S.init(MP, D, F.G, (int)blockIdx.x);
            for (int rep = 0; rep < REP_OUT; ++rep) {
            LAS unsigned long long* rowsum = (LAS unsigned long long*)(F.lds + ROWSUM_OFF); unsigned long long* RSQn = (unsigned long long*)(ws + WS_RSQ) + (size_t)(rep > 0 ? DEPTH + 1 : l + 1) * M;
            if (F.tid < 256) rowsum[F.tid] = 0ull;
            __syncthreads();
            pg8::EpiOut E{(bf16*)(ws + (rep > 0 ? WS_ZA : WS_XB)), rowsum};
            pg8::gemm_phase<pg8::EpiOut, pg8::StaticOrder, true, true>(F.lds + RING_OFF, g, S, E);
            { pg8::Unit u0; const bool has = S.next(0, u0); asm volatile("s_waitcnt lgkmcnt(0)" ::: "memory"); __syncthreads();
              if (has && F.tid < 256) { atomicAdd(RSQn + u0.pm * 256 + F.tid, rowsum[F.tid]); rowsum[F.tid] = 0ull; } __syncthreads(); }
            for (int su = (int)blockIdx.x; su < 256; su += F.G) { pg8::mini_gemm(F.lds + RING_OFF, MG, Wt, D, MP + (su >> 5) * 128, (su & 31) * 64, E);
                asm volatile("s_waitcnt lgkmcnt(0)" ::: "memory"); __syncthreads();
                if (F.tid < 128) { const int row = MP + (su >> 5) * 128 + F.tid; atomicAdd(RSQn + row, rowsum[row & 255]); rowsum[row & 255] = 0ull; } __syncthreads(); }
            }
        }
#endif
        SEAM(pb + 4);
    }
    if (IN(1 + 5 * DEPTH)) p_final(F);
#undef IN
#undef SEAM
}

#ifndef MK_SINGLE
#define MK_SINGLE 1
#endif
extern "C" void kernel_launch(void* const* d_in, const int* in_sizes, int n_in, void* d_out, int out_size, void* d_ws, size_t ws_size, hipStream_t stream) {
    static int grid = 0;
    if (grid == 0) {
        if (n_in != 14 || (size_t)out_size != O_END || ws_size < WS_FIX + 6 * MiB) { fprintf(stderr, "kernel_launch: unexpected shapes (n_in %d out %d ws %zu)\n", n_in, out_size, ws_size); grid = -1; return; }
        int dev = 0, cus = 0, per_cu = 0;
        if (hipGetDevice(&dev) != hipSuccess || hipDeviceGetAttribute(&cus, hipDeviceAttributeMultiprocessorCount, dev) != hipSuccess) { grid = -1; return; }
        if (hipFuncSetAttribute((const void*)fwd, hipFuncAttributeMaxDynamicSharedMemorySize, LDS_BYTES) != hipSuccess) { fprintf(stderr, "kernel_launch: hipFuncSetAttribute failed\n"); grid = -1; return; }
        if (hipOccupancyMaxActiveBlocksPerMultiprocessor(&per_cu, (const void*)fwd, NWAVES * 64, LDS_BYTES) != hipSuccess || per_cu < 1) fprintf(stderr, "kernel_launch: occupancy query reports %d\n", per_cu);
        (void)hipGetLastError();
        grid = cus;
    }
    if (grid < 0) return;
    if (hipMemsetAsync((char*)d_ws + WS_CTL, 0, CTL_ZERO_BYTES, stream) != hipSuccess) return;
    Args a{};
    for (int i = 0; i < 14; ++i) a.in[i] = (const float*)d_in[i];
    a.out = (float*)d_out; a.ws = (unsigned char*)d_ws;
#if MK_SINGLE
    a.ph_lo = 0; a.ph_hi = N_PHASES;
    hipLaunchKernelGGL(fwd, dim3(grid), dim3(NWAVES * 64), LDS_BYTES, stream, a);
#else
    for (int p = 0; p < N_PHASES; ++p) { a.ph_lo = p; a.ph_hi = p + 1; hipLaunchKernelGGL(fwd, dim3(grid), dim3(NWAVES * 64), LDS_BYTES, stream, a); }
#endif
}
```

```cpp
#include <hip/hip_runtime.h>
#include <cstdio>
#include <cstdint>
#define REP_PROJ 1
#define REP_PREP 1
#define REP_SCAN 1
#define REP_ZB 1
#define REP_BR 1
#define REP_XN 1
#define REP_PRO 1
#define REP_MINI 1
#define REP_OUT 1
namespace pg8 {
#define PG8_LAS __attribute__((address_space(3)))
typedef unsigned short bf16_t;
typedef short bf16x8 __attribute__((ext_vector_type(8)));
typedef float f32x4 __attribute__((ext_vector_type(4)));
typedef unsigned u32x4 __attribute__((ext_vector_type(4)));
constexpr int BM = 256, BK = 64, HALF = 128, HTB = HALF * BK * 2  , STAGE_BYTES = 8 * HTB, NXCD = 8, WGM = 8;

__host__ __device__ __forceinline__ int lds_byte(int r, int c) { const int st = (r >> 4) * 2 + (c >> 5), rr = r & 15, cc = c & 31, ob = rr * 64 + cc * 2; return st * 1024 + (ob ^ (((ob >> 9) & 1) << 5)); }
__host__ __device__ __forceinline__ void stage_rc(int b, int& R, int& C) { const int st = b / 1024, sb = b % 1024, swz = sb ^ (((sb >> 9) & 1) << 5); R = (st >> 1) * 16 + swz / 64; C = (st & 1) * 32 + (swz % 64) / 2; }
__host__ __device__ __forceinline__ int perm32(int rho) { const int n = rho >> 4, i = rho & 15; return 8 * (i >> 2) + 4 * n + (i & 3); }

struct Unit { int pm, pn, sel; };
struct Gemm { const bf16_t* A; const bf16_t* Bt; int M, N, K; const bf16_t* A2; const bf16_t* Bt2; };

struct StaticOrder {
    int nM, nN, nwg, G, c;
    __host__ __device__ void init(int M, int N, int G_, int c_) { nM = M / BM; nN = N / BM; nwg = nM * nN; G = G_; c = c_; }
    __host__ __device__ bool next(int i, Unit& u) const {
        const long L = (long)i * G + c; if (L >= nwg) return false;
        int wgid = (int)L; { const int q = nwg / NXCD, r = nwg % NXCD, xcd = wgid % NXCD, off = wgid / NXCD; wgid = (xcd < r ? xcd * (q + 1) : r * (q + 1) + (xcd - r) * q) + off; }
        const int nig = WGM * nN, gid = wgid / nig, fm = gid * WGM, gsz = (nM - fm) < WGM ? (nM - fm) : WGM;
        u.pm = fm + ((wgid % nig) % gsz); u.pn = (wgid % nig) / gsz; u.sel = 0; return true;
    }
    __device__ __forceinline__ void a_ready(const Unit&) const {}
    __device__ __forceinline__ void done(const Unit&) const {}
};
__device__ __forceinline__ unsigned cvt_pk_bf16(float lo, float hi) { unsigned r; asm volatile("v_cvt_pk_bf16_f32 %0, %1, %2" : "=v"(r) : "v"(lo), "v"(hi)); return r; }
constexpr int PW = 18432;
__device__ __forceinline__ float sigm(float x) { return __builtin_amdgcn_rcpf(1.0f + __builtin_amdgcn_exp2f(-1.44269504f * x)); }
__device__ __forceinline__ float bflo(unsigned w) { return __uint_as_float(w << 16); }
__device__ __forceinline__ float bfhi(unsigned w) { return __uint_as_float(w & 0xffff0000u); }
__device__ __forceinline__ u32x4 pack8(const f32x4 v0, const f32x4 v1) { u32x4 w; w.x = cvt_pk_bf16(v0[0], v0[1]); w.y = cvt_pk_bf16(v0[2], v0[3]); w.z = cvt_pk_bf16(v1[0], v1[1]); w.w = cvt_pk_bf16(v1[2], v1[3]); return w; }
struct EpiProj {
    static constexpr int DEPTH = 16; static constexpr bool MIDK = false, CONV = true, INPLACE = false, PAIR = false;
    bf16_t* P; float* LR; const unsigned long long* rsq;
    bf16_t* ZA; float* FIX; const float* convw; const float* sconv; float* ocp; float* ocs;
    static __device__ __forceinline__ f32x4 ror(const f32x4 x, int n) { f32x4 y;
#pragma unroll
        for (int j = 0; j < 4; ++j) y[j] = __int_as_float(n == 1 ? __builtin_amdgcn_update_dpp(0, __float_as_int(x[j]), 0x121, 0xf, 0xf, false) : __builtin_amdgcn_update_dpp(0, __float_as_int(x[j]), 0x122, 0xf, 0xf, false)); return y; }
    __device__ __forceinline__ void conv_unit(const f32x4 (&acc)[2][2][4][2], const Unit& u, int wr, int wc, int fr, int fq) const {
        const int ch0 = 64 * (u.pn - 16) + 16 * wc + 4 * fq; const bool sample = u.pm >= 32;
        const f32x4 w0 = *(const f32x4*)(convw + ch0), w1 = *(const f32x4*)(convw + 2048 + ch0), w2 = *(const f32x4*)(convw + 4096 + ch0);
        unsigned long long rq[2][4];
#pragma unroll
        for (int ai = 0; ai < 2; ++ai)
#pragma unroll
            for (int m = 0; m < 4; ++m) rq[ai][m] = rsq[u.pm * BM + ai * HALF + wr * 64 + m * 16 + fr];
#pragma unroll
        for (int ai = 0; ai < 2; ++ai) { const int br0 = u.pm * BM + ai * HALF + wr * 64, blk = br0 >> 6; const bool seqstart = (br0 & 2047) == 0, seqend = ((br0 + 64) & 2047) == 0;
            f32x4 uprev = {0.f, 0.f, 0.f, 0.f};
#pragma unroll
            for (int m = 0; m < 4; ++m) { const int r = br0 + m * 16 + fr;
                const float rstd = __builtin_amdgcn_rsqf((float)rq[ai][m] * (1.0f / 16777216.0f) * (1.0f / 2048.0f) + 1e-6f);
                const f32x4 cB = acc[ai][0][m][0] * rstd, cC = acc[ai][0][m][1] * rstd, cx = acc[ai][1][m][0] * rstd; f32x4 cg = acc[ai][1][m][1] * rstd;
#pragma unroll
                for (int j = 0; j < 4; ++j) cg[j] = cg[j] * sigm(cg[j]);
                const f32x4 uu = cC * cx, cbg = cB * cg, t1 = ror(uu, 1), t2 = ror(uu, 2);
                f32x4 u1, u2;
                if (!sample) { const f32x4 p1 = ror(uprev, 1), p2 = ror(uprev, 2);
#pragma unroll
                    for (int j = 0; j < 4; ++j) { u1[j] = fr >= 1 ? t1[j] : p1[j]; u2[j] = fr >= 2 ? t2[j] : p2[j]; }
                } else { const int t = fr & 7, sb = (r - 8192) >> 3; const f32x4 b0 = *(const f32x4*)(sconv + (size_t)sb * 4096 + ch0), b1 = *(const f32x4*)(sconv + (size_t)sb * 4096 + 2048 + ch0);
#pragma unroll
                    for (int j = 0; j < 4; ++j) { u1[j] = t >= 1 ? t1[j] : b1[j]; u2[j] = t >= 2 ? t2[j] : (t == 1 ? b1[j] : b0[j]); }
                    if (t >= 6) *(f32x4*)(ocs + (size_t)sb * 4096 + (t - 6) * 2048 + ch0) = uu; }
                const f32x4 z = cbg * (w0 * u2 + w1 * u1 + w2 * uu);
                if (!sample && m == 0 && fr < 2 && !seqstart) {
                    *(f32x4*)(FIX + ((size_t)(blk * 2 + fr)) * 2048 + ch0) = cbg; *(f32x4*)(FIX + (size_t)524288 + ((size_t)(blk * 2 + fr)) * 2048 + ch0) = uu;
                } else { typedef unsigned u32x2 __attribute__((ext_vector_type(2))); u32x2 w; w.x = cvt_pk_bf16(z[0], z[1]); w.y = cvt_pk_bf16(z[2], z[3]); *(u32x2*)(ZA + (size_t)r * 2048 + ch0) = w; }
                if (!sample && m == 3 && fr >= 14) { *(f32x4*)(FIX + (size_t)1048576 + ((size_t)(blk * 2 + fr - 14)) * 2048 + ch0) = uu;
                    if (seqend) *(f32x4*)(ocp + ((size_t)(br0 >> 11) * 2 + (fr - 14)) * 2048 + ch0) = uu; }
                uprev = uu; } }
    }
    struct Pre { float rs; };
    __device__ __forceinline__ Pre pre(int r, int) const { Pre p; p.rs = (float)rsq[r] * (1.0f / 16777216.0f); return p; }
    __device__ __forceinline__ void fin(int r, int c, f32x4 v0, f32x4 v1, const Pre& p) const {
        const int t = c >> 8; const float rstd = __builtin_amdgcn_rsqf(p.rs * (1.0f / 2048.0f) + 1e-6f); v0 = v0 * rstd; v1 = v1 * rstd;
        if (t >= 72) { const int cc = c - 72 * 256; if (cc < 16) { *(f32x4*)(LR + (size_t)r * 16 + cc) = v0; *(f32x4*)(LR + (size_t)r * 16 + cc + 4) = v1; } return; }
        const int mode = (t < 16) ? 1 : (((t >= 40 && t < 48) || t >= 64) ? 2 : 0);
        if (mode == 1) {
#pragma unroll
            for (int j = 0; j < 4; ++j) { v0[j] = sigm(v0[j]); v1[j] = sigm(v1[j]); } }
        if (mode == 2) {
#pragma unroll
            for (int j = 0; j < 4; ++j) { v0[j] = v0[j] * sigm(v0[j]); v1[j] = v1[j] * sigm(v1[j]); } }
        *(u32x4*)(P + (size_t)r * PW + c) = pack8(v0, v1);
    }
};
struct EpiBrA2 {
    static constexpr int DEPTH = 4; static constexpr bool MIDK = false, CONV = false, INPLACE = true, PAIR = false;
    const bf16_t* GA; const bf16_t* GB; const PG8_LAS float* RT;
    struct Pre { u32x4 a, b; };
    __device__ __forceinline__ Pre pre(int r, int c) const { Pre p; p.a = *(const u32x4*)(GA + (size_t)r * PW + c); p.b = *(const u32x4*)(GB + (size_t)r * PW + c); return p; }
    static __device__ __forceinline__ float fac(float ga, float gb, float i0) { return ga * __builtin_amdgcn_rcpf(fmaxf(gb, 1e-30f)) * i0; }
    __device__ __forceinline__ void fin_ip(int r, int, f32x4& v0, f32x4& v1, const Pre& p) const {
        const float i0 = RT[(r & 255) * 8 + 4];
        v0[0] *= fac(bflo(p.a.x), bflo(p.b.x), i0); v0[1] *= fac(bfhi(p.a.x), bfhi(p.b.x), i0); v0[2] *= fac(bflo(p.a.y), bflo(p.b.y), i0); v0[3] *= fac(bfhi(p.a.y), bfhi(p.b.y), i0);
        v1[0] *= fac(bflo(p.a.z), bflo(p.b.z), i0); v1[1] *= fac(bfhi(p.a.z), bfhi(p.b.z), i0); v1[2] *= fac(bflo(p.a.w), bflo(p.b.w), i0); v1[3] *= fac(bfhi(p.a.w), bfhi(p.b.w), i0);
    }
};
struct EpiBrB2 {
    static constexpr int DEPTH = 8; static constexpr bool MIDK = true, CONV = false, INPLACE = false, PAIR = false;
    const bf16_t* GB; bf16_t* MG; const PG8_LAS float* RT;
    struct Pre { u32x4 g; };
    __device__ __forceinline__ Pre pre(int r, int c) const { Pre p; p.g = *(const u32x4*)(GB + (size_t)r * PW + c); return p; }
    __device__ __forceinline__ void fin(int r, int c, f32x4 v0, f32x4 v1, const Pre& p) const {
        const float s3 = RT[(r & 255) * 8 + 3];
        v0[0] *= s3 * fmaxf(bflo(p.g.x), 1e-30f); v0[1] *= s3 * fmaxf(bfhi(p.g.x), 1e-30f); v0[2] *= s3 * fmaxf(bflo(p.g.y), 1e-30f); v0[3] *= s3 * fmaxf(bfhi(p.g.y), 1e-30f);
        v1[0] *= s3 * fmaxf(bflo(p.g.z), 1e-30f); v1[1] *= s3 * fmaxf(bfhi(p.g.z), 1e-30f); v1[2] *= s3 * fmaxf(bflo(p.g.w), 1e-30f); v1[3] *= s3 * fmaxf(bfhi(p.g.w), 1e-30f);
        *(u32x4*)(MG + (size_t)r * 2048 + c) = pack8(v0, v1);
    }
    __device__ __forceinline__ float ratio(int r, int seg) const { return RT[(r & 255) * 8 + seg]; }
};
struct EpiBr {
    static constexpr int DEPTH = 8; static constexpr bool MIDK = true, CONV = false, INPLACE = false, PAIR = true;
    EpiBrA2 a; EpiBrB2 b;
    __device__ __forceinline__ float ratio(int r, int seg) const { return b.ratio(r, seg); }
};
struct PairOrder {
    StaticOrder so;
    __device__ void init(int M, int N, int G_, int c_) { so.init(M, N, G_, c_); }
    __device__ bool next(int i, Unit& u) const { if (!so.next(i >> 1, u)) return false; u.sel = i & 1; return true; }
    __device__ __forceinline__ void a_ready(const Unit&) const {}
    __device__ __forceinline__ void done(const Unit&) const {}
};
struct EpiOut {
    static constexpr int DEPTH = 8; static constexpr bool MIDK = false, CONV = false, INPLACE = false, PAIR = false;
    bf16_t* XB; PG8_LAS unsigned long long* rowsum;
    struct Pre { u32x4 x; };
    __device__ __forceinline__ Pre pre(int r, int c) const { Pre p; p.x = *(const u32x4*)(XB + (size_t)r * 2048 + c); return p; }
    __device__ __forceinline__ void fin(int r, int c, f32x4 v0, f32x4 v1, const Pre& p) const {
        v0[0] += bflo(p.x.x); v0[1] += bfhi(p.x.x); v0[2] += bflo(p.x.y); v0[3] += bfhi(p.x.y); v1[0] += bflo(p.x.z); v1[1] += bfhi(p.x.z); v1[2] += bflo(p.x.w); v1[3] += bfhi(p.x.w);
        *(u32x4*)(XB + (size_t)r * 2048 + c) = pack8(v0, v1);
        const float ss = (v0[0] * v0[0] + v0[1] * v0[1]) + (v0[2] * v0[2] + v0[3] * v0[3]) + (v1[0] * v1[0] + v1[1] * v1[1]) + (v1[2] * v1[2] + v1[3] * v1[3]);
        (void)__hip_atomic_fetch_add(rowsum + (r & 255), (unsigned long long)(ss * 16777216.0f), __ATOMIC_RELAXED, __HIP_MEMORY_SCOPE_WORKGROUP);
    }
};
template <class Epi> __device__ __forceinline__ void epi_big(const Epi& E, f32x4 (&acc)[2][2][4][2], const Unit& u, int wr, int wc, int fr, int fq) {
    if constexpr (Epi::PAIR) { if (u.sel == 0) epi_big(E.a, acc, u, wr, wc, fr, fq); else epi_big(E.b, acc, u, wr, wc, fr, fq); return; } else {
    if constexpr (Epi::CONV) { if (u.pn >= 16 && u.pn < 48) { E.conv_unit(acc, u, wr, wc, fr, fq); return; } }
    const int row0 = u.pm * BM + wr * 64 + fr, col0 = u.pn * BM + wc * 32 + 8 * fq;
    constexpr int DP = Epi::DEPTH;
    typename Epi::Pre pq[DP];
#define EPI_R(i) (row0 + ((i) >> 3) * HALF + (((i) >> 1) & 3) * 16)
#define EPI_C(i) (col0 + ((i) & 1) * HALF)
#pragma unroll
    for (int i = 0; i < DP; ++i) pq[i] = E.pre(EPI_R(i), EPI_C(i));
#pragma unroll
    for (int idx = 0; idx < 16; ++idx) { const int ai = idx >> 3, m = (idx >> 1) & 3, bj = idx & 1;
        if constexpr (Epi::INPLACE) E.fin_ip(EPI_R(idx), EPI_C(idx), acc[ai][bj][m][0], acc[ai][bj][m][1], pq[idx % DP]); else E.fin(EPI_R(idx), EPI_C(idx), acc[ai][bj][m][0], acc[ai][bj][m][1], pq[idx % DP]);
        asm volatile("" ::: "memory");
        if (idx + DP < 16) pq[idx % DP] = E.pre(EPI_R(idx + DP), EPI_C(idx + DP)); }
#undef EPI_R
#undef EPI_C
    }
}
#define PG8_GAS __attribute__((address_space(1)))
constexpr int MINI_SLOT = 24576;
template <class Epi, bool ZERO0> __device__ __forceinline__ void mini_gemm_acc(PG8_LAS unsigned char* lds, const bf16_t* A, const bf16_t* Bt, int K, int row0, int col0, const Epi& E, f32x4 (&acc)[2][2]) {
    int tid_ = threadIdx.x; asm volatile("" : "+v"(tid_));
    const int tid = tid_, wid = __builtin_amdgcn_readfirstlane(tid >> 6), lane = tid & 63, r16 = lane & 15, quad = lane >> 4, wrow = wid >> 1, wcol = wid & 1;
    const PG8_GAS char* src[3];
#pragma unroll
    for (int i = 0; i < 2; ++i) { const int q = 64 * (wid + 8 * i) + lane, row = q >> 3, p = (q & 7) ^ ((row >> 1) & 7); src[i] = (const PG8_GAS char*)(A + (size_t)(row0 + row) * K + 8 * p); }
    { const int q = 64 * wid + lane, row = q >> 3, p = (q & 7) ^ ((row >> 1) & 7); src[2] = (const PG8_GAS char*)(Bt + (size_t)(col0 + (row & ~31) + perm32(row & 31)) * K + 8 * p); }
    const int nkt = K / 64;
    const int dst0 = wid * 1024 + lane * 16, dst1 = (wid + 8) * 1024 + lane * 16, dst2 = (16 + wid) * 1024 + lane * 16;
    if constexpr (ZERO0) {
#pragma unroll
    for (int i = 0; i < 2; ++i)
#pragma unroll
        for (int j = 0; j < 2; ++j) acc[i][j] = (f32x4){0.f, 0.f, 0.f, 0.f};
    }
    int aoff[2], boff[2];
#pragma unroll
    for (int t = 0; t < 2; ++t) { const int ra = 32 * wrow + 16 * t + r16, rb = 32 * wcol + 16 * t + r16; aoff[t] = ra * 128; boff[t] = 16384 + rb * 128; }
    const int sw = (r16 >> 1) & 7;
    constexpr int PD = 4;
    u32x4 q[PD][3];
#pragma unroll
    for (int p = 0; p < PD; ++p)
#pragma unroll
        for (int i = 0; i < 3; ++i) q[p][i] = *(const PG8_GAS u32x4*)(src[i] + (size_t)p * 128);
#pragma unroll 1
    for (int kt0 = 0; kt0 < nkt; kt0 += PD) {
#pragma unroll
        for (int p = 0; p < PD; ++p) { const int kt = kt0 + p;
            PG8_LAS unsigned char* sl = lds + (p & 1) * MINI_SLOT;
            *(PG8_LAS u32x4*)(sl + dst0) = q[p][0]; *(PG8_LAS u32x4*)(sl + dst1) = q[p][1]; *(PG8_LAS u32x4*)(sl + dst2) = q[p][2];
            { const int kk = kt + PD < nkt ? kt + PD : nkt - 1;
#pragma unroll
              for (int i = 0; i < 3; ++i) q[p][i] = *(const PG8_GAS u32x4*)(src[i] + (size_t)kk * 128); }
            asm volatile("s_waitcnt lgkmcnt(0)" ::: "memory"); __builtin_amdgcn_s_barrier(); asm volatile("" ::: "memory");
            if constexpr (Epi::MIDK) { if (p == 0 && (kt0 == 8 || kt0 == 16 || kt0 == 24)) { const int seg = (kt0 >> 3) - 1;
#pragma unroll
                for (int mt = 0; mt < 2; ++mt) { const float rho = E.ratio(row0 + 32 * wrow + 16 * mt + r16, seg); acc[mt][0] = acc[mt][0] * rho; acc[mt][1] = acc[mt][1] * rho; } } }
#pragma unroll
            for (int ks = 0; ks < 2; ++ks) { bf16x8 af[2], bfr[2];
#pragma unroll
                for (int t = 0; t < 2; ++t) { af[t] = *(const PG8_LAS bf16x8*)(sl + aoff[t] + (((4 * ks + quad) ^ sw) << 4)); bfr[t] = *(const PG8_LAS bf16x8*)(sl + boff[t] + (((4 * ks + quad) ^ sw) << 4)); }
#pragma unroll
                for (int mt = 0; mt < 2; ++mt)
#pragma unroll
                    for (int nt = 0; nt < 2; ++nt) acc[mt][nt] = __builtin_amdgcn_mfma_f32_16x16x32_bf16(bfr[nt], af[mt], acc[mt][nt], 0, 0, 0); }
        }
    }
    asm volatile("s_waitcnt lgkmcnt(0)" ::: "memory"); __builtin_amdgcn_s_barrier(); asm volatile("" ::: "memory");
    const int r = row0 + 32 * wrow + r16, c = col0 + 32 * wcol + 8 * quad;
    typename Epi::Pre p0 = E.pre(r, c), p1 = E.pre(r + 16, c);
    if constexpr (Epi::INPLACE) { E.fin_ip(r, c, acc[0][0], acc[0][1], p0); E.fin_ip(r + 16, c, acc[1][0], acc[1][1], p1); }
    else { E.fin(r, c, acc[0][0], acc[0][1], p0); E.fin(r + 16, c, acc[1][0], acc[1][1], p1); }
}
template <class Epi> __device__ __forceinline__ void mini_gemm(PG8_LAS unsigned char* lds, const bf16_t* A, const bf16_t* Bt, int K, int row0, int col0, const Epi& E) { f32x4 acc[2][2]; mini_gemm_acc<Epi, true>(lds, A, Bt, K, row0, col0, E, acc); }
struct ProjOrder {
    StaticOrder so; int G, c;
    __device__ void init(int G_, int c_) { so.init(8192, 18432, G_, c_); G = G_; c = c_; }
    __device__ bool next(int i, Unit& u) const {
        const long L = (long)i * G + c;
        if (L < 2304) return so.next(i, u);
        if (L < 2560) { const int j = (int)L - 2304; u.pm = 32 + (j & 3); u.pn = j >> 2; u.sel = 0; return true; }
        return false;
    }
    __device__ __forceinline__ void a_ready(const Unit&) const {}
    __device__ __forceinline__ void done(const Unit&) const {}
};
template <class Epi, class Sched, bool ALIGN_EPI, bool SP2, bool ZERO0>
__device__ __forceinline__ void gemm_phase_acc(PG8_LAS unsigned char* lds, const Gemm g, const Sched& S, const Epi& E, f32x4 (&acc)[2][2][4][2]) {
    int tid_ = threadIdx.x; asm volatile("" : "+v"(tid_));
    const int tid = tid_, wid = __builtin_amdgcn_readfirstlane(tid >> 6), lane = tid & 63, wr = wid >> 2, wc = wid & 3, fr = lane & 15, fq = lane >> 4;
    const int K = g.K, nt = K / BK;
    unsigned voffA[2], voffB[2];
#pragma unroll
    for (int i = 0; i < 2; ++i) { int R, C; stage_rc(tid * 16 + i * 8192, R, C); const int Rb = (R & ~31) + perm32(R & 31);
        voffA[i] = (unsigned)(R * K + C) * 2u; voffB[i] = (unsigned)(Rb * K + C) * 2u; }
    const size_t kstep = (size_t)(BK * 2);
    const size_t hstep = (size_t)HALF * K * 2;
    const size_t tstep = 2 * hstep;
    const unsigned ldsw = (unsigned)wid * 1024u;
    const int aoff = lds_byte(wr * 64 + fr, fq * 8), boff = lds_byte(wc * 32 + fr, fq * 8);
#define PG8_SA(b, h) (((b) * 2 + (h)) * HTB)
#define PG8_SB(b, h) ((4 + (b) * 2 + (h)) * HTB)
#define PG8_STAGE(bufoff, gbase, voff) do { _Pragma("unroll") for (int _i = 0; _i < 2; ++_i) \
        __builtin_amdgcn_global_load_lds((const unsigned*)((const char*)(gbase) + (voff)[_i]), (PG8_LAS unsigned*)(lds + (bufoff) + ldsw + _i * 8192), 16, 0, 0); } while (0)
#define PG8_LDA(dst, b, h) do { _Pragma("unroll") for (int m = 0; m < 4; ++m) _Pragma("unroll") for (int k = 0; k < 2; ++k) dst[m][k] = *(const PG8_LAS bf16x8*)(lds + PG8_SA(b, h) + aoff + m * 2048 + k * 1024); } while (0)
#define PG8_LDB(dst, b, h) do { _Pragma("unroll") for (int n = 0; n < 2; ++n) _Pragma("unroll") for (int k = 0; k < 2; ++k) dst[n][k] = *(const PG8_LAS bf16x8*)(lds + PG8_SB(b, h) + boff + n * 2048 + k * 1024); } while (0)
#define PG8_MMA(ai, bj, At, Bt) do { __builtin_amdgcn_s_setprio(1); _Pragma("unroll") for (int m = 0; m < 4; ++m) _Pragma("unroll") for (int n = 0; n < 2; ++n) _Pragma("unroll") for (int k = 0; k < 2; ++k) \
        acc[ai][bj][m][n] = __builtin_amdgcn_mfma_f32_16x16x32_bf16(Bt[n][k], At[m][k], acc[ai][bj][m][n], 0, 0, 0); __builtin_amdgcn_s_setprio(0); } while (0)
#define PG8_WAIT_V(n) asm volatile("s_waitcnt vmcnt(" #n ")" ::: "memory")
#define PG8_WAIT_L(n) asm volatile("s_waitcnt lgkmcnt(" #n ")" ::: "memory")
#define PG8_BAR __builtin_amdgcn_s_barrier()
#define PG8_SCHED __builtin_amdgcn_sched_barrier(0)
    Unit cur, nxt; int ui = 0;
    if (!S.next(0, cur)) return;
    if constexpr (ZERO0) {
#pragma unroll
    for (int a = 0; a < 2; ++a)
#pragma unroll
        for (int b = 0; b < 2; ++b)
#pragma unroll
            for (int m = 0; m < 4; ++m)
#pragma unroll
                for (int n = 0; n < 2; ++n) acc[a][b][m][n] = (f32x4){0.f, 0.f, 0.f, 0.f};
    }
    bf16x8 At[4][2], B0[2][2], B1[2][2];
    const char* cA = (const char*)(cur.sel ? g.A2 : g.A) + (size_t)cur.pm * tstep; const char* cB = (const char*)(cur.sel ? g.Bt2 : g.Bt) + (size_t)cur.pn * tstep;
    S.a_ready(cur);
    if constexpr (SP2) {
        PG8_STAGE(PG8_SB(0, 0), cB, voffB); PG8_STAGE(PG8_SB(0, 1), cB + hstep, voffB); PG8_STAGE(PG8_SA(0, 0), cA, voffA); PG8_STAGE(PG8_SA(0, 1), cA + hstep, voffA);
        if (wr == 1) PG8_BAR;
        PG8_WAIT_V(2); PG8_BAR;
        PG8_STAGE(PG8_SB(1, 0), cB + kstep, voffB); PG8_STAGE(PG8_SA(1, 0), cA + kstep, voffA); PG8_STAGE(PG8_SB(1, 1), cB + hstep + kstep, voffB);
        PG8_WAIT_V(6); PG8_BAR;
    } else {
        PG8_STAGE(PG8_SB(0, 0), cB, voffB); PG8_STAGE(PG8_SA(0, 0), cA, voffA); PG8_STAGE(PG8_SB(0, 1), cB + hstep, voffB); PG8_STAGE(PG8_SA(0, 1), cA + hstep, voffA);
        if (wr == 1) PG8_BAR;
        PG8_WAIT_V(4); PG8_BAR;
        PG8_STAGE(PG8_SB(1, 0), cB + kstep, voffB); PG8_STAGE(PG8_SA(1, 0), cA + kstep, voffA); PG8_STAGE(PG8_SB(1, 1), cB + hstep + kstep, voffB);
        PG8_WAIT_V(6); PG8_BAR;
    }
    for (;;) {
        const bool has_next = S.next(ui + 1, nxt);
        const char* nA = has_next ? (const char*)(nxt.sel ? g.A2 : g.A) + (size_t)nxt.pm * tstep : cA; const char* nB = has_next ? (const char*)(nxt.sel ? g.Bt2 : g.Bt) + (size_t)nxt.pn * tstep : cB;
        for (int t = 0; t < nt; t += 2) {
            if constexpr (Epi::MIDK) { if (cur.sel == 1 && (t == 8 || t == 16 || t == 24)) {
                const int seg = (t >> 3) - 1;
#pragma unroll
                for (int ai = 0; ai < 2; ++ai)
#pragma unroll
                    for (int m = 0; m < 4; ++m) { const float rho = E.ratio(ai * HALF + wr * 64 + m * 16 + fr, seg);
#pragma unroll
                        for (int bj = 0; bj < 2; ++bj)
#pragma unroll
                            for (int n = 0; n < 2; ++n) acc[ai][bj][m][n] = acc[ai][bj][m][n] * rho; } } }
            const bool last = (t == nt - 2);
            const char* a1 = cA + (size_t)(t + 1) * kstep;
            const char* a2 = last ? nA : cA + (size_t)(t + 2) * kstep; const char* b2 = last ? nB : cB + (size_t)(t + 2) * kstep;
            const char* a3 = a2 + kstep; const char* b3 = b2 + kstep;
            if (last && has_next) S.a_ready(nxt);
            if constexpr (SP2) {
            PG8_LDB(B0, 0, 0); PG8_LDB(B1, 0, 1); PG8_SCHED; PG8_LDA(At, 0, 0); PG8_STAGE(PG8_SA(1, 1), a1 + hstep, voffA);
            PG8_WAIT_V(8); PG8_WAIT_L(0); PG8_BAR; PG8_MMA(0, 0, At, B0); PG8_MMA(0, 1, At, B1); PG8_BAR; PG8_SCHED;
            PG8_LDA(At, 0, 1); PG8_STAGE(PG8_SB(0, 0), b2, voffB); PG8_STAGE(PG8_SB(0, 1), b2 + hstep, voffB); PG8_STAGE(PG8_SA(0, 0), a2, voffA);
            PG8_WAIT_V(8); PG8_WAIT_L(0); PG8_BAR; PG8_MMA(1, 0, At, B0); PG8_MMA(1, 1, At, B1); PG8_BAR; PG8_SCHED;
            PG8_LDB(B0, 1, 0); PG8_LDB(B1, 1, 1); PG8_SCHED; PG8_LDA(At, 1, 0); PG8_STAGE(PG8_SA(0, 1), a2 + hstep, voffA);
            PG8_WAIT_V(8); PG8_WAIT_L(0); PG8_BAR; PG8_MMA(0, 0, At, B0); PG8_MMA(0, 1, At, B1); PG8_BAR; PG8_SCHED;
            PG8_LDA(At, 1, 1); PG8_STAGE(PG8_SB(1, 0), b3, voffB); PG8_STAGE(PG8_SB(1, 1), b3 + hstep, voffB); PG8_STAGE(PG8_SA(1, 0), a3, voffA);
            PG8_WAIT_V(8); PG8_WAIT_L(0); PG8_BAR; PG8_MMA(1, 0, At, B0); PG8_MMA(1, 1, At, B1); PG8_BAR; PG8_SCHED;
            } else {
            PG8_LDB(B0, 0, 0); PG8_SCHED; PG8_LDA(At, 0, 0); PG8_STAGE(PG8_SA(1, 1), a1 + hstep, voffA);
            PG8_WAIT_L(8); PG8_BAR; PG8_WAIT_L(0); PG8_MMA(0, 0, At, B0); PG8_BAR; PG8_SCHED;
            PG8_LDB(B1, 0, 1); PG8_STAGE(PG8_SB(0, 0), b2, voffB);
            PG8_BAR; PG8_WAIT_L(0); PG8_MMA(0, 1, At, B1); PG8_BAR;
            PG8_LDA(At, 0, 1); PG8_STAGE(PG8_SA(0, 0), a2, voffA);
            PG8_BAR; PG8_WAIT_L(0); PG8_MMA(1, 0, At, B0); PG8_BAR; PG8_SCHED;
            PG8_STAGE(PG8_SB(0, 1), b2 + hstep, voffB);
            PG8_WAIT_V(6); PG8_BAR; PG8_MMA(1, 1, At, B1); PG8_BAR;
            PG8_LDB(B0, 1, 0); PG8_SCHED; PG8_LDA(At, 1, 0); PG8_STAGE(PG8_SA(0, 1), a2 + hstep, voffA);
            PG8_WAIT_L(8); PG8_BAR; PG8_WAIT_L(0); PG8_MMA(0, 0, At, B0); PG8_BAR; PG8_SCHED;
            PG8_LDB(B1, 1, 1); PG8_STAGE(PG8_SB(1, 0), b3, voffB);
            PG8_BAR; PG8_WAIT_L(0); PG8_MMA(0, 1, At, B1); PG8_BAR;
            PG8_LDA(At, 1, 1); PG8_STAGE(PG8_SA(1, 0), a3, voffA);
            PG8_BAR; PG8_WAIT_L(0); PG8_MMA(1, 0, At, B0); PG8_BAR; PG8_SCHED;
            PG8_STAGE(PG8_SB(1, 1), b3 + hstep, voffB);
            PG8_WAIT_V(6); PG8_BAR; PG8_MMA(1, 1, At, B1); PG8_BAR;
            }
        }
        if constexpr (ALIGN_EPI) { if (wr == 0) PG8_BAR; }
        epi_big(E, acc, cur, wr, wc, fr, fq); S.done(cur);
        if (!has_next) break;
        if (nxt.sel == 0) {
#pragma unroll
        for (int a = 0; a < 2; ++a)
#pragma unroll
            for (int b = 0; b < 2; ++b)
#pragma unroll
                for (int m = 0; m < 4; ++m)
#pragma unroll
                    for (int n = 0; n < 2; ++n) acc[a][b][m][n] = (f32x4){0.f, 0.f, 0.f, 0.f};
        }
        cur = nxt; cA = nA; cB = nB; ++ui;
        if constexpr (ALIGN_EPI) { if (wr == 1) PG8_BAR; }
    }
    PG8_WAIT_V(0);
    if constexpr (!ALIGN_EPI) { if (wr == 0) PG8_BAR; }
    PG8_BAR;
#undef PG8_SA
#undef PG8_SB
#undef PG8_STAGE
#undef PG8_LDA
#undef PG8_LDB
#undef PG8_MMA
#undef PG8_WAIT_V
#undef PG8_WAIT_L
#undef PG8_BAR
#undef PG8_SCHED
}
template <class Epi, class Sched, bool ALIGN_EPI = false, bool SP2 = false>
__device__ __forceinline__ void gemm_phase(PG8_LAS unsigned char* lds, const Gemm g, const Sched& S, const Epi& E) { f32x4 acc[2][2][4][2]; gemm_phase_acc<Epi, Sched, ALIGN_EPI, SP2, true>(lds, g, S, E, acc); }
}

constexpr int D = 2048, M = 9216, MP = 8192, DEPTH = 4, NWAVES = 8;
constexpr int INW = 18448, NPAD = 18496, PW = pg8::PW;
constexpr int C_GA = 0, C_GB = 2048, C_CB = 4096, C_CC = 6144, C_CX = 8192, C_CG = 10240, C_Q = 12288, C_K = 13312, C_V = 14336, C_GG = 16384;
constexpr float EPS = 1e-6f;
constexpr size_t O_Y = 0, O_CONVP = 18874368, O_GLAP = 18939904, O_CONVS = 27328512, O_GLAS = 29425664, O_END = 297861120;
constexpr size_t MiB = 1u << 20;
constexpr size_t WS_CTL = 0, CTL_ZERO_BYTES = 2 * MiB;
constexpr size_t WS_WIN = 2 * MiB, WIN_L = (size_t)NPAD * D * 2;
constexpr size_t WS_WA = 296 * MiB, WS_WB = 328 * MiB, WS_WO = 360 * MiB, W_L = (size_t)D * D * 2;
constexpr size_t WS_XF = 392 * MiB, WS_XB = 464 * MiB, WS_P = 500 * MiB, WS_ZA = 824 * MiB, WS_ZB = 860 * MiB, WS_MG = 896 * MiB;
constexpr size_t WS_O = 932 * MiB, WS_T = 1004 * MiB, WS_LR = 1076 * MiB, WS_RSTD = 1077 * MiB, WS_END = 1078 * MiB;
static_assert(WS_WIN + 4 * WIN_L <= WS_WA, "ws map");
constexpr int CW_BAR = 4096;
constexpr size_t WS_RSO = 524288;
constexpr size_t WS_RSQ = 65536;
constexpr int RING_OFF = 0, RING_BYTES = 131072, ROWSUM_OFF = 147456, LDSCTL_OFF = 149504, MISC_OFF = LDSCTL_OFF + 320, RT_OFF = 150528, LDS_BYTES = 158720;

#define GAS __attribute__((address_space(1)))
#define LAS __attribute__((address_space(3)))
typedef unsigned short bf16;
typedef unsigned v4u __attribute__((ext_vector_type(4)));
typedef unsigned v2u __attribute__((ext_vector_type(2)));
typedef float f32x4 __attribute__((ext_vector_type(4)));
typedef GAS unsigned gu32;
#define RLX_AGENT __ATOMIC_RELAXED, __HIP_MEMORY_SCOPE_AGENT
#define LDS_WAIT() asm volatile("s_waitcnt lgkmcnt(0)" ::: "memory")
#define VM_WAIT() asm volatile("s_waitcnt vmcnt(0)" ::: "memory")
__device__ __forceinline__ unsigned f2bf(float f) { unsigned u = __builtin_bit_cast(unsigned, f); return (u + 0x7fffu + ((u >> 16) & 1u)) >> 16; }
__device__ __forceinline__ unsigned pk2(float lo, float hi) { return f2bf(lo) | (f2bf(hi) << 16); }
__device__ __forceinline__ float bflo(unsigned w) { return __uint_as_float(w << 16); }
__device__ __forceinline__ float bfhi(unsigned w) { return __uint_as_float(w & 0xffff0000u); }
__device__ __forceinline__ float bf1(bf16 b) { return __uint_as_float(((unsigned)b) << 16); }

typedef short bf16x8 __attribute__((ext_vector_type(8)));
typedef float f32x2 __attribute__((ext_vector_type(2)));
typedef __bf16 bf16x2_t __attribute__((ext_vector_type(2)));
__device__ __forceinline__ unsigned pkbf(float a, float b) { f32x2 v = {a, b}; bf16x2_t r = __builtin_convertvector(v, bf16x2_t); return __builtin_bit_cast(unsigned, r); }
#define XB_TMO      128
#define XB_XCNT(j)  (256  + 64 * (j))
#define XB_XSUB(j)  (1280 + 64 * (j))
#define XB_XGEN(j)  (2304 + 64 * (j))
#define XB_TOP      3328
#define XB_TOPGEN   3392
#define XCD_BAR_WORDS 3456
#define XB_SPIN_CAP (1u << 18)
__device__ __forceinline__ unsigned xb_ld(unsigned* p)              { return __hip_atomic_load(p, __ATOMIC_RELAXED, __HIP_MEMORY_SCOPE_AGENT); }
__device__ __forceinline__ unsigned xb_add(unsigned* p, unsigned v) { return __hip_atomic_fetch_add(p, v, __ATOMIC_RELAXED, __HIP_MEMORY_SCOPE_AGENT); }
__device__ __forceinline__ unsigned xb_xcc_id() { return (unsigned)__builtin_amdgcn_s_getreg((3 << 11) | 20) & 0xFu; }
#define XB_SPIN(cond, bar) do { unsigned _sp = 0; while (cond) { __builtin_amdgcn_s_sleep(1); \
    if ((++_sp & 255u) == 0u) { if (xb_ld(&(bar)[XB_TMO])) break; if (_sp > XB_SPIN_CAP) { atomicAdd(&(bar)[XB_TMO], 1u); break; } } } } while (0)
struct XcdBarrier { unsigned* bar; unsigned x; volatile LAS unsigned* st; };
__device__ __forceinline__ XcdBarrier xcd_barrier_post(unsigned* bar, volatile LAS unsigned* st) {
    XcdBarrier b; b.bar = bar; b.x = xb_xcc_id(); b.st = st;
    if (threadIdx.x == 0) (void)xb_add(&bar[XB_XCNT(b.x)], 1u);
    return b;
}
__device__ __forceinline__ void xcd_barrier_complete(unsigned* bar, unsigned x, unsigned& nloc, unsigned& nx) {
    const unsigned G = gridDim.x * gridDim.y * gridDim.z;
    unsigned sum, cnt, mine, sp = 0u;
    for (;;) {
        sum = 0u; cnt = 0u; mine = 0u;
#pragma unroll
        for (unsigned j = 0; j < 16; ++j) { const unsigned c = xb_ld(&bar[XB_XCNT(j)]); sum += c; cnt += (c > 0u) ? 1u : 0u; mine = (j == x) ? c : mine; }
        if (sum == G) break;
        __builtin_amdgcn_s_sleep(1);
        if ((++sp & 255u) == 0u) { if (xb_ld(&bar[XB_TMO])) break; if (sp > XB_SPIN_CAP) { atomicAdd(&bar[XB_TMO], 1u); break; } }
    }
    nloc = mine > 0u ? mine : 1u; nx = cnt > 0u ? cnt : 1u;
}
__device__ __forceinline__ void xcd_barrier(const XcdBarrier& b) {
    asm volatile("s_waitcnt vmcnt(0)" ::: "memory");
    __syncthreads();
    if (threadIdx.x == 0) {
        unsigned* bar = b.bar;
        __builtin_amdgcn_s_waitcnt(0);
        unsigned nloc = b.st[0], nx = b.st[1];
        if (nloc == 0u) { xcd_barrier_complete(bar, b.x, nloc, nx); b.st[0] = nloc; b.st[1] = nx; }
        const unsigned old = xb_add(&bar[XB_XSUB(b.x)], 1u);
        const unsigned gen = old / nloc;
        if (old + 1u == (gen + 1u) * nloc) {
            __builtin_amdgcn_fence(__ATOMIC_RELEASE, "agent");
            asm volatile("s_waitcnt vmcnt(0)" ::: "memory");
            const unsigned og = xb_add(&bar[XB_TOP], 1u);
            const unsigned tg = og / nx;
            if (og + 1u == (tg + 1u) * nx) xb_add(&bar[XB_TOPGEN], 1u);
            else XB_SPIN(xb_ld(&bar[XB_TOPGEN]) == tg, bar);
            __builtin_amdgcn_fence(__ATOMIC_ACQUIRE, "agent");
            xb_add(&bar[XB_XGEN(b.x)], 1u);
            asm volatile("s_waitcnt vmcnt(0)" ::: "memory");
        } else {
            XB_SPIN(xb_ld(&bar[XB_XGEN(b.x)]) == gen, bar);
            __builtin_amdgcn_fence(__ATOMIC_ACQUIRE, "agent");
            asm volatile("s_waitcnt vmcnt(0)" ::: "memory");
        }
    }
    __syncthreads();
}

struct Frame {
    LAS unsigned char* lds;
    int tid, lane, wave, vcu, G;
};
__device__ __forceinline__ const float* inp(int k) { asm volatile("" : "+s"(k)); const unsigned long long* ka = (const unsigned long long*)__builtin_amdgcn_kernarg_segment_ptr(); return (const float*)(const GAS float*)ka[k]; }
__device__ __forceinline__ unsigned char* wsp() { return (unsigned char*)inp(15); }
__device__ __forceinline__ float* outp() { return (float*)inp(14); }
enum { I_XP = 0, I_XS, I_SCONV, I_SGLA, I_NORMG, I_WIN, I_CONVW, I_WA2, I_BA, I_GNORMG, I_WBA, I_WBB, I_WO, I_FING };
__device__ __forceinline__ float wave_sum(float v) {
#pragma unroll
    for (int o = 1; o < 64; o <<= 1) v += __shfl_xor(v, o);
    return v;
}
__device__ __forceinline__ void tr_item(const float* W, int ldw, int nvalid, int K, bf16* WT, int nblk, const float* s, int smask, int item, int lane, bool perm) {
    const int kb = item / nblk, nb = item % nblk, k0 = 64 * kb, n = 64 * nb + lane;
    int nd = n;
    if (perm && n >= 4096 && n < 12288) { const int sct = (n - 4096) >> 11, ch = (n - 4096) & 2047, c64 = ch & 63; nd = 4096 + (ch >> 6) * 256 + 128 * (sct >> 1) + 32 * (c64 >> 4) + 8 * ((c64 >> 2) & 3) + 4 * (sct & 1) + (c64 & 3); }
    float v[64];
    if (n < nvalid) { const float* p = W + (size_t)k0 * ldw + n;
#pragma unroll
        for (int i = 0; i < 64; ++i) v[i] = p[(size_t)i * ldw]; }
    else {
#pragma unroll
        for (int i = 0; i < 64; ++i) v[i] = 0.f; }
    if (s) {
#pragma unroll
        for (int i = 0; i < 64; ++i) v[i] *= s[(k0 + i) & smask]; }
    GAS v4u* d = (GAS v4u*)(WT + (size_t)nd * K + k0);
#pragma unroll
    for (int c = 0; c < 8; ++c) { v4u o; o.x = pkbf(v[8 * c], v[8 * c + 1]); o.y = pkbf(v[8 * c + 2], v[8 * c + 3]); o.z = pkbf(v[8 * c + 4], v[8 * c + 5]); o.w = pkbf(v[8 * c + 6], v[8 * c + 7]); d[c] = o; }
}
__device__ __forceinline__ void p_prologue(Frame& F0) {
    Frame F = F0; asm volatile("" : "+v"(F.tid), "+v"(F.lane));
    const int gw = F.vcu * NWAVES + F.wave, NGW = F.G * NWAVES;
    constexpr int I_IN = (D / 64) * (NPAD / 64), I_SQ = (D / 64) * (D / 64), I_L = I_IN + 3 * I_SQ;
    for (int it = gw; it < DEPTH * I_L; it += NGW) {
        const int l = it / I_L; int r = it % I_L;
        if (r < I_IN) { tr_item(inp(I_WIN) + (size_t)l * D * INW, INW, INW, D, (bf16*)(wsp() + WS_WIN + l * WIN_L), NPAD / 64, inp(I_NORMG) + l * D, 0xffff, r, F.lane, true); continue; } r -= I_IN;
        if (r < I_SQ) { tr_item(inp(I_WBA) + (size_t)l * D * D, D, D, D, (bf16*)(wsp() + WS_WA + l * W_L), D / 64, nullptr, 0, r, F.lane, false); continue; } r -= I_SQ;
        if (r < I_SQ) { tr_item(inp(I_WBB) + (size_t)l * D * D, D, D, D, (bf16*)(wsp() + WS_WB + l * W_L), D / 64, inp(I_GNORMG) + l * 512, 511, r, F.lane, false); continue; } r -= I_SQ;
        tr_item(inp(I_WO) + (size_t)l * D * D, D, D, D, (bf16*)(wsp() + WS_WO + l * W_L), D / 64, nullptr, 0, r, F.lane, false);
    }
}
__device__ __forceinline__ void p_xprep(Frame& F0, int l) {
    Frame F = F0; asm volatile("" : "+v"(F.tid), "+v"(F.lane));
    const int gw = F.vcu * NWAVES + F.wave, NGW = F.G * NWAVES;
    bf16* XB = (bf16*)(wsp() + WS_XB); unsigned long long* RS = (unsigned long long*)(wsp() + WS_RSQ);
    for (int r = gw; r < M; r += NGW) {
        const float* src = r < MP ? inp(I_XP) + (size_t)r * D : inp(I_XS) + (size_t)(r - MP) * D;
        const GAS f32x4* s4 = (const GAS f32x4*)src + F.lane;
        f32x4 v[8]; float ss = 0.f;
#pragma unroll
        for (int j = 0; j < 8; ++j) { v[j] = s4[64 * j]; ss += (v[j].x * v[j].x + v[j].y * v[j].y) + (v[j].z * v[j].z + v[j].w * v[j].w); }
        const float tot = wave_sum(ss);
        if (F.lane == 0) RS[r] = (unsigned long long)(tot * 16777216.0f);
        GAS unsigned long long* o8 = (GAS unsigned long long*)(XB + (size_t)r * D) + F.lane;
#pragma unroll
        for (int j = 0; j < 8; ++j) o8[64 * j] = (unsigned long long)pk2(v[j].x, v[j].y) | ((unsigned long long)pk2(v[j].z, v[j].w) << 32);
    }
}
__device__ __forceinline__ void p_final(Frame& F0) {
    Frame F = F0; asm volatile("" : "+v"(F.tid), "+v"(F.lane));
    const int gw = F.vcu * NWAVES + F.wave, NGW = F.G * NWAVES;
    const bf16* XB = (const bf16*)(wsp() + WS_XB);
    for (int r = gw; r < M; r += NGW) {
        const GAS v2u* s2 = (const GAS v2u*)(XB + (size_t)r * D) + F.lane; const GAS f32x4* g4 = (const GAS f32x4*)inp(I_FING) + F.lane;
        f32x4 v[8];
#pragma unroll
        for (int j = 0; j < 8; ++j) { const v2u w = s2[64 * j]; v[j] = (f32x4){bflo(w.x), bfhi(w.x), bflo(w.y), bfhi(w.y)}; }
        const float rstd = 1.f / sqrtf((float)((const unsigned long long*)(wsp() + WS_RSQ))[DEPTH * M + r] * (1.0f / 16777216.0f) * (1.f / D) + EPS);
        GAS f32x4* d4 = (GAS f32x4*)(outp() + O_Y + (size_t)r * D) + F.lane;
#pragma unroll
        for (int j = 0; j < 8; ++j) d4[64 * j] = v[j] * rstd * g4[64 * j];
    }
}
__device__ __forceinline__ unsigned short bf1r(float a) { return (unsigned short)(pkbf(a, 0.f) & 0xffffu); }
__device__ __forceinline__ float logsig16(float a) { return (fminf(a, 0.f) - 0.69314718f * __builtin_amdgcn_logf(1.0f + __builtin_amdgcn_exp2f(-1.44269504f * fabsf(a)))) * 0.0625f; }
__device__ __forceinline__ float fexp(float x) { return __builtin_amdgcn_exp2f(1.44269504f * x); }
__device__ __forceinline__ int qt_off(int t, int p) { return t * 512 + (((p & 16) | ((p ^ t) & 15)) << 4); }
__device__ __forceinline__ int r8_off(int r, int p) { return r * 128 + ((p ^ ((r >> 1) & 7)) << 4); }
__device__ __forceinline__ int qt_pos(int k) { const int k32 = k & 31; return (k & ~31) + 8 * ((k32 & 15) >> 2) + 4 * (k32 >> 4) + (k32 & 3); }
constexpr size_t WS_QT = 1078 * MiB, WS_KD = 1094 * MiB, WS_AI = 1110 * MiB, WS_GM = 1114 * MiB, WS_VT = 1115 * MiB, WS_END2 = 1147 * MiB;
constexpr int QT_B = 32768, KD_B = 32768, AI_B = 8192, GM_B = 1024, VT_B = 65536, SCAN_BUF = QT_B + KD_B + AI_B + GM_B;

__device__ __forceinline__ void p_gla_prep(Frame& F0, int l) {
    Frame F = F0; asm volatile("" : "+v"(F.tid), "+v"(F.lane));
    const bf16* P = (const bf16*)(wsp() + WS_P); const float* LR = (const float*)(wsp() + WS_LR);
    LAS unsigned char* Qs = F.lds; LAS unsigned char* Ks = F.lds + 32768; LAS unsigned char* VTs = F.lds;
    LAS unsigned char* Qraw = F.lds + 65536; LAS unsigned char* Kraw = F.lds + 98304;
    LAS float* LRs = (LAS float*)(F.lds + 131072); LAS float* TOT = (LAS float*)(F.lds + 135168);
    const int k = F.tid & 255, half = F.tid >> 8;
    for (int item = F.vcu; item < 512; item += F.G) {
        const int b = item >> 7, c = (item >> 2) & 31, h = item & 3, r0 = b * 2048 + c * 64;
        v4u va[4], vb[4], qv[4], kv[4]; f32x4 lrv = {0.f, 0.f, 0.f, 0.f};
#pragma unroll
        for (int i = 0; i < 4; ++i) { const int id = i * 512 + F.tid, tp = id & 31, pc = id >> 5;
            va[i] = *(const GAS v4u*)(P + (size_t)(r0 + 2 * tp) * PW + C_V + h * 512 + 8 * pc); vb[i] = *(const GAS v4u*)(P + (size_t)(r0 + 2 * tp + 1) * PW + C_V + h * 512 + 8 * pc);
            const int t = id >> 5, p = id & 31;
            qv[i] = *(const GAS v4u*)(P + (size_t)(r0 + t) * PW + C_Q + h * 256 + 8 * p); kv[i] = *(const GAS v4u*)(P + (size_t)(r0 + t) * PW + C_K + h * 256 + 8 * p); }
        if (F.tid < 256) lrv = *(const GAS f32x4*)(LR + (size_t)r0 * 16 + 4 * F.tid);
        float w2[16]; const float bias = inp(I_BA)[l * 1024 + h * 256 + k];
        { const float* w2p = inp(I_WA2) + (size_t)l * 16 * 1024 + h * 256 + k;
#pragma unroll
          for (int j = 0; j < 16; ++j) w2[j] = w2p[j * 1024]; }
#pragma unroll
        for (int i = 0; i < 4; ++i) { const int id = i * 512 + F.tid, tp = id & 31, pc = id >> 5; const v4u a = va[i], bb = vb[i];
            LAS unsigned* d = (LAS unsigned*)(VTs + (8 * pc) * 128 + 4 * tp);
            d[0 * 32] = (a.x & 0xffffu) | (bb.x << 16); d[1 * 32] = (a.x >> 16) | (bb.x & 0xffff0000u); d[2 * 32] = (a.y & 0xffffu) | (bb.y << 16); d[3 * 32] = (a.y >> 16) | (bb.y & 0xffff0000u);
            d[4 * 32] = (a.z & 0xffffu) | (bb.z << 16); d[5 * 32] = (a.z >> 16) | (bb.z & 0xffff0000u); d[6 * 32] = (a.w & 0xffffu) | (bb.w << 16); d[7 * 32] = (a.w >> 16) | (bb.w & 0xffff0000u);
            *(LAS v4u*)(Qraw + id * 16) = qv[i]; *(LAS v4u*)(Kraw + id * 16) = kv[i]; }
        if (F.tid < 256) *(LAS f32x4*)(LRs + 4 * F.tid) = lrv;
        __syncthreads();
        { GAS v4u* dst = (GAS v4u*)(wsp() + WS_VT + (size_t)item * VT_B);
#pragma unroll
          for (int i = 0; i < 8; ++i) dst[i * 512 + F.tid] = *(const LAS v4u*)(VTs + (i * 512 + F.tid) * 16); }
        float bc[32]; float run = 0.f;
#pragma unroll
        for (int i = 0; i < 32; ++i) { const LAS f32x4* lr4 = (const LAS f32x4*)(LRs + (half * 32 + i) * 16); float a = bias;
#pragma unroll
            for (int j4 = 0; j4 < 4; ++j4) { const f32x4 x = lr4[j4]; a += x[0] * w2[4 * j4] + x[1] * w2[4 * j4 + 1] + x[2] * w2[4 * j4 + 2] + x[3] * w2[4 * j4 + 3]; }
            run += logsig16(a); bc[i] = run; }
        TOT[half * 256 + k] = run;
        __syncthreads();
        const float lo_tot = TOT[k], blast = lo_tot + TOT[256 + k], boff = half ? lo_tot : 0.f;
        if (half == 0) ((float*)(wsp() + WS_GM))[(size_t)item * 256 + k] = fexp(blast);
        const int pos = qt_pos(k), pp = pos >> 3, pe = (pos & 7) * 2;
        unsigned char* kdg = wsp() + WS_KD + (size_t)item * KD_B;
#pragma unroll
        for (int g = 0; g < 4; ++g) { unsigned kdw[4];
#pragma unroll
            for (int e = 0; e < 8; ++e) { const int i = g * 8 + e, t = half * 32 + i; const float bt = bc[i] + boff;
                const float qf = bf1(*(const LAS unsigned short*)(Qraw + t * 512 + k * 2)) * 0.0625f * fexp(bt), kf = bf1(*(const LAS unsigned short*)(Kraw + t * 512 + k * 2));
                const float kh = kf * fexp(-bt), kd = kf * fexp(blast - bt);
                *(LAS unsigned short*)(Qs + qt_off(t, pp) + pe) = bf1r(qf); *(LAS unsigned short*)(Ks + qt_off(t, pp) + pe) = bf1r(kh);
                if (e & 1) kdw[e >> 1] = (kdw[e >> 1] & 0xffffu) | ((unsigned)bf1r(kd) << 16); else kdw[e >> 1] = bf1r(kd); }
            v4u w; w.x = kdw[0]; w.y = kdw[1]; w.z = kdw[2]; w.w = kdw[3];
            *(GAS v4u*)(kdg + r8_off(k, half * 4 + g)) = w; }
        __syncthreads();
        { GAS v4u* dq = (GAS v4u*)(wsp() + WS_QT + (size_t)item * QT_B);
#pragma unroll
          for (int i = 0; i < 4; ++i) dq[i * 512 + F.tid] = *(const LAS v4u*)(Qs + (i * 512 + F.tid) * 16); }
        { const int r16 = F.lane & 15, quad = F.lane >> 4;
#pragma unroll
          for (int u = 0; u < 2; ++u) { const int id = F.wave * 2 + u, si = id >> 2, ti = id & 3;
              f32x4 acc = {0.f, 0.f, 0.f, 0.f};
              if (ti >= si) {
#pragma unroll
                  for (int ks = 0; ks < 8; ++ks) { const bf16x8 ka = *(const LAS bf16x8*)(Ks + qt_off(16 * si + r16, 4 * ks + quad)), qb = *(const LAS bf16x8*)(Qs + qt_off(16 * ti + r16, 4 * ks + quad));
                      acc = __builtin_amdgcn_mfma_f32_16x16x32_bf16(ka, qb, acc, 0, 0, 0); } }
              const int t = 16 * ti + r16, s0 = 16 * si + 4 * quad;
              v2u w; w.x = pkbf(s0 + 0 <= t ? acc[0] : 0.f, s0 + 1 <= t ? acc[1] : 0.f); w.y = pkbf(s0 + 2 <= t ? acc[2] : 0.f, s0 + 3 <= t ? acc[3] : 0.f);
              *(GAS v2u*)(wsp() + WS_AI + (size_t)item * AI_B + r8_off(t, 2 * si + (quad >> 1)) + (quad & 1) * 8) = w; } }
        __syncthreads();
    }
}
__device__ __forceinline__ void scan_stage(unsigned char* ws, LAS unsigned char* lds, int item, int c, int lw, int lane) {
    LAS unsigned char* buf = lds + (c & 1) * SCAN_BUF;
    const unsigned char* gq = ws + WS_QT + (size_t)item * QT_B; const unsigned char* gk = ws + WS_KD + (size_t)item * KD_B;
    const unsigned char* ga = ws + WS_AI + (size_t)item * AI_B; const unsigned char* gg = ws + WS_GM + (size_t)item * GM_B;
#pragma unroll
    for (int i = 0; i < 8; ++i) { const int wp = lw + 4 * i;
        __builtin_amdgcn_global_load_lds((const unsigned*)(gq + wp * 1024 + lane * 16), (LAS unsigned*)(buf + wp * 1024), 16, 0, 0);
        __builtin_amdgcn_global_load_lds((const unsigned*)(gk + wp * 1024 + lane * 16), (LAS unsigned*)(buf + QT_B + wp * 1024), 16, 0, 0); }
#pragma unroll
    for (int i = 0; i < 2; ++i) { const int wp = lw + 4 * i;
        __builtin_amdgcn_global_load_lds((const unsigned*)(ga + wp * 1024 + lane * 16), (LAS unsigned*)(buf + QT_B + KD_B + wp * 1024), 16, 0, 0); }
    if (lw == 0) __builtin_amdgcn_global_load_lds((const unsigned*)(gg + lane * 16), (LAS unsigned*)(buf + QT_B + KD_B + AI_B), 16, 0, 0);
}
__device__ __forceinline__ void p_gla_scan(Frame& F0, int l) {
    Frame F = F0; asm volatile("" : "+v"(F.tid), "+v"(F.lane));
    if (F.vcu >= 128) return;
    const int b = F.vcu >> 5, h = (F.vcu >> 3) & 3, vq = F.vcu & 7;
    bf16* ZBp = (bf16*)(wsp() + WS_ZB); const bf16* Pp = (const bf16*)(wsp() + WS_P); unsigned long long* RSO = (unsigned long long*)(wsp() + WS_RSO) + (size_t)l * M * 4;
    const int r16 = F.lane & 15, quad = F.lane >> 4, w = F.wave;
    const int vcol0 = vq * 64 + (w & 3) * 16;
    f32x4 S[16];
#pragma unroll
    for (int i = 0; i < 16; ++i) S[i] = (f32x4){0.f, 0.f, 0.f, 0.f};
    if (w >= 4) {
        scan_stage(wsp(), F.lds, (b * 32 + 0) * 4 + h, 0, w - 4, F.lane);
#pragma unroll 1
        for (int c = 0; c < 32; ++c) {
            asm volatile("s_waitcnt vmcnt(0)" ::: "memory");
            asm volatile("" ::: "memory"); __builtin_amdgcn_s_barrier(); asm volatile("" ::: "memory");
            if (c + 1 < 32) scan_stage(wsp(), F.lds, (b * 32 + c + 1) * 4 + h, c + 1, w - 4, F.lane);
        }
        asm volatile("s_waitcnt vmcnt(0)" ::: "memory");
        __syncthreads();
        return;
    }
    bf16x8 vf[2], vn[2];
    { const unsigned char* gv = wsp() + WS_VT + (size_t)((b * 32 + 0) * 4 + h) * VT_B + (vcol0 + r16) * 128 + quad * 16; vf[0] = *(const GAS bf16x8*)gv; vf[1] = *(const GAS bf16x8*)(gv + 64); }
    v4u gq[2], gqn[2];
    { const int r0 = b * 2048;
#pragma unroll
      for (int m = 0; m < 2; ++m) gq[m] = *(const GAS v4u*)(Pp + (size_t)(r0 + 16 * (2 * m + (quad & 1)) + r16) * PW + C_GG + h * 512 + vcol0 + 4 * (quad & 2)); }
    __builtin_amdgcn_s_setprio(3);
    auto chunk = [&](const int c, bf16x8 (&vcur)[2], bf16x8 (&vnxt)[2], v4u (&gcur)[2], v4u (&gnxt)[2]) __attribute__((always_inline)) {
        asm volatile("" ::: "memory"); __builtin_amdgcn_s_barrier(); asm volatile("" ::: "memory");
        const LAS unsigned char* buf = F.lds + (c & 1) * SCAN_BUF;
        const LAS unsigned char* Qb = buf; const LAS unsigned char* Kb = buf + QT_B; const LAS unsigned char* Ab = buf + QT_B + KD_B; const LAS unsigned char* Gb = buf + QT_B + KD_B + AI_B;
        f32x4 acc[4];
#pragma unroll
        for (int ti = 0; ti < 4; ++ti) acc[ti] = (f32x4){0.f, 0.f, 0.f, 0.f};
        bf16x8 rb[3][4];
#define SCAN_LDG(g, d) { _Pragma("unroll") for (int ti = 0; ti < 4; ++ti) d[ti] = (g) < 8 ? *(const LAS bf16x8*)(Qb + qt_off(16 * ti + r16, 4 * (g) + quad)) : *(const LAS bf16x8*)(Ab + r8_off(16 * ti + r16, 4 * ((g) - 8) + quad)); }
        SCAN_LDG(0, rb[0]) SCAN_LDG(1, rb[1])
#pragma unroll
        for (int g = 0; g < 10; ++g) {
            if (g + 2 < 10) SCAN_LDG(g + 2, rb[(g + 2) % 3])
            bf16x8 sa;
            if (g < 8) { v4u sp; sp.x = pkbf(S[2 * g][0], S[2 * g][1]); sp.y = pkbf(S[2 * g][2], S[2 * g][3]); sp.z = pkbf(S[2 * g + 1][0], S[2 * g + 1][1]); sp.w = pkbf(S[2 * g + 1][2], S[2 * g + 1][3]); sa = __builtin_bit_cast(bf16x8, sp); }
            else sa = vcur[g - 8];
            __builtin_amdgcn_sched_barrier(0);
#pragma unroll
            for (int ti = 0; ti < 4; ++ti) acc[ti] = __builtin_amdgcn_mfma_f32_16x16x32_bf16(sa, rb[g % 3][ti], acc[ti], 0, 0, 0);
            __builtin_amdgcn_sched_barrier(0);
        }
#undef SCAN_LDG
        { const int cn = c + 1 < 32 ? c + 1 : c, r0 = b * 2048 + cn * 64;
#pragma unroll
          for (int m = 0; m < 2; ++m) gnxt[m] = *(const GAS v4u*)(Pp + (size_t)(r0 + 16 * (2 * m + (quad & 1)) + r16) * PW + C_GG + h * 512 + vcol0 + 4 * (quad & 2));
          const unsigned char* gv = wsp() + WS_VT + (size_t)((b * 32 + cn) * 4 + h) * VT_B + (vcol0 + r16) * 128 + quad * 16; vnxt[0] = *(const GAS bf16x8*)gv; vnxt[1] = *(const GAS bf16x8*)(gv + 64); }
        f32x4 gb[2][2]; bf16x8 kb[2][2][2];
#define SCAN_LD3(p, s) { _Pragma("unroll") for (int e = 0; e < 2; ++e) { gb[s][e] = *(const LAS f32x4*)(Gb + (16 * (2 * (p) + e) + 4 * quad) * 4); \
            _Pragma("unroll") for (int ks = 0; ks < 2; ++ks) kb[s][e][ks] = *(const LAS bf16x8*)(Kb + r8_off(16 * (2 * (p) + e) + r16, 4 * ks + quad)); } }
        SCAN_LD3(0, 0)
        __builtin_amdgcn_sched_barrier(0);
        { const int r0 = b * 2048 + c * 64;
          const bool odd = quad & 1; float ss[4]; v2u wv[4];
#pragma unroll
          for (int m = 0; m < 2; ++m) { const v4u ld = gcur[m]; v2u own, snd, rcv;
              own.x = odd ? ld.z : ld.x; own.y = odd ? ld.w : ld.y; snd.x = odd ? ld.x : ld.z; snd.y = odd ? ld.y : ld.w;
              rcv.x = (unsigned)__shfl_xor((int)snd.x, 16); rcv.y = (unsigned)__shfl_xor((int)snd.y, 16);
              const v2u ga = odd ? rcv : own, gb2 = odd ? own : rcv;
              { const f32x4 a = acc[2 * m];     wv[2 * m].x     = pkbf(a[0] * bflo(ga.x),  a[1] * bfhi(ga.x));  wv[2 * m].y     = pkbf(a[2] * bflo(ga.y),  a[3] * bfhi(ga.y));  ss[2 * m]     = (a[0] * a[0] + a[1] * a[1]) + (a[2] * a[2] + a[3] * a[3]); }
              { const f32x4 a = acc[2 * m + 1]; wv[2 * m + 1].x = pkbf(a[0] * bflo(gb2.x), a[1] * bfhi(gb2.x)); wv[2 * m + 1].y = pkbf(a[2] * bflo(gb2.y), a[3] * bfhi(gb2.y)); ss[2 * m + 1] = (a[0] * a[0] + a[1] * a[1]) + (a[2] * a[2] + a[3] * a[3]); } }
#pragma unroll
          for (int m = 0; m < 2; ++m) { const v2u mine = odd ? wv[2 * m + 1] : wv[2 * m], snd = odd ? wv[2 * m] : wv[2 * m + 1]; v2u rcv;
              rcv.x = (unsigned)__shfl_xor((int)snd.x, 16); rcv.y = (unsigned)__shfl_xor((int)snd.y, 16);
              v4u o4; o4.x = odd ? rcv.x : mine.x; o4.y = odd ? rcv.y : mine.y; o4.z = odd ? mine.x : rcv.x; o4.w = odd ? mine.y : rcv.y;
              *(GAS v4u*)(ZBp + (size_t)(r0 + 16 * (2 * m + (quad & 1)) + r16) * D + h * 512 + vcol0 + 4 * (quad & 2)) = o4; }
#pragma unroll
          for (int ti = 0; ti < 4; ++ti) ss[ti] += __shfl_xor(ss[ti], 16);
#pragma unroll
          for (int ti = 0; ti < 4; ++ti) ss[ti] += __shfl_xor(ss[ti], 32);
          { const float sq = quad == 0 ? ss[0] : quad == 1 ? ss[1] : quad == 2 ? ss[2] : ss[3];
            atomicAdd(RSO + (size_t)h * M + r0 + 16 * quad + r16, (unsigned long long)(sq * 16777216.0f)); } }
        __builtin_amdgcn_sched_barrier(0);
#pragma unroll
        for (int p = 0; p < 8; ++p) {
            if (p + 1 < 8) SCAN_LD3(p + 1, (p + 1) & 1)
            __builtin_amdgcn_sched_barrier(0);
            S[2 * p] = S[2 * p] * gb[p & 1][0]; S[2 * p + 1] = S[2 * p + 1] * gb[p & 1][1];
#pragma unroll
            for (int ks = 0; ks < 2; ++ks)
#pragma unroll
                for (int e = 0; e < 2; ++e) S[2 * p + e] = __builtin_amdgcn_mfma_f32_16x16x32_bf16(kb[p & 1][e][ks], vcur[ks], S[2 * p + e], 0, 0, 0);
            __builtin_amdgcn_sched_barrier(0);
        }
#undef SCAN_LD3
    };
#pragma unroll 1
    for (int c2 = 0; c2 < 32; c2 += 2) { chunk(c2, vf, vn, gq, gqn); chunk(c2 + 1, vn, vf, gqn, gq); }
    __builtin_amdgcn_s_setprio(0);
    { float* dst = outp() + O_GLAP + ((size_t)((l * 4 + b) * 4 + h) * 256) * 512 + vcol0 + r16;
#pragma unroll
        for (int i = 0; i < 16; ++i)
#pragma unroll
            for (int j = 0; j < 4; ++j) dst[(size_t)(16 * i + 4 * quad + j) * 512] = S[i][j]; }
    __syncthreads();
}
constexpr int CW_Q0 = 8192;
__device__ __forceinline__ void p_gla_sample(Frame& F0, int l, int rep) {
    Frame F = F0; asm volatile("" : "+v"(F.tid), "+v"(F.lane));
    const bf16* P = (const bf16*)(wsp() + WS_P); const float* LR = (const float*)(wsp() + WS_LR);
    LAS float* QK = (LAS float*)F.lds;
    LAS float* QH = (LAS float*)(F.lds + 20480);
    LAS float* KH = (LAS float*)(F.lds + 28672);
    LAS float* VS = (LAS float*)(F.lds + 36864);
    LAS float* AS = (LAS float*)(F.lds + 53248);
    LAS float* LRs = (LAS float*)(F.lds + 53504);
    LAS float* TOT = (LAS float*)(F.lds + 54016);
    LAS int* QW = (LAS int*)(F.lds + 56064);
    LAS float* OR = (LAS float*)(F.lds + 57344);
    unsigned* qhead = (unsigned*)(wsp() + WS_CTL) + CW_Q0 + 64 * (l + 4 * rep);
    const int k = F.tid & 255, half = F.tid >> 8;
    for (;;) {
        if (F.tid == 0) QW[0] = (int)__hip_atomic_fetch_add(qhead, 1u, __ATOMIC_RELAXED, __HIP_MEMORY_SCOPE_AGENT);
        __syncthreads();
        const int unit = QW[0];
        if (unit >= 1024) break;
        const int sb = unit >> 3, h = (unit >> 1) & 3, vh = unit & 1, r0 = MP + sb * 8;
        f32x4 lrv = {0.f, 0.f, 0.f, 0.f}; if (F.tid < 32) lrv = *(const GAS f32x4*)(LR + (size_t)r0 * 16 + 4 * F.tid);
        bf16 vraw[4], qraw[4], kraw[4];
#pragma unroll
        for (int i = 0; i < 4; ++i) { const int e = i * 512 + F.tid; vraw[i] = P[(size_t)(r0 + (e >> 8)) * PW + C_V + h * 512 + vh * 256 + (e & 255)];
            qraw[i] = P[(size_t)(r0 + half * 4 + i) * PW + C_Q + h * 256 + k]; kraw[i] = P[(size_t)(r0 + half * 4 + i) * PW + C_K + h * 256 + k]; }
        float w2[16]; const float bias = inp(I_BA)[l * 1024 + h * 256 + k];
        { const float* w2p = inp(I_WA2) + (size_t)l * 16 * 1024 + h * 256 + k;
#pragma unroll
          for (int j = 0; j < 16; ++j) w2[j] = w2p[j * 1024]; }
        if (F.tid < 32) *(LAS f32x4*)(LRs + 4 * F.tid) = lrv;
#pragma unroll
        for (int i = 0; i < 4; ++i) VS[i * 512 + F.tid] = bf1(vraw[i]);
        __syncthreads();
        float bc[4]; float run = 0.f;
#pragma unroll
        for (int i = 0; i < 4; ++i) { const LAS f32x4* lr4 = (const LAS f32x4*)(LRs + (half * 4 + i) * 16); float a = bias;
#pragma unroll
            for (int j4 = 0; j4 < 4; ++j4) { const f32x4 x = lr4[j4]; a += x[0] * w2[4 * j4] + x[1] * w2[4 * j4 + 1] + x[2] * w2[4 * j4 + 2] + x[3] * w2[4 * j4 + 3]; }
            run += logsig16(a); bc[i] = run; }
        TOT[half * 256 + k] = run;
        __syncthreads();
        const float lo_tot = TOT[k], blast = lo_tot + TOT[256 + k], boff = half ? lo_tot : 0.f;
        if (half == 0) QK[k * 20 + 16] = fexp(blast);
#pragma unroll
        for (int i = 0; i < 4; ++i) { const int t = half * 4 + i; const float bt = bc[i] + boff;
            const float qv = bf1(qraw[i]) * 0.0625f * fexp(bt), kv = bf1(kraw[i]);
            QK[k * 20 + t] = qv; QK[k * 20 + 8 + t] = kv * fexp(blast - bt); QH[t * 256 + k] = qv; KH[t * 256 + k] = kv * fexp(-bt); }
        __syncthreads();
        { const int e = F.tid >> 3, part = F.tid & 7, t = e >> 3, sq = e & 7; float a = 0.f;
#pragma unroll
          for (int i = 0; i < 32; ++i) a += QH[t * 256 + part * 32 + i] * KH[sq * 256 + part * 32 + i];
          a += __shfl_xor(a, 1); a += __shfl_xor(a, 2); a += __shfl_xor(a, 4);
          if (part == 0) AS[e] = (sq <= t) ? a : 0.f; }
        const int vq4 = F.tid & 63, kr = F.tid >> 6;
        f32x4 vv[8], oa[8];
#pragma unroll
        for (int t = 0; t < 8; ++t) { vv[t] = *(const LAS f32x4*)(VS + t * 256 + 4 * vq4); oa[t] = (f32x4){0.f, 0.f, 0.f, 0.f}; }
        const float* s0p = inp(I_SGLA) + ((size_t)((l * 128 + sb) * 4 + h) * 256 + kr) * 512 + vh * 256 + 4 * vq4;
        float* s1p = outp() + O_GLAS + ((size_t)((l * 128 + sb) * 4 + h) * 256 + kr) * 512 + vh * 256 + 4 * vq4;
        f32x4 cur[8], nxt[8];
#pragma unroll
        for (int u = 0; u < 8; ++u) cur[u] = __builtin_nontemporal_load((const f32x4*)(s0p + (size_t)(8 * u) * 512));
        for (int g = 0; g < 4; ++g) {
            if (g < 3) {
#pragma unroll
                for (int u = 0; u < 8; ++u) nxt[u] = __builtin_nontemporal_load((const f32x4*)(s0p + (size_t)(8 * (8 * (g + 1) + u)) * 512)); }
#pragma unroll
            for (int u = 0; u < 8; ++u) { const int kk = 8 * (8 * g + u) + kr; const f32x4 s0 = cur[u];
                const LAS f32x4* q4 = (const LAS f32x4*)(QK + kk * 20); const f32x4 qa = q4[0], qb = q4[1], ka = q4[2], kb = q4[3]; const float gm = QK[kk * 20 + 16];
                f32x4 sn = s0 * gm;
#pragma unroll
                for (int t = 0; t < 4; ++t) { oa[t] += s0 * qa[t]; oa[4 + t] += s0 * qb[t]; sn += vv[t] * ka[t]; sn += vv[4 + t] * kb[t]; }
                __builtin_nontemporal_store(sn, (f32x4*)(s1p + (size_t)(8 * (8 * g + u)) * 512)); }
#pragma unroll
            for (int u = 0; u < 8; ++u) cur[u] = nxt[u];
        }
#pragma unroll
        for (int t = 0; t < 8; ++t) *(LAS f32x4*)(OR + (kr * 8 + t) * 256 + 4 * vq4) = oa[t];
        __syncthreads();
#pragma unroll
        for (int i = 0; i < 4; ++i) { const int e = i * 512 + F.tid, t = e >> 8, vc = e & 255; float o = 0.f;
#pragma unroll
            for (int q = 0; q < 8; ++q) o += OR[(q * 8 + t) * 256 + vc];
#pragma unroll
            for (int sq = 0; sq < 8; ++sq) o += AS[t * 8 + sq] * VS[sq * 256 + vc];
            const float sg = bf1(P[(size_t)(r0 + t) * PW + C_GG + h * 512 + vh * 256 + vc]);
            ((bf16*)(wsp() + WS_ZB))[(size_t)(r0 + t) * D + h * 512 + vh * 256 + vc] = bf1r(o * sg);
            const float ss = wave_sum(o * o);
            if (F.lane == 0) atomicAdd((unsigned long long*)(wsp() + WS_RSO) + ((size_t)l * 4 + h) * M + r0 + t, (unsigned long long)(ss * 16777216.0f)); }
        __syncthreads();
    }
}
constexpr size_t WS_FIX = 1147 * MiB;
__device__ __forceinline__ void p_convfix(Frame& F0, int l) {
    Frame F = F0; asm volatile("" : "+v"(F.tid), "+v"(F.lane));
    const float* FX = (const float*)(wsp() + WS_FIX); bf16* ZA = (bf16*)(wsp() + WS_ZA); const float* cw = inp(I_CONVW) + (size_t)l * 3 * D;
    for (int it = F.vcu * 512 + F.tid; it < 128 * 2048; it += F.G * 512) { const int blk = it >> 11, ch = it & 2047;
        if ((blk & 31) == 0) continue;
        const float c0 = FX[(size_t)(blk * 2) * 2048 + ch], c1 = FX[(size_t)(blk * 2 + 1) * 2048 + ch];
        const float h0 = FX[524288 + (size_t)(blk * 2) * 2048 + ch], h1 = FX[524288 + (size_t)(blk * 2 + 1) * 2048 + ch];
        const float t0 = FX[1048576 + (size_t)((blk - 1) * 2) * 2048 + ch], t1 = FX[1048576 + (size_t)((blk - 1) * 2 + 1) * 2048 + ch];
        const float w0 = cw[ch], w1 = cw[D + ch], w2 = cw[2 * D + ch];
        ZA[(size_t)(blk * 64) * D + ch] = bf1r(c0 * (w0 * t0 + w1 * t1 + w2 * h0));
        ZA[(size_t)(blk * 64 + 1) * D + ch] = bf1r(c1 * (w0 * t1 + w1 * h0 + w2 * h1)); }
}
__device__ __forceinline__ void rt_row(LAS float* RT, const unsigned long long* RSO, int row) {
    const GAS unsigned long long* p = (const GAS unsigned long long*)(RSO + row);
    const float q0 = (float)p[0] * (1.f / 16777216.f), q1 = (float)p[M] * (1.f / 16777216.f), q2 = (float)p[2 * M] * (1.f / 16777216.f), q3 = (float)p[3 * M] * (1.f / 16777216.f);
    const float s0 = 1.f / sqrtf(q0 * (1.f / 512.f) + EPS), s1 = 1.f / sqrtf(q1 * (1.f / 512.f) + EPS), s2 = 1.f / sqrtf(q2 * (1.f / 512.f) + EPS), s3 = 1.f / sqrtf(q3 * (1.f / 512.f) + EPS);
    *(LAS f32x4*)(RT + (row & 255) * 8) = (f32x4){s0 / s1, s1 / s2, s2 / s3, s3}; *(LAS f32x4*)(RT + (row & 255) * 8 + 4) = (f32x4){1.f / s0, 0.f, 0.f, 0.f};
}
struct Args { const float* in[14]; float* out; unsigned char* ws; int ph_lo, ph_hi; };
constexpr int N_PHASES = 2 + 5 * DEPTH;
__global__ void __launch_bounds__(NWAVES * 64, 2) fwd(Args args) {
    extern __shared__ __attribute__((aligned(16))) unsigned char lds[];
    Frame F;
    F.lds = (LAS unsigned char*)lds;
    F.tid = threadIdx.x; F.lane = F.tid & 63; F.wave = __builtin_amdgcn_readfirstlane(F.tid >> 6);
    F.G = gridDim.x; { const int bx = blockIdx.x; F.vcu = (F.G % 8 == 0) ? (bx % 8) * (F.G / 8) + bx / 8 : bx; }
    volatile LAS unsigned* MISC = (volatile LAS unsigned*)(F.lds + MISC_OFF);
    for (int u = F.tid; u < (LDS_BYTES - LDSCTL_OFF) / 4; u += NWAVES * 64) ((LAS unsigned*)(F.lds + LDSCTL_OFF))[u] = 0u;
    __syncthreads();
    const int lo = args.ph_lo, hi = args.ph_hi;
    XcdBarrier bar; bar.bar = (unsigned*)(wsp() + WS_CTL) + CW_BAR; bar.x = 0; bar.st = nullptr;
    if (hi - lo > 1) bar = xcd_barrier_post((unsigned*)(wsp() + WS_CTL) + CW_BAR, MISC + 8);
#define IN(k) (lo <= (k) && (k) < hi)
#define SEAM(k) do { if (IN(k) && IN((k) + 1)) xcd_barrier(bar); } while (0)

    #ifndef NO_P0
    if (IN(0)) { for (int rep = 0; rep < REP_PRO; ++rep) p_prologue(F); p_xprep(F, 0); }
#endif
    SEAM(0);
#pragma unroll 1
    for (int l = 0; l < DEPTH; ++l) {
        const int pb = 1 + 5 * l;
#ifndef NO_PROJ
        if (IN(pb)) {
            unsigned char* const ws = wsp(); bf16* XB = (bf16*)(ws + WS_XB); bf16* P = (bf16*)(ws + WS_P); float* LR = (float*)(ws + WS_LR); const unsigned long long* RS = (const unsigned long long*)(ws + WS_RSQ) + (size_t)l * M;
            const bf16* Wt = (const bf16*)(ws + WS_WIN + l * WIN_L);
            pg8::Gemm g{XB, Wt, M, PW, D}; pg8::ProjOrder S; S.init(F.G, (int)blockIdx.x);
            pg8::EpiProj E{P, LR, RS, (bf16*)(ws + WS_ZA), (float*)(ws + WS_FIX), inp(I_CONVW) + (size_t)l * 3 * D, inp(I_SCONV) + (size_t)l * 128 * 2 * D, outp() + O_CONVP + (size_t)l * 4 * 2 * D, outp() + O_CONVS + (size_t)l * 128 * 2 * D};
            for (int rep = 0; rep < REP_PROJ; ++rep) {
            pg8::gemm_phase<pg8::EpiProj, pg8::ProjOrder, true, true>(F.lds + RING_OFF, g, S, E);
            if (F.G == 256) {
                const int c = (int)blockIdx.x;
                pg8::mini_gemm(F.lds + RING_OFF, XB, Wt, D, MP + (c >> 5) * 128, C_GG + (c & 31) * 64, E);
                const int lrt = c < 64 ? c : (c >= 192 && c < 200 ? c - 128 : -1);
                if (lrt >= 0) pg8::mini_gemm(F.lds + RING_OFF, XB, Wt, D, lrt * 128, PW, E);
            } else
            for (int su = (int)blockIdx.x; su < 256 + M / 128; su += F.G) {
                if (su < 256) pg8::mini_gemm(F.lds + RING_OFF, XB, Wt, D, MP + (su >> 5) * 128, C_GG + (su & 31) * 64, E); else pg8::mini_gemm(F.lds + RING_OFF, XB, Wt, D, (su - 256) * 128, PW, E); }
            }
        }
#endif
        SEAM(pb);
        if (IN(pb + 1)) {
#ifndef NO_CONV
            for (int rep = 0; rep < REP_PREP; ++rep) p_convfix(F, l);
#endif
#ifndef NO_GLA
            for (int rep = 0; rep < REP_PREP; ++rep) p_gla_prep(F, l);
#endif
        } SEAM(pb + 1);
        if (IN(pb + 2)) {
#ifndef NO_GLA
            for (int rep = 0; rep < REP_SCAN; ++rep) { p_gla_scan(F, l); p_gla_sample(F, l, rep); }
#endif
        } SEAM(pb + 2);
#ifndef NO_BR
        if (IN(pb + 3)) {
            unsigned char* const ws = wsp(); bf16* P = (bf16*)(ws + WS_P); bf16* ZA = (bf16*)(ws + WS_ZA); bf16* ZB = (bf16*)(ws + WS_ZB); bf16* MG = (bf16*)(ws + WS_MG);
            const bf16* WtA = (const bf16*)(ws + WS_WA + l * W_L); const bf16* WtB = (const bf16*)(ws + WS_WB + l * W_L);
            LAS float* RT = (LAS float*)(F.lds + RT_OFF); const unsigned long long* RSO = (const unsigned long long*)(ws + WS_RSO) + (size_t)l * M * 4;
            pg8::StaticOrder S; S.init(MP, D, F.G, (int)blockIdx.x);
            pg8::EpiBrA2 EA{P + C_GA, P + C_GB, RT}; pg8::EpiBrB2 EB{P + C_GB, MG, RT};
            { pg8::Unit u0; if (S.next(0, u0) && F.tid < 256) rt_row(RT, RSO, u0.pm * 256 + F.tid); __syncthreads(); }
            { pg8::Gemm g{ZA, WtA, MP, D, D, ZB, WtB}; pg8::PairOrder S2; S2.init(MP, D, F.G, (int)blockIdx.x); pg8::EpiBr EE{EA, EB};
              pg8::gemm_phase<pg8::EpiBr, pg8::PairOrder, true, true>(F.lds + RING_OFF, g, S2, EE); }
            for (int su = (int)blockIdx.x; su < 256; su += F.G) { __syncthreads(); if (F.tid < 128) rt_row(RT, RSO, MP + (su >> 5) * 128 + F.tid); __syncthreads();
                f32x4 a2[2][2];
                pg8::mini_gemm_acc<pg8::EpiBrA2, true>(F.lds + RING_OFF, ZA, WtA, D, MP + (su >> 5) * 128, (su & 31) * 64, EA, a2);
                pg8::mini_gemm_acc<pg8::EpiBrB2, false>(F.lds + RING_OFF, ZB, WtB, D, MP + (su >> 5) * 128, (su & 31) * 64, EB, a2); }
        }
#endif
        SEAM(pb + 3);
#ifndef NO_OUT
        if (IN(pb + 4)) {
            unsigned char* const ws = wsp(); bf16* MG = (bf16*)(ws + WS_MG);
            const bf16* Wt = (const bf16*)(ws + WS_WO + l * W_L); pg8::Gemm g{MG, Wt, MP, D, D}; pg8::StaticOrder S; S.init(MP, D, F.G, (int)blockIdx.x);
            for (int rep = 0; rep < REP_OUT; ++rep) {
            LAS unsigned long long* rowsum = (LAS unsigned long long*)(F.lds + ROWSUM_OFF); unsigned long long* RSQn = (unsigned long long*)(ws + WS_RSQ) + (size_t)(rep > 0 ? DEPTH + 1 : l + 1) * M;
            if (F.tid < 256) rowsum[F.tid] = 0ull;
            __syncthreads();
            pg8::EpiOut E{(bf16*)(ws + (rep > 0 ? WS_ZA : WS_XB)), rowsum};
            pg8::gemm_phase<pg8::EpiOut, pg8::StaticOrder, true, true>(F.lds + RING_OFF, g, S, E);
            { pg8::Unit u0; const bool has = S.next(0, u0); asm volatile("s_waitcnt lgkmcnt(0)" ::: "memory"); __syncthreads();
              if (has && F.tid < 256) { atomicAdd(RSQn + u0.pm * 256 + F.tid, rowsum[F.tid]); rowsum[F.tid] = 0ull; } __syncthreads(); }
            for (int su = (int)blockIdx.x; su < 256; su += F.G) { pg8::mini_gemm(F.lds + RING_OFF, MG, Wt, D, MP + (su >> 5) * 128, (su & 31) * 64, E);
                asm volatile("s_waitcnt lgkmcnt(0)" ::: "memory"); __syncthreads();
                if (F.tid < 128) { const int row = MP + (su >> 5) * 128 + F.tid; atomicAdd(RSQn + row, rowsum[row & 255]); rowsum[row & 255] = 0ull; } __syncthreads(); }
            }
        }
#endif
        SEAM(pb + 4);
    }
    if (IN(1 + 5 * DEPTH)) p_final(F);
#undef IN
#undef SEAM
}

#ifndef MK_SINGLE
#define MK_SINGLE 1
#endif
extern "C" void kernel_launch(void* const* d_in, const int* in_sizes, int n_in, void* d_out, int out_size, void* d_ws, size_t ws_size, hipStream_t stream) {
    static int grid = 0;
    if (grid == 0) {
        if (n_in != 14 || (size_t)out_size != O_END || ws_size < WS_FIX + 6 * MiB) { fprintf(stderr, "kernel_launch: unexpected shapes (n_in %d out %d ws %zu)\n", n_in, out_size, ws_size); grid = -1; return; }
        int dev = 0, cus = 0, per_cu = 0;
        if (hipGetDevice(&dev) != hipSuccess || hipDeviceGetAttribute(&cus, hipDeviceAttributeMultiprocessorCount, dev) != hipSuccess) { grid = -1; return; }
        if (hipFuncSetAttribute((const void*)fwd, hipFuncAttributeMaxDynamicSharedMemorySize, LDS_BYTES) != hipSuccess) { fprintf(stderr, "kernel_launch: hipFuncSetAttribute failed\n"); grid = -1; return; }
        if (hipOccupancyMaxActiveBlocksPerMultiprocessor(&per_cu, (const void*)fwd, NWAVES * 64, LDS_BYTES) != hipSuccess || per_cu < 1) fprintf(stderr, "kernel_launch: occupancy query reports %d\n", per_cu);
        (void)hipGetLastError();
        grid = cus;
    }
    if (grid < 0) return;
    if (hipMemsetAsync((char*)d_ws + WS_CTL, 0, CTL_ZERO_BYTES, stream) != hipSuccess) return;
    Args a{};
    for (int i = 0; i < 14; ++i) a.in[i] = (const float*)d_in[i];
    a.out = (float*)d_out; a.ws = (unsigned char*)d_ws;
#if MK_SINGLE
    a.ph_lo = 0; a.ph_hi = N_PHASES;
    hipLaunchKernelGGL(fwd, dim3(grid), dim3(NWAVES * 64), LDS_BYTES, stream, a);
#else
    for (int p = 0; p < N_PHASES; ++p) { a.ph_lo = p; a.ph_hi = p + 1; hipLaunchKernelGGL(fwd, dim3(grid), dim3(NWAVES * 64), LDS_BYTES, stream, a); }
#endif
}
```

```cpp
#include <hip/hip_runtime.h>
#include <cstdio>
#include <cstdint>
#define REP_PROJ 1
#define REP_PREP 1
#define REP_SCAN 1
#define REP_ZB 1
#define REP_BR 1
#define REP_XN 1
#define REP_PRO 1
#define REP_MINI 1
#define REP_OUT 1
namespace pg8 {
#define PG8_LAS __attribute__((address_space(3)))
typedef unsigned short bf16_t;
typedef short bf16x8 __attribute__((ext_vector_type(8)));
typedef float f32x4 __attribute__((ext_vector_type(4)));
typedef unsigned u32x4 __attribute__((ext_vector_type(4)));
constexpr int BM = 256, BK = 64, HALF = 128, HTB = HALF * BK * 2  , STAGE_BYTES = 8 * HTB, NXCD = 8, WGM = 8;

__host__ __device__ __forceinline__ int lds_byte(int r, int c) { const int st = (r >> 4) * 2 + (c >> 5), rr = r & 15, cc = c & 31, ob = rr * 64 + cc * 2; return st * 1024 + (ob ^ (((ob >> 9) & 1) << 5)); }
__host__ __device__ __forceinline__ void stage_rc(int b, int& R, int& C) { const int st = b / 1024, sb = b % 1024, swz = sb ^ (((sb >> 9) & 1) << 5); R = (st >> 1) * 16 + swz / 64; C = (st & 1) * 32 + (swz % 64) / 2; }
__host__ __device__ __forceinline__ int perm32(int rho) { const int n = rho >> 4, i = rho & 15; return 8 * (i >> 2) + 4 * n + (i & 3); }

struct Unit { int pm, pn, sel; };
struct Gemm { const bf16_t* A; const bf16_t* Bt; int M, N, K; const bf16_t* A2; const bf16_t* Bt2; };

struct StaticOrder {
    int nM, nN, nwg, G, c;
    __host__ __device__ void init(int M, int N, int G_, int c_) { nM = M / BM; nN = N / BM; nwg = nM * nN; G = G_; c = c_; }
    __host__ __device__ bool next(int i, Unit& u) const {
        const long L = (long)i * G + c; if (L >= nwg) return false;
        int wgid = (int)L; { const int q = nwg / NXCD, r = nwg % NXCD, xcd = wgid % NXCD, off = wgid / NXCD; wgid = (xcd < r ? xcd * (q + 1) : r * (q + 1) + (xcd - r) * q) + off; }
        const int nig = WGM * nN, gid = wgid / nig, fm = gid * WGM, gsz = (nM - fm) < WGM ? (nM - fm) : WGM;
        u.pm = fm + ((wgid % nig) % gsz); u.pn = (wgid % nig) / gsz; u.sel = 0; return true;
    }
    __device__ __forceinline__ void a_ready(const Unit&) const {}
    __device__ __forceinline__ void done(const Unit&) const {}
};
__device__ __forceinline__ unsigned cvt_pk_bf16(float lo, float hi) { unsigned r; asm volatile("v_cvt_pk_bf16_f32 %0, %1, %2" : "=v"(r) : "v"(lo), "v"(hi)); return r; }
constexpr int PW = 18432;
__device__ __forceinline__ float sigm(float x) { return __builtin_amdgcn_rcpf(1.0f + __builtin_amdgcn_exp2f(-1.44269504f * x)); }
__device__ __forceinline__ float bflo(unsigned w) { return __uint_as_float(w << 16); }
__device__ __forceinline__ float bfhi(unsigned w) { return __uint_as_float(w & 0xffff0000u); }
__device__ __forceinline__ u32x4 pack8(const f32x4 v0, const f32x4 v1) { u32x4 w; w.x = cvt_pk_bf16(v0[0], v0[1]); w.y = cvt_pk_bf16(v0[2], v0[3]); w.z = cvt_pk_bf16(v1[0], v1[1]); w.w = cvt_pk_bf16(v1[2], v1[3]); return w; }
constexpr int PG8_RTAB_OFF = 150528;
struct EpiProj {
    static constexpr int DEPTH = 4; static constexpr bool MIDK = false, CONV = true, INPLACE = false, PAIR = false, RSTAB = true;
    bf16_t* P; float* LR; const unsigned long long* rsq;
    bf16_t* ZA; float* FIX; const float* convw; const float* sconv; float* ocp; float* ocs; mutable const PG8_LAS unsigned char* tab = nullptr;
    static __device__ __forceinline__ f32x4 ror(const f32x4 x, int n) { f32x4 y;
#pragma unroll
        for (int j = 0; j < 4; ++j) y[j] = __int_as_float(n == 1 ? __builtin_amdgcn_update_dpp(0, __float_as_int(x[j]), 0x121, 0xf, 0xf, false) : __builtin_amdgcn_update_dpp(0, __float_as_int(x[j]), 0x122, 0xf, 0xf, false)); return y; }
    __device__ __forceinline__ void conv_unit(const f32x4 (&acc)[2][2][4][2], const Unit& u, int wr, int wc, int fr, int fq) const {
        const int ch0 = 64 * (u.pn - 16) + 16 * wc + 4 * fq; const bool sample = u.pm >= 32;
        const PG8_LAS float* wt = (const PG8_LAS float*)(tab + 2048) + 16 * wc + 4 * fq;
        const f32x4 w0 = *(const PG8_LAS f32x4*)wt, w1 = *(const PG8_LAS f32x4*)(wt + 64), w2 = *(const PG8_LAS f32x4*)(wt + 128);
        unsigned long long rq[2][4];
#pragma unroll
        for (int ai = 0; ai < 2; ++ai)
#pragma unroll
            for (int m = 0; m < 4; ++m) rq[ai][m] = *(const PG8_LAS unsigned long long*)(tab + (ai * HALF + wr * 64 + m * 16 + fr) * 8);
#pragma unroll
        for (int ai = 0; ai < 2; ++ai) { const int br0 = u.pm * BM + ai * HALF + wr * 64, blk = br0 >> 6; const bool seqstart = (br0 & 2047) == 0, seqend = ((br0 + 64) & 2047) == 0;
            f32x4 uprev = {0.f, 0.f, 0.f, 0.f};
#pragma unroll
            for (int m = 0; m < 4; ++m) { const int r = br0 + m * 16 + fr;
                const float rstd = __builtin_amdgcn_rsqf((float)rq[ai][m] * (1.0f / 16777216.0f) * (1.0f / 2048.0f) + 1e-6f);
                const f32x4 cB = acc[ai][0][m][0] * rstd, cC = acc[ai][0][m][1] * rstd, cx = acc[ai][1][m][0] * rstd; f32x4 cg = acc[ai][1][m][1] * rstd;
#pragma unroll
                for (int j = 0; j < 4; ++j) cg[j] = cg[j] * sigm(cg[j]);
                const f32x4 uu = cC * cx, cbg = cB * cg, t1 = ror(uu, 1), t2 = ror(uu, 2);
                f32x4 u1, u2;
                if (!sample) { const f32x4 p1 = ror(uprev, 1), p2 = ror(uprev, 2);
#pragma unroll
                    for (int j = 0; j < 4; ++j) { u1[j] = fr >= 1 ? t1[j] : p1[j]; u2[j] = fr >= 2 ? t2[j] : p2[j]; }
                } else { const int t = fr & 7, sb = (r - 8192) >> 3; const f32x4 b0 = *(const f32x4*)(sconv + (size_t)sb * 4096 + ch0), b1 = *(const f32x4*)(sconv + (size_t)sb * 4096 + 2048 + ch0);
#pragma unroll
                    for (int j = 0; j < 4; ++j) { u1[j] = t >= 1 ? t1[j] : b1[j]; u2[j] = t >= 2 ? t2[j] : (t == 1 ? b1[j] : b0[j]); }
                    if (t >= 6) *(f32x4*)(ocs + (size_t)sb * 4096 + (t - 6) * 2048 + ch0) = uu; }
                const f32x4 z = cbg * (w0 * u2 + w1 * u1 + w2 * uu);
                if (!sample && m == 0 && fr < 2 && !seqstart) {
                    *(f32x4*)(FIX + ((size_t)(blk * 2 + fr)) * 2048 + ch0) = cbg; *(f32x4*)(FIX + (size_t)524288 + ((size_t)(blk * 2 + fr)) * 2048 + ch0) = uu;
                } else { typedef unsigned u32x2 __attribute__((ext_vector_type(2))); u32x2 w; w.x = cvt_pk_bf16(z[0], z[1]); w.y = cvt_pk_bf16(z[2], z[3]); *(u32x2*)(ZA + (size_t)r * 2048 + ch0) = w; }
                if (!sample && m == 3 && fr >= 14) { *(f32x4*)(FIX + (size_t)1048576 + ((size_t)(blk * 2 + fr - 14)) * 2048 + ch0) = uu;
                    if (seqend) *(f32x4*)(ocp + ((size_t)(br0 >> 11) * 2 + (fr - 14)) * 2048 + ch0) = uu; }
                uprev = uu; } }
    }
    struct Pre { float rs; };
    __device__ __forceinline__ Pre pre(int r, int) const { Pre p; p.rs = (float)rsq[r] * (1.0f / 16777216.0f); return p; }
    __device__ __forceinline__ Pre pre_t(int r) const { Pre p; p.rs = (float)(*(const PG8_LAS unsigned long long*)(tab + (r & 255) * 8)) * (1.0f / 16777216.0f); return p; }
    __device__ __forceinline__ void tab_stage(PG8_LAS unsigned char* lds, const Unit& u, int slot, int wid, int lane) const {
        PG8_LAS unsigned char* t = lds + PG8_RTAB_OFF + slot * 3072;
        if (wid < 2) __builtin_amdgcn_global_load_lds((const unsigned*)((const char*)rsq + ((size_t)u.pm * 256 + wid * 128) * 8 + lane * 16), (PG8_LAS unsigned*)(t + wid * 1024), 16, 0, 0);
        else if (wid == 2) { const int pc = (u.pn >= 16 && u.pn < 48) ? u.pn - 16 : 0, L = lane < 48 ? lane : 47;
            __builtin_amdgcn_global_load_lds((const unsigned*)((const char*)convw + ((size_t)(L >> 4) * 2048 + 64 * pc + 4 * (L & 15)) * 4), (PG8_LAS unsigned*)(t + 2048), 16, 0, 0); }
    }
    __device__ __forceinline__ void tab_set(PG8_LAS unsigned char* lds, int slot) const { tab = lds + PG8_RTAB_OFF + slot * 3072; }
    __device__ __forceinline__ void fin(int r, int c, f32x4 v0, f32x4 v1, const Pre& p) const {
        const int t = c >> 8; const float rstd = __builtin_amdgcn_rsqf(p.rs * (1.0f / 2048.0f) + 1e-6f); v0 = v0 * rstd; v1 = v1 * rstd;
        if (t >= 72) { const int cc = c - 72 * 256; if (cc < 16) { *(f32x4*)(LR + (size_t)r * 16 + cc) = v0; *(f32x4*)(LR + (size_t)r * 16 + cc + 4) = v1; } return; }
        const int mode = (t < 16) ? 1 : (((t >= 40 && t < 48) || t >= 64) ? 2 : 0);
        if (mode == 1) {
#pragma unroll
            for (int j = 0; j < 4; ++j) { v0[j] = sigm(v0[j]); v1[j] = sigm(v1[j]); } }
        if (mode == 2) {
#pragma unroll
            for (int j = 0; j < 4; ++j) { v0[j] = v0[j] * sigm(v0[j]); v1[j] = v1[j] * sigm(v1[j]); } }
        *(u32x4*)(P + (size_t)r * PW + c) = pack8(v0, v1);
    }
};
struct EpiBrA2 {
    static constexpr int DEPTH = 4; static constexpr bool MIDK = false, CONV = false, INPLACE = true, PAIR = false, RSTAB = false;
    const bf16_t* GA; const bf16_t* GB; const PG8_LAS float* RT;
    struct Pre { u32x4 a, b; };
    __device__ __forceinline__ Pre pre(int r, int c) const { Pre p; p.a = *(const u32x4*)(GA + (size_t)r * PW + c); p.b = *(const u32x4*)(GB + (size_t)r * PW + c); return p; }
    static __device__ __forceinline__ float fac(float ga, float gb, float i0) { return ga * __builtin_amdgcn_rcpf(fmaxf(gb, 1e-30f)) * i0; }
    __device__ __forceinline__ void fin_ip(int r, int, f32x4& v0, f32x4& v1, const Pre& p) const {
        const float i0 = RT[(r & 255) * 8 + 4];
        v0[0] *= fac(bflo(p.a.x), bflo(p.b.x), i0); v0[1] *= fac(bfhi(p.a.x), bfhi(p.b.x), i0); v0[2] *= fac(bflo(p.a.y), bflo(p.b.y), i0); v0[3] *= fac(bfhi(p.a.y), bfhi(p.b.y), i0);
        v1[0] *= fac(bflo(p.a.z), bflo(p.b.z), i0); v1[1] *= fac(bfhi(p.a.z), bfhi(p.b.z), i0); v1[2] *= fac(bflo(p.a.w), bflo(p.b.w), i0); v1[3] *= fac(bfhi(p.a.w), bfhi(p.b.w), i0);
    }
};
struct EpiBrB2 {
    static constexpr int DEPTH = 8; static constexpr bool MIDK = true, CONV = false, INPLACE = false, PAIR = false, RSTAB = false;
    const bf16_t* GB; bf16_t* MG; const PG8_LAS float* RT;
    struct Pre { u32x4 g; };
    __device__ __forceinline__ Pre pre(int r, int c) const { Pre p; p.g = *(const u32x4*)(GB + (size_t)r * PW + c); return p; }
    __device__ __forceinline__ void fin(int r, int c, f32x4 v0, f32x4 v1, const Pre& p) const {
        const float s3 = RT[(r & 255) * 8 + 3];
        v0[0] *= s3 * fmaxf(bflo(p.g.x), 1e-30f); v0[1] *= s3 * fmaxf(bfhi(p.g.x), 1e-30f); v0[2] *= s3 * fmaxf(bflo(p.g.y), 1e-30f); v0[3] *= s3 * fmaxf(bfhi(p.g.y), 1e-30f);
        v1[0] *= s3 * fmaxf(bflo(p.g.z), 1e-30f); v1[1] *= s3 * fmaxf(bfhi(p.g.z), 1e-30f); v1[2] *= s3 * fmaxf(bflo(p.g.w), 1e-30f); v1[3] *= s3 * fmaxf(bfhi(p.g.w), 1e-30f);
        *(u32x4*)(MG + (size_t)r * 2048 + c) = pack8(v0, v1);
    }
    __device__ __forceinline__ float ratio(int r, int seg) const { return RT[(r & 255) * 8 + seg]; }
};
struct EpiBr {
    static constexpr int DEPTH = 8; static constexpr bool MIDK = true, CONV = false, INPLACE = false, PAIR = true, RSTAB = false;
    EpiBrA2 a; EpiBrB2 b;
    __device__ __forceinline__ float ratio(int r, int seg) const { return b.ratio(r, seg); }
};
struct PairOrder {
    StaticOrder so;
    __device__ void init(int M, int N, int G_, int c_) { so.init(M, N, G_, c_); }
    __device__ bool next(int i, Unit& u) const { if (!so.next(i >> 1, u)) return false; u.sel = i & 1; return true; }
    __device__ __forceinline__ void a_ready(const Unit&) const {}
    __device__ __forceinline__ void done(const Unit&) const {}
};
struct EpiOut {
    static constexpr int DEPTH = 8; static constexpr bool MIDK = false, CONV = false, INPLACE = false, PAIR = false, RSTAB = false;
    bf16_t* XB; PG8_LAS unsigned long long* rowsum;
    struct Pre { u32x4 x; };
    __device__ __forceinline__ Pre pre(int r, int c) const { Pre p; p.x = *(const u32x4*)(XB + (size_t)r * 2048 + c); return p; }
    __device__ __forceinline__ void fin(int r, int c, f32x4 v0, f32x4 v1, const Pre& p) const {
        v0[0] += bflo(p.x.x); v0[1] += bfhi(p.x.x); v0[2] += bflo(p.x.y); v0[3] += bfhi(p.x.y); v1[0] += bflo(p.x.z); v1[1] += bfhi(p.x.z); v1[2] += bflo(p.x.w); v1[3] += bfhi(p.x.w);
        *(u32x4*)(XB + (size_t)r * 2048 + c) = pack8(v0, v1);
        const float ss = (v0[0] * v0[0] + v0[1] * v0[1]) + (v0[2] * v0[2] + v0[3] * v0[3]) + (v1[0] * v1[0] + v1[1] * v1[1]) + (v1[2] * v1[2] + v1[3] * v1[3]);
        (void)__hip_atomic_fetch_add(rowsum + (r & 255), (unsigned long long)(ss * 16777216.0f), __ATOMIC_RELAXED, __HIP_MEMORY_SCOPE_WORKGROUP);
    }
};
template <class Epi> __device__ __forceinline__ void epi_big(const Epi& E, f32x4 (&acc)[2][2][4][2], const Unit& u, int wr, int wc, int fr, int fq) {
    if constexpr (Epi::PAIR) { if (u.sel == 0) epi_big(E.a, acc, u, wr, wc, fr, fq); else epi_big(E.b, acc, u, wr, wc, fr, fq); return; } else {
    if constexpr (Epi::CONV) { if (u.pn >= 16 && u.pn < 48) { E.conv_unit(acc, u, wr, wc, fr, fq); return; } }
    const int row0 = u.pm * BM + wr * 64 + fr, col0 = u.pn * BM + wc * 32 + 8 * fq;
    constexpr int DP = Epi::DEPTH;
    typename Epi::Pre pq[DP];
#define EPI_R(i) (row0 + ((i) >> 3) * HALF + (((i) >> 1) & 3) * 16)
#define EPI_C(i) (col0 + ((i) & 1) * HALF)
#pragma unroll
    for (int i = 0; i < DP; ++i) { if constexpr (Epi::RSTAB) pq[i] = E.pre_t(EPI_R(i)); else pq[i] = E.pre(EPI_R(i), EPI_C(i)); }
#pragma unroll
    for (int idx = 0; idx < 16; ++idx) { const int ai = idx >> 3, m = (idx >> 1) & 3, bj = idx & 1;
        if constexpr (Epi::INPLACE) E.fin_ip(EPI_R(idx), EPI_C(idx), acc[ai][bj][m][0], acc[ai][bj][m][1], pq[idx % DP]); else E.fin(EPI_R(idx), EPI_C(idx), acc[ai][bj][m][0], acc[ai][bj][m][1], pq[idx % DP]);
        asm volatile("" ::: "memory");
        if (idx + DP < 16) { if constexpr (Epi::RSTAB) pq[idx % DP] = E.pre_t(EPI_R(idx + DP)); else pq[idx % DP] = E.pre(EPI_R(idx + DP), EPI_C(idx + DP)); } }
#undef EPI_R
#undef EPI_C
    }
}
#define PG8_GAS __attribute__((address_space(1)))
constexpr int MINI_SLOT = 24576;
template <class Epi, bool ZERO0> __device__ __forceinline__ void mini_gemm_acc(PG8_LAS unsigned char* lds, const bf16_t* A, const bf16_t* Bt, int K, int row0, int col0, const Epi& E, f32x4 (&acc)[2][2]) {
    int tid_ = threadIdx.x; asm volatile("" : "+v"(tid_));
    const int tid = tid_, wid = __builtin_amdgcn_readfirstlane(tid >> 6), lane = tid & 63, r16 = lane & 15, quad = lane >> 4, wrow = wid >> 1, wcol = wid & 1;
    const PG8_GAS char* src[3];
#pragma unroll
    for (int i = 0; i < 2; ++i) { const int q = 64 * (wid + 8 * i) + lane, row = q >> 3, p = (q & 7) ^ ((row >> 1) & 7); src[i] = (const PG8_GAS char*)(A + (size_t)(row0 + row) * K + 8 * p); }
    { const int q = 64 * wid + lane, row = q >> 3, p = (q & 7) ^ ((row >> 1) & 7); src[2] = (const PG8_GAS char*)(Bt + (size_t)(col0 + (row & ~31) + perm32(row & 31)) * K + 8 * p); }
    const int nkt = K / 64;
    const int dst0 = wid * 1024 + lane * 16, dst1 = (wid + 8) * 1024 + lane * 16, dst2 = (16 + wid) * 1024 + lane * 16;
    if constexpr (ZERO0) {
#pragma unroll
    for (int i = 0; i < 2; ++i)
#pragma unroll
        for (int j = 0; j < 2; ++j) acc[i][j] = (f32x4){0.f, 0.f, 0.f, 0.f};
    }
    int aoff[2], boff[2];
#pragma unroll
    for (int t = 0; t < 2; ++t) { const int ra = 32 * wrow + 16 * t + r16, rb = 32 * wcol + 16 * t + r16; aoff[t] = ra * 128; boff[t] = 16384 + rb * 128; }
    const int sw = (r16 >> 1) & 7;
    constexpr int PD = 4;
    u32x4 q[PD][3];
#pragma unroll
    for (int p = 0; p < PD; ++p)
#pragma unroll
        for (int i = 0; i < 3; ++i) q[p][i] = *(const PG8_GAS u32x4*)(src[i] + (size_t)p * 128);
#pragma unroll 1
    for (int kt0 = 0; kt0 < nkt; kt0 += PD) {
#pragma unroll
        for (int p = 0; p < PD; ++p) { const int kt = kt0 + p;
            PG8_LAS unsigned char* sl = lds + (p & 1) * MINI_SLOT;
            *(PG8_LAS u32x4*)(sl + dst0) = q[p][0]; *(PG8_LAS u32x4*)(sl + dst1) = q[p][1]; *(PG8_LAS u32x4*)(sl + dst2) = q[p][2];
            { const int kk = kt + PD < nkt ? kt + PD : nkt - 1;
#pragma unroll
              for (int i = 0; i < 3; ++i) q[p][i] = *(const PG8_GAS u32x4*)(src[i] + (size_t)kk * 128); }
            asm volatile("s_waitcnt lgkmcnt(0)" ::: "memory"); __builtin_amdgcn_s_barrier(); asm volatile("" ::: "memory");
            if constexpr (Epi::MIDK) { if (p == 0 && (kt0 == 8 || kt0 == 16 || kt0 == 24)) { const int seg = (kt0 >> 3) - 1;
#pragma unroll
                for (int mt = 0; mt < 2; ++mt) { const float rho = E.ratio(row0 + 32 * wrow + 16 * mt + r16, seg); acc[mt][0] = acc[mt][0] * rho; acc[mt][1] = acc[mt][1] * rho; } } }
#pragma unroll
            for (int ks = 0; ks < 2; ++ks) { bf16x8 af[2], bfr[2];
#pragma unroll
                for (int t = 0; t < 2; ++t) { af[t] = *(const PG8_LAS bf16x8*)(sl + aoff[t] + (((4 * ks + quad) ^ sw) << 4)); bfr[t] = *(const PG8_LAS bf16x8*)(sl + boff[t] + (((4 * ks + quad) ^ sw) << 4)); }
#pragma unroll
                for (int mt = 0; mt < 2; ++mt)
#pragma unroll
                    for (int nt = 0; nt < 2; ++nt) acc[mt][nt] = __builtin_amdgcn_mfma_f32_16x16x32_bf16(bfr[nt], af[mt], acc[mt][nt], 0, 0, 0); }
        }
    }
    asm volatile("s_waitcnt lgkmcnt(0)" ::: "memory"); __builtin_amdgcn_s_barrier(); asm volatile("" ::: "memory");
    const int r = row0 + 32 * wrow + r16, c = col0 + 32 * wcol + 8 * quad;
    typename Epi::Pre p0 = E.pre(r, c), p1 = E.pre(r + 16, c);
    if constexpr (Epi::INPLACE) { E.fin_ip(r, c, acc[0][0], acc[0][1], p0); E.fin_ip(r + 16, c, acc[1][0], acc[1][1], p1); }
    else { E.fin(r, c, acc[0][0], acc[0][1], p0); E.fin(r + 16, c, acc[1][0], acc[1][1], p1); }
}
template <class Epi> __device__ __forceinline__ void mini_gemm(PG8_LAS unsigned char* lds, const bf16_t* A, const bf16_t* Bt, int K, int row0, int col0, const Epi& E) { f32x4 acc[2][2]; mini_gemm_acc<Epi, true>(lds, A, Bt, K, row0, col0, E, acc); }
struct ProjOrder {
    StaticOrder so; int G, c;
    __device__ void init(int G_, int c_) { so.init(8192, 18432, G_, c_); G = G_; c = c_; }
    __device__ bool next(int i, Unit& u) const {
        const long L = (long)i * G + c;
        if (L < 2304) return so.next(i, u);
        if (L < 2560) { const int j = (int)L - 2304; u.pm = 32 + (j & 3); u.pn = j >> 2; u.sel = 0; return true; }
        return false;
    }
    __device__ __forceinline__ void a_ready(const Unit&) const {}
    __device__ __forceinline__ void done(const Unit&) const {}
};
template <class Epi, class Sched, bool ALIGN_EPI, bool SP2, bool ZERO0>
__device__ __forceinline__ void gemm_phase_acc(PG8_LAS unsigned char* lds, const Gemm g, const Sched& S, const Epi& E, f32x4 (&acc)[2][2][4][2]) {
    int tid_ = threadIdx.x; asm volatile("" : "+v"(tid_));
    const int tid = tid_, wid = __builtin_amdgcn_readfirstlane(tid >> 6), lane = tid & 63, wr = wid >> 2, wc = wid & 3, fr = lane & 15, fq = lane >> 4;
    const int K = g.K, nt = K / BK;
    unsigned voffA[2], voffB[2];
#pragma unroll
    for (int i = 0; i < 2; ++i) { int R, C; stage_rc(tid * 16 + i * 8192, R, C); const int Rb = (R & ~31) + perm32(R & 31);
        voffA[i] = (unsigned)(R * K + C) * 2u; voffB[i] = (unsigned)(Rb * K + C) * 2u; }
    const size_t kstep = (size_t)(BK * 2);
    const size_t hstep = (size_t)HALF * K * 2;
    const size_t tstep = 2 * hstep;
    const unsigned ldsw = (unsigned)wid * 1024u;
    const int aoff = lds_byte(wr * 64 + fr, fq * 8), boff = lds_byte(wc * 32 + fr, fq * 8);
#define PG8_SA(b, h) (((b) * 2 + (h)) * HTB)
#define PG8_SB(b, h) ((4 + (b) * 2 + (h)) * HTB)
#define PG8_STAGE(bufoff, gbase, voff) do { _Pragma("unroll") for (int _i = 0; _i < 2; ++_i) \
        __builtin_amdgcn_global_load_lds((const unsigned*)((const char*)(gbase) + (voff)[_i]), (PG8_LAS unsigned*)(lds + (bufoff) + ldsw + _i * 8192), 16, 0, 0); } while (0)
#define PG8_LDA(dst, b, h) do { _Pragma("unroll") for (int m = 0; m < 4; ++m) _Pragma("unroll") for (int k = 0; k < 2; ++k) dst[m][k] = *(const PG8_LAS bf16x8*)(lds + PG8_SA(b, h) + aoff + m * 2048 + k * 1024); } while (0)
#define PG8_LDB(dst, b, h) do { _Pragma("unroll") for (int n = 0; n < 2; ++n) _Pragma("unroll") for (int k = 0; k < 2; ++k) dst[n][k] = *(const PG8_LAS bf16x8*)(lds + PG8_SB(b, h) + boff + n * 2048 + k * 1024); } while (0)
#define PG8_MMA(ai, bj, At, Bt) do { __builtin_amdgcn_s_setprio(1); _Pragma("unroll") for (int m = 0; m < 4; ++m) _Pragma("unroll") for (int n = 0; n < 2; ++n) _Pragma("unroll") for (int k = 0; k < 2; ++k) \
        acc[ai][bj][m][n] = __builtin_amdgcn_mfma_f32_16x16x32_bf16(Bt[n][k], At[m][k], acc[ai][bj][m][n], 0, 0, 0); __builtin_amdgcn_s_setprio(0); } while (0)
#define PG8_WAIT_V(n) asm volatile("s_waitcnt vmcnt(" #n ")" ::: "memory")
#define PG8_WAIT_L(n) asm volatile("s_waitcnt lgkmcnt(" #n ")" ::: "memory")
#define PG8_BAR __builtin_amdgcn_s_barrier()
#define PG8_SCHED __builtin_amdgcn_sched_barrier(0)
    Unit cur, nxt; int ui = 0;
    if (!S.next(0, cur)) return;
    if constexpr (ZERO0) {
#pragma unroll
    for (int a = 0; a < 2; ++a)
#pragma unroll
        for (int b = 0; b < 2; ++b)
#pragma unroll
            for (int m = 0; m < 4; ++m)
#pragma unroll
                for (int n = 0; n < 2; ++n) acc[a][b][m][n] = (f32x4){0.f, 0.f, 0.f, 0.f};
    }
    bf16x8 At[4][2], B0[2][2], B1[2][2];
    const char* cA = (const char*)(cur.sel ? g.A2 : g.A) + (size_t)cur.pm * tstep; const char* cB = (const char*)(cur.sel ? g.Bt2 : g.Bt) + (size_t)cur.pn * tstep;
    S.a_ready(cur);
    if constexpr (Epi::RSTAB) E.tab_stage(lds, cur, 0, wid, lane);
    if constexpr (SP2) {
        PG8_STAGE(PG8_SB(0, 0), cB, voffB); PG8_STAGE(PG8_SB(0, 1), cB + hstep, voffB); PG8_STAGE(PG8_SA(0, 0), cA, voffA); PG8_STAGE(PG8_SA(0, 1), cA + hstep, voffA);
        if (wr == 1) PG8_BAR;
        PG8_WAIT_V(2); PG8_BAR;
        PG8_STAGE(PG8_SB(1, 0), cB + kstep, voffB); PG8_STAGE(PG8_SA(1, 0), cA + kstep, voffA); PG8_STAGE(PG8_SB(1, 1), cB + hstep + kstep, voffB);
        PG8_WAIT_V(6); PG8_BAR;
    } else {
        PG8_STAGE(PG8_SB(0, 0), cB, voffB); PG8_STAGE(PG8_SA(0, 0), cA, voffA); PG8_STAGE(PG8_SB(0, 1), cB + hstep, voffB); PG8_STAGE(PG8_SA(0, 1), cA + hstep, voffA);
        if (wr == 1) PG8_BAR;
        PG8_WAIT_V(4); PG8_BAR;
        PG8_STAGE(PG8_SB(1, 0), cB + kstep, voffB); PG8_STAGE(PG8_SA(1, 0), cA + kstep, voffA); PG8_STAGE(PG8_SB(1, 1), cB + hstep + kstep, voffB);
        PG8_WAIT_V(6); PG8_BAR;
    }
    for (;;) {
        const bool has_next = S.next(ui + 1, nxt);
        const char* nA = has_next ? (const char*)(nxt.sel ? g.A2 : g.A) + (size_t)nxt.pm * tstep : cA; const char* nB = has_next ? (const char*)(nxt.sel ? g.Bt2 : g.Bt) + (size_t)nxt.pn * tstep : cB;
        for (int t = 0; t < nt; t += 2) {
            if constexpr (Epi::MIDK) { if (cur.sel == 1 && (t == 8 || t == 16 || t == 24)) {
                const int seg = (t >> 3) - 1;
#pragma unroll
                for (int ai = 0; ai < 2; ++ai)
#pragma unroll
                    for (int m = 0; m < 4; ++m) { const float rho = E.ratio(ai * HALF + wr * 64 + m * 16 + fr, seg);
#pragma unroll
                        for (int bj = 0; bj < 2; ++bj)
#pragma unroll
                            for (int n = 0; n < 2; ++n) acc[ai][bj][m][n] = acc[ai][bj][m][n] * rho; } } }
            const bool last = (t == nt - 2);
            const char* a1 = cA + (size_t)(t + 1) * kstep;
            const char* a2 = last ? nA : cA + (size_t)(t + 2) * kstep; const char* b2 = last ? nB : cB + (size_t)(t + 2) * kstep;
            const char* a3 = a2 + kstep; const char* b3 = b2 + kstep;
            if (last && has_next) S.a_ready(nxt);
            if constexpr (SP2) {
            PG8_LDB(B0, 0, 0); PG8_LDB(B1, 0, 1); PG8_SCHED; PG8_LDA(At, 0, 0); PG8_STAGE(PG8_SA(1, 1), a1 + hstep, voffA);
            PG8_WAIT_V(8); PG8_WAIT_L(0); PG8_BAR; PG8_MMA(0, 0, At, B0); PG8_MMA(0, 1, At, B1); PG8_BAR; PG8_SCHED;
            PG8_LDA(At, 0, 1); if constexpr (Epi::RSTAB) { if (last && has_next) E.tab_stage(lds, nxt, (ui + 1) & 1, wid, lane); }
            PG8_STAGE(PG8_SB(0, 0), b2, voffB); PG8_STAGE(PG8_SB(0, 1), b2 + hstep, voffB); PG8_STAGE(PG8_SA(0, 0), a2, voffA);
            PG8_WAIT_V(8); PG8_WAIT_L(0); PG8_BAR; PG8_MMA(1, 0, At, B0); PG8_MMA(1, 1, At, B1); PG8_BAR; PG8_SCHED;
            PG8_LDB(B0, 1, 0); PG8_LDB(B1, 1, 1); PG8_SCHED; PG8_LDA(At, 1, 0); PG8_STAGE(PG8_SA(0, 1), a2 + hstep, voffA);
            PG8_WAIT_V(8); PG8_WAIT_L(0); PG8_BAR; PG8_MMA(0, 0, At, B0); PG8_MMA(0, 1, At, B1); PG8_BAR; PG8_SCHED;
            PG8_LDA(At, 1, 1); PG8_STAGE(PG8_SB(1, 0), b3, voffB); PG8_STAGE(PG8_SB(1, 1), b3 + hstep, voffB); PG8_STAGE(PG8_SA(1, 0), a3, voffA);
            PG8_WAIT_V(8); PG8_WAIT_L(0); PG8_BAR; PG8_MMA(1, 0, At, B0); PG8_MMA(1, 1, At, B1); PG8_BAR; PG8_SCHED;
            } else {
            PG8_LDB(B0, 0, 0); PG8_SCHED; PG8_LDA(At, 0, 0); PG8_STAGE(PG8_SA(1, 1), a1 + hstep, voffA);
            PG8_WAIT_L(8); PG8_BAR; PG8_WAIT_L(0); PG8_MMA(0, 0, At, B0); PG8_BAR; PG8_SCHED;
            PG8_LDB(B1, 0, 1); PG8_STAGE(PG8_SB(0, 0), b2, voffB);
            PG8_BAR; PG8_WAIT_L(0); PG8_MMA(0, 1, At, B1); PG8_BAR;
            PG8_LDA(At, 0, 1); PG8_STAGE(PG8_SA(0, 0), a2, voffA);
            PG8_BAR; PG8_WAIT_L(0); PG8_MMA(1, 0, At, B0); PG8_BAR; PG8_SCHED;
            PG8_STAGE(PG8_SB(0, 1), b2 + hstep, voffB);
            PG8_WAIT_V(6); PG8_BAR; PG8_MMA(1, 1, At, B1); PG8_BAR;
            PG8_LDB(B0, 1, 0); PG8_SCHED; PG8_LDA(At, 1, 0); PG8_STAGE(PG8_SA(0, 1), a2 + hstep, voffA);
            PG8_WAIT_L(8); PG8_BAR; PG8_WAIT_L(0); PG8_MMA(0, 0, At, B0); PG8_BAR; PG8_SCHED;
            PG8_LDB(B1, 1, 1); PG8_STAGE(PG8_SB(1, 0), b3, voffB);
            PG8_BAR; PG8_WAIT_L(0); PG8_MMA(0, 1, At, B1); PG8_BAR;
            PG8_LDA(At, 1, 1); PG8_STAGE(PG8_SA(1, 0), a3, voffA);
            PG8_BAR; PG8_WAIT_L(0); PG8_MMA(1, 0, At, B0); PG8_BAR; PG8_SCHED;
            PG8_STAGE(PG8_SB(1, 1), b3 + hstep, voffB);
            PG8_WAIT_V(6); PG8_BAR; PG8_MMA(1, 1, At, B1); PG8_BAR;
            }
        }
        if constexpr (ALIGN_EPI) { if (wr == 0) PG8_BAR; }
        if constexpr (Epi::RSTAB) E.tab_set(lds, ui & 1);
        epi_big(E, acc, cur, wr, wc, fr, fq); S.done(cur);
        if (!has_next) break;
        if (nxt.sel == 0) {
#pragma unroll
        for (int a = 0; a < 2; ++a)
#pragma unroll
            for (int b = 0; b < 2; ++b)
#pragma unroll
                for (int m = 0; m < 4; ++m)
#pragma unroll
                    for (int n = 0; n < 2; ++n) acc[a][b][m][n] = (f32x4){0.f, 0.f, 0.f, 0.f};
        }
        cur = nxt; cA = nA; cB = nB; ++ui;
        if constexpr (ALIGN_EPI) { if (wr == 1) PG8_BAR; }
    }
    PG8_WAIT_V(0);
    if constexpr (!ALIGN_EPI) { if (wr == 0) PG8_BAR; }
    PG8_BAR;
#undef PG8_SA
#undef PG8_SB
#undef PG8_STAGE
#undef PG8_LDA
#undef PG8_LDB
#undef PG8_MMA
#undef PG8_WAIT_V
#undef PG8_WAIT_L
#undef PG8_BAR
#undef PG8_SCHED
}
template <class Epi, class Sched, bool ALIGN_EPI = false, bool SP2 = false>
__device__ __forceinline__ void gemm_phase(PG8_LAS unsigned char* lds, const Gemm g, const Sched& S, const Epi& E) { f32x4 acc[2][2][4][2]; gemm_phase_acc<Epi, Sched, ALIGN_EPI, SP2, true>(lds, g, S, E, acc); }
}

constexpr int D = 2048, M = 9216, MP = 8192, DEPTH = 4, NWAVES = 8;
constexpr int INW = 18448, NPAD = 18496, PW = pg8::PW;
constexpr int C_GA = 0, C_GB = 2048, C_CB = 4096, C_CC = 6144, C_CX = 8192, C_CG = 10240, C_Q = 12288, C_K = 13312, C_V = 14336, C_GG = 16384;
constexpr float EPS = 1e-6f;
constexpr size_t O_Y = 0, O_CONVP = 18874368, O_GLAP = 18939904, O_CONVS = 27328512, O_GLAS = 29425664, O_END = 297861120;
constexpr size_t MiB = 1u << 20;
constexpr size_t WS_CTL = 0, CTL_ZERO_BYTES = 2 * MiB;
constexpr size_t WS_WIN = 2 * MiB, WIN_L = (size_t)NPAD * D * 2;
constexpr size_t WS_WA = 296 * MiB, WS_WB = 328 * MiB, WS_WO = 360 * MiB, W_L = (size_t)D * D * 2;
constexpr size_t WS_XF = 392 * MiB, WS_XB = 464 * MiB, WS_P = 500 * MiB, WS_ZA = 824 * MiB, WS_ZB = 860 * MiB, WS_MG = 896 * MiB;
constexpr size_t WS_O = 932 * MiB, WS_T = 1004 * MiB, WS_LR = 1076 * MiB, WS_RSTD = 1077 * MiB, WS_END = 1078 * MiB;
static_assert(WS_WIN + 4 * WIN_L <= WS_WA, "ws map");
constexpr int CW_BAR = 4096;
constexpr size_t WS_RSO = 524288;
constexpr size_t WS_RSQ = 65536;
constexpr int RING_OFF = 0, RING_BYTES = 131072, ROWSUM_OFF = 147456, LDSCTL_OFF = 149504, MISC_OFF = LDSCTL_OFF + 320, RT_OFF = 150528, LDS_BYTES = 158720;

#define GAS __attribute__((address_space(1)))
#define LAS __attribute__((address_space(3)))
typedef unsigned short bf16;
typedef unsigned v4u __attribute__((ext_vector_type(4)));
typedef unsigned v2u __attribute__((ext_vector_type(2)));
typedef float f32x4 __attribute__((ext_vector_type(4)));
typedef GAS unsigned gu32;
#define RLX_AGENT __ATOMIC_RELAXED, __HIP_MEMORY_SCOPE_AGENT
#define LDS_WAIT() asm volatile("s_waitcnt lgkmcnt(0)" ::: "memory")
#define VM_WAIT() asm volatile("s_waitcnt vmcnt(0)" ::: "memory")
__device__ __forceinline__ unsigned f2bf(float f) { unsigned u = __builtin_bit_cast(unsigned, f); return (u + 0x7fffu + ((u >> 16) & 1u)) >> 16; }
__device__ __forceinline__ unsigned pk2(float lo, float hi) { return f2bf(lo) | (f2bf(hi) << 16); }
__device__ __forceinline__ float bflo(unsigned w) { return __uint_as_float(w << 16); }
__device__ __forceinline__ float bfhi(unsigned w) { return __uint_as_float(w & 0xffff0000u); }
__device__ __forceinline__ float bf1(bf16 b) { return __uint_as_float(((unsigned)b) << 16); }

typedef short bf16x8 __attribute__((ext_vector_type(8)));
typedef float f32x2 __attribute__((ext_vector_type(2)));
typedef __bf16 bf16x2_t __attribute__((ext_vector_type(2)));
__device__ __forceinline__ unsigned pkbf(float a, float b) { f32x2 v = {a, b}; bf16x2_t r = __builtin_convertvector(v, bf16x2_t); return __builtin_bit_cast(unsigned, r); }
#define XB_TMO      128
#define XB_XCNT(j)  (256  + 64 * (j))
#define XB_XSUB(j)  (1280 + 64 * (j))
#define XB_XGEN(j)  (2304 + 64 * (j))
#define XB_TOP      3328
#define XB_TOPGEN   3392
#define XCD_BAR_WORDS 3456
#define XB_SPIN_CAP (1u << 18)
__device__ __forceinline__ unsigned xb_ld(unsigned* p)              { return __hip_atomic_load(p, __ATOMIC_RELAXED, __HIP_MEMORY_SCOPE_AGENT); }
__device__ __forceinline__ unsigned xb_add(unsigned* p, unsigned v) { return __hip_atomic_fetch_add(p, v, __ATOMIC_RELAXED, __HIP_MEMORY_SCOPE_AGENT); }
__device__ __forceinline__ unsigned xb_xcc_id() { return (unsigned)__builtin_amdgcn_s_getreg((3 << 11) | 20) & 0xFu; }
#define XB_SPIN(cond, bar) do { unsigned _sp = 0; while (cond) { __builtin_amdgcn_s_sleep(1); \
    if ((++_sp & 255u) == 0u) { if (xb_ld(&(bar)[XB_TMO])) break; if (_sp > XB_SPIN_CAP) { atomicAdd(&(bar)[XB_TMO], 1u); break; } } } } while (0)
struct XcdBarrier { unsigned* bar; unsigned x; volatile LAS unsigned* st; };
__device__ __forceinline__ XcdBarrier xcd_barrier_post(unsigned* bar, volatile LAS unsigned* st) {
    XcdBarrier b; b.bar = bar; b.x = xb_xcc_id(); b.st = st;
    if (threadIdx.x == 0) (void)xb_add(&bar[XB_XCNT(b.x)], 1u);
    return b;
}
__device__ __forceinline__ void xcd_barrier_complete(unsigned* bar, unsigned x, unsigned& nloc, unsigned& nx) {
    const unsigned G = gridDim.x * gridDim.y * gridDim.z;
    unsigned sum, cnt, mine, sp = 0u;
    for (;;) {
        sum = 0u; cnt = 0u; mine = 0u;
#pragma unroll
        for (unsigned j = 0; j < 16; ++j) { const unsigned c = xb_ld(&bar[XB_XCNT(j)]); sum += c; cnt += (c > 0u) ? 1u : 0u; mine = (j == x) ? c : mine; }
        if (sum == G) break;
        __builtin_amdgcn_s_sleep(1);
        if ((++sp & 255u) == 0u) { if (xb_ld(&bar[XB_TMO])) break; if (sp > XB_SPIN_CAP) { atomicAdd(&bar[XB_TMO], 1u); break; } }
    }
    nloc = mine > 0u ? mine : 1u; nx = cnt > 0u ? cnt : 1u;
}
__device__ __forceinline__ void xcd_barrier(const XcdBarrier& b) {
    asm volatile("s_waitcnt vmcnt(0)" ::: "memory");
    __syncthreads();
    if (threadIdx.x == 0) {
        unsigned* bar = b.bar;
        __builtin_amdgcn_s_waitcnt(0);
        unsigned nloc = b.st[0], nx = b.st[1];
        if (nloc == 0u) { xcd_barrier_complete(bar, b.x, nloc, nx); b.st[0] = nloc; b.st[1] = nx; }
        const unsigned old = xb_add(&bar[XB_XSUB(b.x)], 1u);
        const unsigned gen = old / nloc;
        if (old + 1u == (gen + 1u) * nloc) {
            __builtin_amdgcn_fence(__ATOMIC_RELEASE, "agent");
            asm volatile("s_waitcnt vmcnt(0)" ::: "memory");
            const unsigned og = xb_add(&bar[XB_TOP], 1u);
            const unsigned tg = og / nx;
            if (og + 1u == (tg + 1u) * nx) xb_add(&bar[XB_TOPGEN], 1u);
            else XB_SPIN(xb_ld(&bar[XB_TOPGEN]) == tg, bar);
            __builtin_amdgcn_fence(__ATOMIC_ACQUIRE, "agent");
            xb_add(&bar[XB_XGEN(b.x)], 1u);
            asm volatile("s_waitcnt vmcnt(0)" ::: "memory");
        } else {
            XB_SPIN(xb_ld(&bar[XB_XGEN(b.x)]) == gen, bar);
            __builtin_amdgcn_fence(__ATOMIC_ACQUIRE, "agent");
            asm volatile("s_waitcnt vmcnt(0)" ::: "memory");
        }
    }
    __syncthreads();
}

struct Frame {
    LAS unsigned char* lds;
    int tid, lane, wave, vcu, G;
};
__device__ __forceinline__ const float* inp(int k) { asm volatile("" : "+s"(k)); const unsigned long long* ka = (const unsigned long long*)__builtin_amdgcn_kernarg_segment_ptr(); return (const float*)(const GAS float*)ka[k]; }
__device__ __forceinline__ unsigned char* wsp() { return (unsigned char*)inp(15); }
__device__ __forceinline__ float* outp() { return (float*)inp(14); }
enum { I_XP = 0, I_XS, I_SCONV, I_SGLA, I_NORMG, I_WIN, I_CONVW, I_WA2, I_BA, I_GNORMG, I_WBA, I_WBB, I_WO, I_FING };
__device__ __forceinline__ float wave_sum(float v) {
#pragma unroll
    for (int o = 1; o < 64; o <<= 1) v += __shfl_xor(v, o);
    return v;
}
__device__ __forceinline__ void tr_item(const float* W, int ldw, int nvalid, int K, bf16* WT, int nblk, const float* s, int smask, int item, int lane, bool perm) {
    const int kb = item / nblk, nb = item % nblk, k0 = 64 * kb, n = 64 * nb + lane;
    int nd = n;
    if (perm && n >= 4096 && n < 12288) { const int sct = (n - 4096) >> 11, ch = (n - 4096) & 2047, c64 = ch & 63; nd = 4096 + (ch >> 6) * 256 + 128 * (sct >> 1) + 32 * (c64 >> 4) + 8 * ((c64 >> 2) & 3) + 4 * (sct & 1) + (c64 & 3); }
    float v[64];
    if (n < nvalid) { const float* p = W + (size_t)k0 * ldw + n;
#pragma unroll
        for (int i = 0; i < 64; ++i) v[i] = p[(size_t)i * ldw]; }
    else {
#pragma unroll
        for (int i = 0; i < 64; ++i) v[i] = 0.f; }
    if (s) {
#pragma unroll
        for (int i = 0; i < 64; ++i) v[i] *= s[(k0 + i) & smask]; }
    GAS v4u* d = (GAS v4u*)(WT + (size_t)nd * K + k0);
#pragma unroll
    for (int c = 0; c < 8; ++c) { v4u o; o.x = pkbf(v[8 * c], v[8 * c + 1]); o.y = pkbf(v[8 * c + 2], v[8 * c + 3]); o.z = pkbf(v[8 * c + 4], v[8 * c + 5]); o.w = pkbf(v[8 * c + 6], v[8 * c + 7]); d[c] = o; }
}
__device__ __forceinline__ void p_prologue(Frame& F0) {
    Frame F = F0; asm volatile("" : "+v"(F.tid), "+v"(F.lane));
    const int gw = F.vcu * NWAVES + F.wave, NGW = F.G * NWAVES;
    constexpr int I_IN = (D / 64) * (NPAD / 64), I_SQ = (D / 64) * (D / 64), I_L = I_IN + 3 * I_SQ;
    for (int it = gw; it < DEPTH * I_L; it += NGW) {
        const int l = it / I_L; int r = it % I_L;
        if (r < I_IN) { tr_item(inp(I_WIN) + (size_t)l * D * INW, INW, INW, D, (bf16*)(wsp() + WS_WIN + l * WIN_L), NPAD / 64, inp(I_NORMG) + l * D, 0xffff, r, F.lane, true); continue; } r -= I_IN;
        if (r < I_SQ) { tr_item(inp(I_WBA) + (size_t)l * D * D, D, D, D, (bf16*)(wsp() + WS_WA + l * W_L), D / 64, nullptr, 0, r, F.lane, false); continue; } r -= I_SQ;
        if (r < I_SQ) { tr_item(inp(I_WBB) + (size_t)l * D * D, D, D, D, (bf16*)(wsp() + WS_WB + l * W_L), D / 64, inp(I_GNORMG) + l * 512, 511, r, F.lane, false); continue; } r -= I_SQ;
        tr_item(inp(I_WO) + (size_t)l * D * D, D, D, D, (bf16*)(wsp() + WS_WO + l * W_L), D / 64, nullptr, 0, r, F.lane, false);
    }
}
__device__ __forceinline__ void p_xprep(Frame& F0, int l) {
    Frame F = F0; asm volatile("" : "+v"(F.tid), "+v"(F.lane));
    const int gw = F.vcu * NWAVES + F.wave, NGW = F.G * NWAVES;
    bf16* XB = (bf16*)(wsp() + WS_XB); unsigned long long* RS = (unsigned long long*)(wsp() + WS_RSQ);
    for (int r = gw; r < M; r += NGW) {
        const float* src = r < MP ? inp(I_XP) + (size_t)r * D : inp(I_XS) + (size_t)(r - MP) * D;
        const GAS f32x4* s4 = (const GAS f32x4*)src + F.lane;
        f32x4 v[8]; float ss = 0.f;
#pragma unroll
        for (int j = 0; j < 8; ++j) { v[j] = s4[64 * j]; ss += (v[j].x * v[j].x + v[j].y * v[j].y) + (v[j].z * v[j].z + v[j].w * v[j].w); }
        const float tot = wave_sum(ss);
        if (F.lane == 0) RS[r] = (unsigned long long)(tot * 16777216.0f);
        GAS unsigned long long* o8 = (GAS unsigned long long*)(XB + (size_t)r * D) + F.lane;
#pragma unroll
        for (int j = 0; j < 8; ++j) o8[64 * j] = (unsigned long long)pk2(v[j].x, v[j].y) | ((unsigned long long)pk2(v[j].z, v[j].w) << 32);
    }
}
__device__ __forceinline__ void p_final(Frame& F0) {
    Frame F = F0; asm volatile("" : "+v"(F.tid), "+v"(F.lane));
    const int gw = F.vcu * NWAVES + F.wave, NGW = F.G * NWAVES;
    const bf16* XB = (const bf16*)(wsp() + WS_XB);
    for (int r = gw; r < M; r += NGW) {
        const GAS v2u* s2 = (const GAS v2u*)(XB + (size_t)r * D) + F.lane; const GAS f32x4* g4 = (const GAS f32x4*)inp(I_FING) + F.lane;
        f32x4 v[8];
#pragma unroll
        for (int j = 0; j < 8; ++j) { const v2u w = s2[64 * j]; v[j] = (f32x4){bflo(w.x), bfhi(w.x), bflo(w.y), bfhi(w.y)}; }
        const float rstd = 1.f / sqrtf((float)((const unsigned long long*)(wsp() + WS_RSQ))[DEPTH * M + r] * (1.0f / 16777216.0f) * (1.f / D) + EPS);
        GAS f32x4* d4 = (GAS f32x4*)(outp() + O_Y + (size_t)r * D) + F.lane;
#pragma unroll
        for (int j = 0; j < 8; ++j) d4[64 * j] = v[j] * rstd * g4[64 * j];
    }
}
__device__ __forceinline__ unsigned short bf1r(float a) { return (unsigned short)(pkbf(a, 0.f) & 0xffffu); }
__device__ __forceinline__ float logsig16(float a) { return (fminf(a, 0.f) - 0.69314718f * __builtin_amdgcn_logf(1.0f + __builtin_amdgcn_exp2f(-1.44269504f * fabsf(a)))) * 0.0625f; }
__device__ __forceinline__ float fexp(float x) { return __builtin_amdgcn_exp2f(1.44269504f * x); }
__device__ __forceinline__ int qt_off(int t, int p) { return t * 512 + (((p & 16) | ((p ^ t) & 15)) << 4); }
__device__ __forceinline__ int r8_off(int r, int p) { return r * 128 + ((p ^ ((r >> 1) & 7)) << 4); }
__device__ __forceinline__ int qt_pos(int k) { const int k32 = k & 31; return (k & ~31) + 8 * ((k32 & 15) >> 2) + 4 * (k32 >> 4) + (k32 & 3); }
constexpr size_t WS_QT = 1078 * MiB, WS_KD = 1094 * MiB, WS_AI = 1110 * MiB, WS_GM = 1114 * MiB, WS_VT = 1115 * MiB, WS_END2 = 1147 * MiB;
constexpr int QT_B = 32768, KD_B = 32768, AI_B = 8192, GM_B = 1024, VT_B = 65536, SCAN_BUF = QT_B + KD_B + AI_B + GM_B;

__device__ __forceinline__ void p_gla_prep(Frame& F0, int l) {
    Frame F = F0; asm volatile("" : "+v"(F.tid), "+v"(F.lane));
    const bf16* P = (const bf16*)(wsp() + WS_P); const float* LR = (const float*)(wsp() + WS_LR);
    LAS unsigned char* Qs = F.lds; LAS unsigned char* Ks = F.lds + 32768; LAS unsigned char* VTs = F.lds;
    LAS unsigned char* Qraw = F.lds + 65536; LAS unsigned char* Kraw = F.lds + 98304;
    LAS float* LRs = (LAS float*)(F.lds + 131072); LAS float* TOT = (LAS float*)(F.lds + 135168);
    const int k = F.tid & 255, half = F.tid >> 8;
    for (int item = F.vcu; item < 512; item += F.G) {
        const int b = item >> 7, c = (item >> 2) & 31, h = item & 3, r0 = b * 2048 + c * 64;
        v4u va[4], vb[4], qv[4], kv[4]; f32x4 lrv = {0.f, 0.f, 0.f, 0.f};
#pragma unroll
        for (int i = 0; i < 4; ++i) { const int id = i * 512 + F.tid, tp = id & 31, pc = id >> 5;
            va[i] = *(const GAS v4u*)(P + (size_t)(r0 + 2 * tp) * PW + C_V + h * 512 + 8 * pc); vb[i] = *(const GAS v4u*)(P + (size_t)(r0 + 2 * tp + 1) * PW + C_V + h * 512 + 8 * pc);
            const int t = id >> 5, p = id & 31;
            qv[i] = *(const GAS v4u*)(P + (size_t)(r0 + t) * PW + C_Q + h * 256 + 8 * p); kv[i] = *(const GAS v4u*)(P + (size_t)(r0 + t) * PW + C_K + h * 256 + 8 * p); }
        if (F.tid < 256) lrv = *(const GAS f32x4*)(LR + (size_t)r0 * 16 + 4 * F.tid);
        float w2[16]; const float bias = inp(I_BA)[l * 1024 + h * 256 + k];
        { const float* w2p = inp(I_WA2) + (size_t)l * 16 * 1024 + h * 256 + k;
#pragma unroll
          for (int j = 0; j < 16; ++j) w2[j] = w2p[j * 1024]; }
#pragma unroll
        for (int i = 0; i < 4; ++i) { const int id = i * 512 + F.tid, tp = id & 31, pc = id >> 5; const v4u a = va[i], bb = vb[i];
            LAS unsigned* d = (LAS unsigned*)(VTs + (8 * pc) * 128 + 4 * tp);
            d[0 * 32] = (a.x & 0xffffu) | (bb.x << 16); d[1 * 32] = (a.x >> 16) | (bb.x & 0xffff0000u); d[2 * 32] = (a.y & 0xffffu) | (bb.y << 16); d[3 * 32] = (a.y >> 16) | (bb.y & 0xffff0000u);
            d[4 * 32] = (a.z & 0xffffu) | (bb.z << 16); d[5 * 32] = (a.z >> 16) | (bb.z & 0xffff0000u); d[6 * 32] = (a.w & 0xffffu) | (bb.w << 16); d[7 * 32] = (a.w >> 16) | (bb.w & 0xffff0000u);
            *(LAS v4u*)(Qraw + id * 16) = qv[i]; *(LAS v4u*)(Kraw + id * 16) = kv[i]; }
        if (F.tid < 256) *(LAS f32x4*)(LRs + 4 * F.tid) = lrv;
        __syncthreads();
        { GAS v4u* dst = (GAS v4u*)(wsp() + WS_VT + (size_t)item * VT_B);
#pragma unroll
          for (int i = 0; i < 8; ++i) dst[i * 512 + F.tid] = *(const LAS v4u*)(VTs + (i * 512 + F.tid) * 16); }
        float bc[32]; float run = 0.f;
#pragma unroll
        for (int i = 0; i < 32; ++i) { const LAS f32x4* lr4 = (const LAS f32x4*)(LRs + (half * 32 + i) * 16); float a = bias;
#pragma unroll
            for (int j4 = 0; j4 < 4; ++j4) { const f32x4 x = lr4[j4]; a += x[0] * w2[4 * j4] + x[1] * w2[4 * j4 + 1] + x[2] * w2[4 * j4 + 2] + x[3] * w2[4 * j4 + 3]; }
            run += logsig16(a); bc[i] = run; }
        TOT[half * 256 + k] = run;
        __syncthreads();
        const float lo_tot = TOT[k], blast = lo_tot + TOT[256 + k], boff = half ? lo_tot : 0.f;
        if (half == 0) ((float*)(wsp() + WS_GM))[(size_t)item * 256 + k] = fexp(blast);
        const int pos = qt_pos(k), pp = pos >> 3, pe = (pos & 7) * 2;
        unsigned char* kdg = wsp() + WS_KD + (size_t)item * KD_B;
#pragma unroll
        for (int g = 0; g < 4; ++g) { unsigned kdw[4];
#pragma unroll
            for (int e = 0; e < 8; ++e) { const int i = g * 8 + e, t = half * 32 + i; const float bt = bc[i] + boff;
                const float qf = bf1(*(const LAS unsigned short*)(Qraw + t * 512 + k * 2)) * 0.0625f * fexp(bt), kf = bf1(*(const LAS unsigned short*)(Kraw + t * 512 + k * 2));
                const float kh = kf * fexp(-bt), kd = kf * fexp(blast - bt);
                *(LAS unsigned short*)(Qs + qt_off(t, pp) + pe) = bf1r(qf); *(LAS unsigned short*)(Ks + qt_off(t, pp) + pe) = bf1r(kh);
                if (e & 1) kdw[e >> 1] = (kdw[e >> 1] & 0xffffu) | ((unsigned)bf1r(kd) << 16); else kdw[e >> 1] = bf1r(kd); }
            v4u w; w.x = kdw[0]; w.y = kdw[1]; w.z = kdw[2]; w.w = kdw[3];
            *(GAS v4u*)(kdg + r8_off(k, half * 4 + g)) = w; }
        __syncthreads();
        { GAS v4u* dq = (GAS v4u*)(wsp() + WS_QT + (size_t)item * QT_B);
#pragma unroll
          for (int i = 0; i < 4; ++i) dq[i * 512 + F.tid] = *(const LAS v4u*)(Qs + (i * 512 + F.tid) * 16); }
        { const int r16 = F.lane & 15, quad = F.lane >> 4;
#pragma unroll
          for (int u = 0; u < 2; ++u) { const int id = F.wave * 2 + u, si = id >> 2, ti = id & 3;
              f32x4 acc = {0.f, 0.f, 0.f, 0.f};
              if (ti >= si) {
#pragma unroll
                  for (int ks = 0; ks < 8; ++ks) { const bf16x8 ka = *(const LAS bf16x8*)(Ks + qt_off(16 * si + r16, 4 * ks + quad)), qb = *(const LAS bf16x8*)(Qs + qt_off(16 * ti + r16, 4 * ks + quad));
                      acc = __builtin_amdgcn_mfma_f32_16x16x32_bf16(ka, qb, acc, 0, 0, 0); } }
              const int t = 16 * ti + r16, s0 = 16 * si + 4 * quad;
              v2u w; w.x = pkbf(s0 + 0 <= t ? acc[0] : 0.f, s0 + 1 <= t ? acc[1] : 0.f); w.y = pkbf(s0 + 2 <= t ? acc[2] : 0.f, s0 + 3 <= t ? acc[3] : 0.f);
              *(GAS v2u*)(wsp() + WS_AI + (size_t)item * AI_B + r8_off(t, 2 * si + (quad >> 1)) + (quad & 1) * 8) = w; } }
        __syncthreads();
    }
}
__device__ __forceinline__ void scan_stage(unsigned char* ws, LAS unsigned char* lds, int item, int c, int lw, int lane) {
    LAS unsigned char* buf = lds + (c & 1) * SCAN_BUF;
    const unsigned char* gq = ws + WS_QT + (size_t)item * QT_B; const unsigned char* gk = ws + WS_KD + (size_t)item * KD_B;
    const unsigned char* ga = ws + WS_AI + (size_t)item * AI_B; const unsigned char* gg = ws + WS_GM + (size_t)item * GM_B;
#pragma unroll
    for (int i = 0; i < 8; ++i) { const int wp = lw + 4 * i;
        __builtin_amdgcn_global_load_lds((const unsigned*)(gq + wp * 1024 + lane * 16), (LAS unsigned*)(buf + wp * 1024), 16, 0, 0);
        __builtin_amdgcn_global_load_lds((const unsigned*)(gk + wp * 1024 + lane * 16), (LAS unsigned*)(buf + QT_B + wp * 1024), 16, 0, 0); }
#pragma unroll
    for (int i = 0; i < 2; ++i) { const int wp = lw + 4 * i;
        __builtin_amdgcn_global_load_lds((const unsigned*)(ga + wp * 1024 + lane * 16), (LAS unsigned*)(buf + QT_B + KD_B + wp * 1024), 16, 0, 0); }
    if (lw == 0) __builtin_amdgcn_global_load_lds((const unsigned*)(gg + lane * 16), (LAS unsigned*)(buf + QT_B + KD_B + AI_B), 16, 0, 0);
}
__device__ __forceinline__ void p_gla_scan(Frame& F0, int l) {
    Frame F = F0; asm volatile("" : "+v"(F.tid), "+v"(F.lane));
    if (F.vcu >= 128) return;
    const int b = F.vcu >> 5, h = (F.vcu >> 3) & 3, vq = F.vcu & 7;
    bf16* ZBp = (bf16*)(wsp() + WS_ZB); const bf16* Pp = (const bf16*)(wsp() + WS_P); unsigned long long* RSO = (unsigned long long*)(wsp() + WS_RSO) + (size_t)l * M * 4;
    const int r16 = F.lane & 15, quad = F.lane >> 4, w = F.wave;
    const int vcol0 = vq * 64 + (w & 3) * 16;
    f32x4 S[16];
#pragma unroll
    for (int i = 0; i < 16; ++i) S[i] = (f32x4){0.f, 0.f, 0.f, 0.f};
    if (w >= 4) {
        scan_stage(wsp(), F.lds, (b * 32 + 0) * 4 + h, 0, w - 4, F.lane);
#pragma unroll 1
        for (int c = 0; c < 32; ++c) {
            asm volatile("s_waitcnt vmcnt(0)" ::: "memory");
            asm volatile("" ::: "memory"); __builtin_amdgcn_s_barrier(); asm volatile("" ::: "memory");
            if (c + 1 < 32) scan_stage(wsp(), F.lds, (b * 32 + c + 1) * 4 + h, c + 1, w - 4, F.lane);
        }
        asm volatile("s_waitcnt vmcnt(0)" ::: "memory");
        __syncthreads();
        return;
    }
    bf16x8 vf[2], vn[2];
    { const unsigned char* gv = wsp() + WS_VT + (size_t)((b * 32 + 0) * 4 + h) * VT_B + (vcol0 + r16) * 128 + quad * 16; vf[0] = *(const GAS bf16x8*)gv; vf[1] = *(const GAS bf16x8*)(gv + 64); }
    v4u gq[2], gqn[2];
    { const int r0 = b * 2048;
#pragma unroll
      for (int m = 0; m < 2; ++m) gq[m] = *(const GAS v4u*)(Pp + (size_t)(r0 + 16 * (2 * m + (quad & 1)) + r16) * PW + C_GG + h * 512 + vcol0 + 4 * (quad & 2)); }
    __builtin_amdgcn_s_setprio(3);
    auto chunk = [&](const int c, bf16x8 (&vcur)[2], bf16x8 (&vnxt)[2], v4u (&gcur)[2], v4u (&gnxt)[2]) __attribute__((always_inline)) {
        asm volatile("" ::: "memory"); __builtin_amdgcn_s_barrier(); asm volatile("" ::: "memory");
        const LAS unsigned char* buf = F.lds + (c & 1) * SCAN_BUF;
        const LAS unsigned char* Qb = buf; const LAS unsigned char* Kb = buf + QT_B; const LAS unsigned char* Ab = buf + QT_B + KD_B; const LAS unsigned char* Gb = buf + QT_B + KD_B + AI_B;
        f32x4 acc[4];
#pragma unroll
        for (int ti = 0; ti < 4; ++ti) acc[ti] = (f32x4){0.f, 0.f, 0.f, 0.f};
        bf16x8 rb[3][4];
#define SCAN_LDG(g, d) { _Pragma("unroll") for (int ti = 0; ti < 4; ++ti) d[ti] = (g) < 8 ? *(const LAS bf16x8*)(Qb + qt_off(16 * ti + r16, 4 * (g) + quad)) : *(const LAS bf16x8*)(Ab + r8_off(16 * ti + r16, 4 * ((g) - 8) + quad)); }
        SCAN_LDG(0, rb[0]) SCAN_LDG(1, rb[1])
#pragma unroll
        for (int g = 0; g < 10; ++g) {
            if (g + 2 < 10) SCAN_LDG(g + 2, rb[(g + 2) % 3])
            bf16x8 sa;
            if (g < 8) { v4u sp; sp.x = pkbf(S[2 * g][0], S[2 * g][1]); sp.y = pkbf(S[2 * g][2], S[2 * g][3]); sp.z = pkbf(S[2 * g + 1][0], S[2 * g + 1][1]); sp.w = pkbf(S[2 * g + 1][2], S[2 * g + 1][3]); sa = __builtin_bit_cast(bf16x8, sp); }
            else sa = vcur[g - 8];
            __builtin_amdgcn_sched_barrier(0);
#pragma unroll
            for (int ti = 0; ti < 4; ++ti) acc[ti] = __builtin_amdgcn_mfma_f32_16x16x32_bf16(sa, rb[g % 3][ti], acc[ti], 0, 0, 0);
            __builtin_amdgcn_sched_barrier(0);
        }
#undef SCAN_LDG
        { const int cn = c + 1 < 32 ? c + 1 : c, r0 = b * 2048 + cn * 64;
#pragma unroll
          for (int m = 0; m < 2; ++m) gnxt[m] = *(const GAS v4u*)(Pp + (size_t)(r0 + 16 * (2 * m + (quad & 1)) + r16) * PW + C_GG + h * 512 + vcol0 + 4 * (quad & 2));
          const unsigned char* gv = wsp() + WS_VT + (size_t)((b * 32 + cn) * 4 + h) * VT_B + (vcol0 + r16) * 128 + quad * 16; vnxt[0] = *(const GAS bf16x8*)gv; vnxt[1] = *(const GAS bf16x8*)(gv + 64); }
        f32x4 gb[2][2]; bf16x8 kb[2][2][2];
#define SCAN_LD3(p, s) { _Pragma("unroll") for (int e = 0; e < 2; ++e) { gb[s][e] = *(const LAS f32x4*)(Gb + (16 * (2 * (p) + e) + 4 * quad) * 4); \
            _Pragma("unroll") for (int ks = 0; ks < 2; ++ks) kb[s][e][ks] = *(const LAS bf16x8*)(Kb + r8_off(16 * (2 * (p) + e) + r16, 4 * ks + quad)); } }
        SCAN_LD3(0, 0)
        __builtin_amdgcn_sched_barrier(0);
        { const int r0 = b * 2048 + c * 64;
          const bool odd = quad & 1; float ss[4]; v2u wv[4];
#pragma unroll
          for (int m = 0; m < 2; ++m) { const v4u ld = gcur[m]; v2u own, snd, rcv;
              own.x = odd ? ld.z : ld.x; own.y = odd ? ld.w : ld.y; snd.x = odd ? ld.x : ld.z; snd.y = odd ? ld.y : ld.w;
              rcv.x = (unsigned)__shfl_xor((int)snd.x, 16); rcv.y = (unsigned)__shfl_xor((int)snd.y, 16);
              const v2u ga = odd ? rcv : own, gb2 = odd ? own : rcv;
              { const f32x4 a = acc[2 * m];     wv[2 * m].x     = pkbf(a[0] * bflo(ga.x),  a[1] * bfhi(ga.x));  wv[2 * m].y     = pkbf(a[2] * bflo(ga.y),  a[3] * bfhi(ga.y));  ss[2 * m]     = (a[0] * a[0] + a[1] * a[1]) + (a[2] * a[2] + a[3] * a[3]); }
              { const f32x4 a = acc[2 * m + 1]; wv[2 * m + 1].x = pkbf(a[0] * bflo(gb2.x), a[1] * bfhi(gb2.x)); wv[2 * m + 1].y = pkbf(a[2] * bflo(gb2.y), a[3] * bfhi(gb2.y)); ss[2 * m + 1] = (a[0] * a[0] + a[1] * a[1]) + (a[2] * a[2] + a[3] * a[3]); } }
#pragma unroll
          for (int m = 0; m < 2; ++m) { const v2u mine = odd ? wv[2 * m + 1] : wv[2 * m], snd = odd ? wv[2 * m] : wv[2 * m + 1]; v2u rcv;
              rcv.x = (unsigned)__shfl_xor((int)snd.x, 16); rcv.y = (unsigned)__shfl_xor((int)snd.y, 16);
              v4u o4; o4.x = odd ? rcv.x : mine.x; o4.y = odd ? rcv.y : mine.y; o4.z = odd ? mine.x : rcv.x; o4.w = odd ? mine.y : rcv.y;
              *(GAS v4u*)(ZBp + (size_t)(r0 + 16 * (2 * m + (quad & 1)) + r16) * D + h * 512 + vcol0 + 4 * (quad & 2)) = o4; }
#pragma unroll
          for (int ti = 0; ti < 4; ++ti) ss[ti] += __shfl_xor(ss[ti], 16);
#pragma unroll
          for (int ti = 0; ti < 4; ++ti) ss[ti] += __shfl_xor(ss[ti], 32);
          { const float sq = quad == 0 ? ss[0] : quad == 1 ? ss[1] : quad == 2 ? ss[2] : ss[3];
            atomicAdd(RSO + (size_t)h * M + r0 + 16 * quad + r16, (unsigned long long)(sq * 16777216.0f)); } }
        __builtin_amdgcn_sched_barrier(0);
#pragma unroll
        for (int p = 0; p < 8; ++p) {
            if (p + 1 < 8) SCAN_LD3(p + 1, (p + 1) & 1)
            __builtin_amdgcn_sched_barrier(0);
            S[2 * p] = S[2 * p] * gb[p & 1][0]; S[2 * p + 1] = S[2 * p + 1] * gb[p & 1][1];
#pragma unroll
            for (int ks = 0; ks < 2; ++ks)
#pragma unroll
                for (int e = 0; e < 2; ++e) S[2 * p + e] = __builtin_amdgcn_mfma_f32_16x16x32_bf16(kb[p & 1][e][ks], vcur[ks], S[2 * p + e], 0, 0, 0);
            __builtin_amdgcn_sched_barrier(0);
        }
#undef SCAN_LD3
    };
#pragma unroll 1
    for (int c2 = 0; c2 < 32; c2 += 2) { chunk(c2, vf, vn, gq, gqn); chunk(c2 + 1, vn, vf, gqn, gq); }
    __builtin_amdgcn_s_setprio(0);
    { float* dst = outp() + O_GLAP + ((size_t)((l * 4 + b) * 4 + h) * 256) * 512 + vcol0 + r16;
#pragma unroll
        for (int i = 0; i < 16; ++i)
#pragma unroll
            for (int j = 0; j < 4; ++j) dst[(size_t)(16 * i + 4 * quad + j) * 512] = S[i][j]; }
    __syncthreads();
}
constexpr int CW_Q0 = 8192;
__device__ __forceinline__ void p_gla_sample(Frame& F0, int l, int rep) {
    Frame F = F0; asm volatile("" : "+v"(F.tid), "+v"(F.lane));
    const bf16* P = (const bf16*)(wsp() + WS_P); const float* LR = (const float*)(wsp() + WS_LR);
    LAS float* QK = (LAS float*)F.lds;
    LAS float* QH = (LAS float*)(F.lds + 20480);
    LAS float* KH = (LAS float*)(F.lds + 28672);
    LAS float* VS = (LAS float*)(F.lds + 36864);
    LAS float* AS = (LAS float*)(F.lds + 53248);
    LAS float* LRs = (LAS float*)(F.lds + 53504);
    LAS float* TOT = (LAS float*)(F.lds + 54016);
    LAS int* QW = (LAS int*)(F.lds + 56064);
    LAS float* OR = (LAS float*)(F.lds + 57344);
    unsigned* qhead = (unsigned*)(wsp() + WS_CTL) + CW_Q0 + 64 * (l + 4 * rep);
    const int k = F.tid & 255, half = F.tid >> 8;
    for (;;) {
        if (F.tid == 0) QW[0] = (int)__hip_atomic_fetch_add(qhead, 1u, __ATOMIC_RELAXED, __HIP_MEMORY_SCOPE_AGENT);
        __syncthreads();
        const int unit = QW[0];
        if (unit >= 1024) break;
        const int sb = unit >> 3, h = (unit >> 1) & 3, vh = unit & 1, r0 = MP + sb * 8;
        f32x4 lrv = {0.f, 0.f, 0.f, 0.f}; if (F.tid < 32) lrv = *(const GAS f32x4*)(LR + (size_t)r0 * 16 + 4 * F.tid);
        bf16 vraw[4], qraw[4], kraw[4];
#pragma unroll
        for (int i = 0; i < 4; ++i) { const int e = i * 512 + F.tid; vraw[i] = P[(size_t)(r0 + (e >> 8)) * PW + C_V + h * 512 + vh * 256 + (e & 255)];
            qraw[i] = P[(size_t)(r0 + half * 4 + i) * PW + C_Q + h * 256 + k]; kraw[i] = P[(size_t)(r0 + half * 4 + i) * PW + C_K + h * 256 + k]; }
        float w2[16]; const float bias = inp(I_BA)[l * 1024 + h * 256 + k];
        { const float* w2p = inp(I_WA2) + (size_t)l * 16 * 1024 + h * 256 + k;
#pragma unroll
          for (int j = 0; j < 16; ++j) w2[j] = w2p[j * 1024]; }
        if (F.tid < 32) *(LAS f32x4*)(LRs + 4 * F.tid) = lrv;
#pragma unroll
        for (int i = 0; i < 4; ++i) VS[i * 512 + F.tid] = bf1(vraw[i]);
        __syncthreads();
        float bc[4]; float run = 0.f;
#pragma unroll
        for (int i = 0; i < 4; ++i) { const LAS f32x4* lr4 = (const LAS f32x4*)(LRs + (half * 4 + i) * 16); float a = bias;
#pragma unroll
            for (int j4 = 0; j4 < 4; ++j4) { const f32x4 x = lr4[j4]; a += x[0] * w2[4 * j4] + x[1] * w2[4 * j4 + 1] + x[2] * w2[4 * j4 + 2] + x[3] * w2[4 * j4 + 3]; }
            run += logsig16(a); bc[i] = run; }
        TOT[half * 256 + k] = run;
        __syncthreads();
        const float lo_tot = TOT[k], blast = lo_tot + TOT[256 + k], boff = half ? lo_tot : 0.f;
        if (half == 0) QK[k * 20 + 16] = fexp(blast);
#pragma unroll
        for (int i = 0; i < 4; ++i) { const int t = half * 4 + i; const float bt = bc[i] + boff;
            const float qv = bf1(qraw[i]) * 0.0625f * fexp(bt), kv = bf1(kraw[i]);
            QK[k * 20 + t] = qv; QK[k * 20 + 8 + t] = kv * fexp(blast - bt); QH[t * 256 + k] = qv; KH[t * 256 + k] = kv * fexp(-bt); }
        __syncthreads();
        { const int e = F.tid >> 3, part = F.tid & 7, t = e >> 3, sq = e & 7; float a = 0.f;
#pragma unroll
          for (int i = 0; i < 32; ++i) a += QH[t * 256 + part * 32 + i] * KH[sq * 256 + part * 32 + i];
          a += __shfl_xor(a, 1); a += __shfl_xor(a, 2); a += __shfl_xor(a, 4);
          if (part == 0) AS[e] = (sq <= t) ? a : 0.f; }
        const int vq4 = F.tid & 63, kr = F.tid >> 6;
        f32x4 vv[8], oa[8];
#pragma unroll
        for (int t = 0; t < 8; ++t) { vv[t] = *(const LAS f32x4*)(VS + t * 256 + 4 * vq4); oa[t] = (f32x4){0.f, 0.f, 0.f, 0.f}; }
        const float* s0p = inp(I_SGLA) + ((size_t)((l * 128 + sb) * 4 + h) * 256 + kr) * 512 + vh * 256 + 4 * vq4;
        float* s1p = outp() + O_GLAS + ((size_t)((l * 128 + sb) * 4 + h) * 256 + kr) * 512 + vh * 256 + 4 * vq4;
        f32x4 cur[8], nxt[8];
#pragma unroll
        for (int u = 0; u < 8; ++u) cur[u] = __builtin_nontemporal_load((const f32x4*)(s0p + (size_t)(8 * u) * 512));
        for (int g = 0; g < 4; ++g) {
            if (g < 3) {
#pragma unroll
                for (int u = 0; u < 8; ++u) nxt[u] = __builtin_nontemporal_load((const f32x4*)(s0p + (size_t)(8 * (8 * (g + 1) + u)) * 512)); }
#pragma unroll
            for (int u = 0; u < 8; ++u) { const int kk = 8 * (8 * g + u) + kr; const f32x4 s0 = cur[u];
                const LAS f32x4* q4 = (const LAS f32x4*)(QK + kk * 20); const f32x4 qa = q4[0], qb = q4[1], ka = q4[2], kb = q4[3]; const float gm = QK[kk * 20 + 16];
                f32x4 sn = s0 * gm;
#pragma unroll
                for (int t = 0; t < 4; ++t) { oa[t] += s0 * qa[t]; oa[4 + t] += s0 * qb[t]; sn += vv[t] * ka[t]; sn += vv[4 + t] * kb[t]; }
                __builtin_nontemporal_store(sn, (f32x4*)(s1p + (size_t)(8 * (8 * g + u)) * 512)); }
#pragma unroll
            for (int u = 0; u < 8; ++u) cur[u] = nxt[u];
        }
#pragma unroll
        for (int t = 0; t < 8; ++t) *(LAS f32x4*)(OR + (kr * 8 + t) * 256 + 4 * vq4) = oa[t];
        __syncthreads();
#pragma unroll
        for (int i = 0; i < 4; ++i) { const int e = i * 512 + F.tid, t = e >> 8, vc = e & 255; float o = 0.f;
#pragma unroll
            for (int q = 0; q < 8; ++q) o += OR[(q * 8 + t) * 256 + vc];
#pragma unroll
            for (int sq = 0; sq < 8; ++sq) o += AS[t * 8 + sq] * VS[sq * 256 + vc];
            const float sg = bf1(P[(size_t)(r0 + t) * PW + C_GG + h * 512 + vh * 256 + vc]);
            ((bf16*)(wsp() + WS_ZB))[(size_t)(r0 + t) * D + h * 512 + vh * 256 + vc] = bf1r(o * sg);
            const float ss = wave_sum(o * o);
            if (F.lane == 0) atomicAdd((unsigned long long*)(wsp() + WS_RSO) + ((size_t)l * 4 + h) * M + r0 + t, (unsigned long long)(ss * 16777216.0f)); }
        __syncthreads();
    }
}
constexpr size_t WS_FIX = 1147 * MiB;
__device__ __forceinline__ void p_convfix(Frame& F0, int l) {
    Frame F = F0; asm volatile("" : "+v"(F.tid), "+v"(F.lane));
    const float* FX = (const float*)(wsp() + WS_FIX); bf16* ZA = (bf16*)(wsp() + WS_ZA); const float* cw = inp(I_CONVW) + (size_t)l * 3 * D;
    for (int it = F.vcu * 512 + F.tid; it < 128 * 2048; it += F.G * 512) { const int blk = it >> 11, ch = it & 2047;
        if ((blk & 31) == 0) continue;
        const float c0 = FX[(size_t)(blk * 2) * 2048 + ch], c1 = FX[(size_t)(blk * 2 + 1) * 2048 + ch];
        const float h0 = FX[524288 + (size_t)(blk * 2) * 2048 + ch], h1 = FX[524288 + (size_t)(blk * 2 + 1) * 2048 + ch];
        const float t0 = FX[1048576 + (size_t)((blk - 1) * 2) * 2048 + ch], t1 = FX[1048576 + (size_t)((blk - 1) * 2 + 1) * 2048 + ch];
        const float w0 = cw[ch], w1 = cw[D + ch], w2 = cw[2 * D + ch];
        ZA[(size_t)(blk * 64) * D + ch] = bf1r(c0 * (w0 * t0 + w1 * t1 + w2 * h0));
        ZA[(size_t)(blk * 64 + 1) * D + ch] = bf1r(c1 * (w0 * t1 + w1 * h0 + w2 * h1)); }
}
__device__ __forceinline__ void rt_row(LAS float* RT, const unsigned long long* RSO, int row) {
    const GAS unsigned long long* p = (const GAS unsigned long long*)(RSO + row);
    const float q0 = (float)p[0] * (1.f / 16777216.f), q1 = (float)p[M] * (1.f / 16777216.f), q2 = (float)p[2 * M] * (1.f / 16777216.f), q3 = (float)p[3 * M] * (1.f / 16777216.f);
    const float s0 = 1.f / sqrtf(q0 * (1.f / 512.f) + EPS), s1 = 1.f / sqrtf(q1 * (1.f / 512.f) + EPS), s2 = 1.f / sqrtf(q2 * (1.f / 512.f) + EPS), s3 = 1.f / sqrtf(q3 * (1.f / 512.f) + EPS);
    *(LAS f32x4*)(RT + (row & 255) * 8) = (f32x4){s0 / s1, s1 / s2, s2 / s3, s3}; *(LAS f32x4*)(RT + (row & 255) * 8 + 4) = (f32x4){1.f / s0, 0.f, 0.f, 0.f};
}
struct Args { const float* in[14]; float* out; unsigned char* ws; int ph_lo, ph_hi; };
constexpr int N_PHASES = 2 + 5 * DEPTH;
__global__ void __launch_bounds__(NWAVES * 64, 2) fwd(Args args) {
    extern __shared__ __attribute__((aligned(16))) unsigned char lds[];
    Frame F;
    F.lds = (LAS unsigned char*)lds;
    F.tid = threadIdx.x; F.lane = F.tid & 63; F.wave = __builtin_amdgcn_readfirstlane(F.tid >> 6);
    F.G = gridDim.x; { const int bx = blockIdx.x; F.vcu = (F.G % 8 == 0) ? (bx % 8) * (F.G / 8) + bx / 8 : bx; }
    volatile LAS unsigned* MISC = (volatile LAS unsigned*)(F.lds + MISC_OFF);
    for (int u = F.tid; u < (LDS_BYTES - LDSCTL_OFF) / 4; u += NWAVES * 64) ((LAS unsigned*)(F.lds + LDSCTL_OFF))[u] = 0u;
    __syncthreads();
    const int lo = args.ph_lo, hi = args.ph_hi;
    XcdBarrier bar; bar.bar = (unsigned*)(wsp() + WS_CTL) + CW_BAR; bar.x = 0; bar.st = nullptr;
    if (hi - lo > 1) bar = xcd_barrier_post((unsigned*)(wsp() + WS_CTL) + CW_BAR, MISC + 8);
#define IN(k) (lo <= (k) && (k) < hi)
#define SEAM(k) do { if (IN(k) && IN((k) + 1)) xcd_barrier(bar); } while (0)

    #ifndef NO_P0
    if (IN(0)) { for (int rep = 0; rep < REP_PRO; ++rep) p_prologue(F); p_xprep(F, 0); }
#endif
    SEAM(0);
#pragma unroll 1
    for (int l = 0; l < DEPTH; ++l) {
        const int pb = 1 + 5 * l;
#ifndef NO_PROJ
        if (IN(pb)) {
            unsigned char* const ws = wsp(); bf16* XB = (bf16*)(ws + WS_XB); bf16* P = (bf16*)(ws + WS_P); float* LR = (float*)(ws + WS_LR); const unsigned long long* RS = (const unsigned long long*)(ws + WS_RSQ) + (size_t)l * M;
            const bf16* Wt = (const bf16*)(ws + WS_WIN + l * WIN_L);
            pg8::Gemm g{XB, Wt, M, PW, D}; pg8::ProjOrder S; S.init(F.G, (int)blockIdx.x);
            pg8::EpiProj E{P, LR, RS, (bf16*)(ws + WS_ZA), (float*)(ws + WS_FIX), inp(I_CONVW) + (size_t)l * 3 * D, inp(I_SCONV) + (size_t)l * 128 * 2 * D, outp() + O_CONVP + (size_t)l * 4 * 2 * D, outp() + O_CONVS + (size_t)l * 128 * 2 * D};
            for (int rep = 0; rep < REP_PROJ; ++rep) {
            pg8::gemm_phase<pg8::EpiProj, pg8::ProjOrder, true, true>(F.lds + RING_OFF, g, S, E);
            for (int su = (int)blockIdx.x; su < 256 + M / 128; su += F.G) {
                if (su < 256) pg8::mini_gemm(F.lds + RING_OFF, XB, Wt, D, MP + (su >> 5) * 128, C_GG + (su & 31) * 64, E); else pg8::mini_gemm(F.lds + RING_OFF, XB, Wt, D, (su - 256) * 128, PW, E); }
            }
        }
#endif
        SEAM(pb);
        if (IN(pb + 1)) {
#ifndef NO_CONV
            for (int rep = 0; rep < REP_PREP; ++rep) p_convfix(F, l);
#endif
#ifndef NO_GLA
            for (int rep = 0; rep < REP_PREP; ++rep) p_gla_prep(F, l);
#endif
        } SEAM(pb + 1);
        if (IN(pb + 2)) {
#ifndef NO_GLA
            for (int rep = 0; rep < REP_SCAN; ++rep) { p_gla_scan(F, l); p_gla_sample(F, l, rep); }
#endif
        } SEAM(pb + 2);
#ifndef NO_BR
        if (IN(pb + 3)) {
            unsigned char* const ws = wsp(); bf16* P = (bf16*)(ws + WS_P); bf16* ZA = (bf16*)(ws + WS_ZA); bf16* ZB = (bf16*)(ws + WS_ZB); bf16* MG = (bf16*)(ws + WS_MG);
            const bf16* WtA = (const bf16*)(ws + WS_WA + l * W_L); const bf16* WtB = (const bf16*)(ws + WS_WB + l * W_L);
            LAS float* RT = (LAS float*)(F.lds + RT_OFF); const unsigned long long* RSO = (const unsigned long long*)(ws + WS_RSO) + (size_t)l * M * 4;
            pg8::StaticOrder S; S.init(MP, D, F.G, (int)blockIdx.x);
            pg8::EpiBrA2 EA{P + C_GA, P + C_GB, RT}; pg8::EpiBrB2 EB{P + C_GB, MG, RT};
            { pg8::Unit u0; if (S.next(0, u0) && F.tid < 256) rt_row(RT, RSO, u0.pm * 256 + F.tid); __syncthreads(); }
            { pg8::Gemm g{ZA, WtA, MP, D, D, ZB, WtB}; pg8::PairOrder S2; S2.init(MP, D, F.G, (int)blockIdx.x); pg8::EpiBr EE{EA, EB};
              pg8::gemm_phase<pg8::EpiBr, pg8::PairOrder, true, true>(F.lds + RING_OFF, g, S2, EE); }
            for (int su = (int)blockIdx.x; su < 256; su += F.G) { __syncthreads(); if (F.tid < 128) rt_row(RT, RSO, MP + (su >> 5) * 128 + F.tid); __syncthreads();
                f32x4 a2[2][2];
                pg8::mini_gemm_acc<pg8::EpiBrA2, true>(F.lds + RING_OFF, ZA, WtA, D, MP + (su >> 5) * 128, (su & 31) * 64, EA, a2);
                pg8::mini_gemm_acc<pg8::EpiBrB2, false>(F.lds + RING_OFF, ZB, WtB, D, MP + (su >> 5) * 128, (su & 31) * 64, EB, a2); }
        }
#endif
        SEAM(pb + 3);
#ifndef NO_OUT
        if (IN(pb + 4)) {
            unsigned char* const ws = wsp(); bf16* MG = (bf16*)(ws + WS_MG);
            const bf16* Wt = (const bf16*)(ws + WS_WO + l * W_L); pg8::Gemm g{MG, Wt, MP, D, D}; pg8::StaticOrder S; S.init(MP, D, F.G, (int)blockIdx.x);
            for (int rep = 0; rep < REP_OUT; ++rep) {
            LAS unsigned long long* rowsum = (LAS unsigned long long*)(F.lds + ROWSUM_OFF); unsigned long long* RSQn = (unsigned long long*)(ws + WS_RSQ) + (size_t)(rep > 0 ? DEPTH + 1 : l + 1) * M;
            if (F.tid < 256) rowsum[F.tid] = 0ull;
            __syncthreads();
            pg8::EpiOut E{(bf16*)(ws + (rep > 0 ? WS_ZA : WS_XB)), rowsum};
            pg8::gemm_phase<pg8::EpiOut, pg8::StaticOrder, true, true>(F.lds + RING_OFF, g, S, E);
            { pg8::Unit u0; const bool has = S.next(0, u0); asm volatile("s_waitcnt lgkmcnt(0)" ::: "memory"); __syncthreads();
              if (has && F.tid < 256) { atomicAdd(RSQn + u0.pm * 256 + F.tid, rowsum[F.tid]); rowsum[F.tid] = 0ull; } __syncthreads(); }
            for (int su = (int)blockIdx.x; su < 256; su += F.G) { pg8::mini_gemm(F.lds + RING_OFF, MG, Wt, D, MP + (su >> 5) * 128, (su & 31) * 64, E);
                asm volatile("s_waitcnt lgkmcnt(0)" ::: "memory"); __syncthreads();
                if (F.tid < 128) { const int row = MP + (su >> 5) * 128 + F.tid; atomicAdd(RSQn + row, rowsum[row & 255]); rowsum[row & 255] = 0ull; } __syncthreads(); }
            }
        }
#endif
        SEAM(pb + 4);
    }
    if (IN(1 + 5 * DEPTH)) p_final(F);
#undef IN
#undef SEAM
}

#ifndef MK_SINGLE
#define MK_SINGLE 1
#endif
extern "C" void kernel_launch(void* const* d_in, const int* in_sizes, int n_in, void* d_out, int out_size, void* d_ws, size_t ws_size, hipStream_t stream) {
    static int grid = 0;
    if (grid == 0) {
        if (n_in != 14 || (size_t)out_size != O_END || ws_size < WS_FIX + 6 * MiB) { fprintf(stderr, "kernel_launch: unexpected shapes (n_in %d out %d ws %zu)\n", n_in, out_size, ws_size); grid = -1; return; }
        int dev = 0, cus = 0, per_cu = 0;
        if (hipGetDevice(&dev) != hipSuccess || hipDeviceGetAttribute(&cus, hipDeviceAttributeMultiprocessorCount, dev) != hipSuccess) { grid = -1; return; }
        if (hipFuncSetAttribute((const void*)fwd, hipFuncAttributeMaxDynamicSharedMemorySize, LDS_BYTES) != hipSuccess) { fprintf(stderr, "kernel_launch: hipFuncSetAttribute failed\n"); grid = -1; return; }
        if (hipOccupancyMaxActiveBlocksPerMultiprocessor(&per_cu, (const void*)fwd, NWAVES * 64, LDS_BYTES) != hipSuccess || per_cu < 1) fprintf(stderr, "kernel_launch: occupancy query reports %d\n", per_cu);
        (void)hipGetLastError();
        grid = cus;
    }
    if (grid < 0) return;
    if (hipMemsetAsync((char*)d_ws + WS_CTL, 0, CTL_ZERO_BYTES, stream) != hipSuccess) return;
    Args a{};
    for (int i = 0; i < 14; ++i) a.in[i] = (const float*)d_in[i];
    a.out = (float*)d_out; a.ws = (unsigned char*)d_ws;
#if MK_SINGLE
    a.ph_lo = 0; a.ph_hi = N_PHASES;
    hipLaunchKernelGGL(fwd, dim3(grid), dim3(NWAVES * 64), LDS_BYTES, stream, a);
#else
    for (int p = 0; p < N_PHASES; ++p) { a.ph_lo = p; a.ph_hi = p + 1; hipLaunchKernelGGL(fwd, dim3(grid), dim3(NWAVES * 64), LDS_BYTES, stream, a); }
#endif
}
```

```cpp
#include <hip/hip_runtime.h>
#include <cstdio>
#include <cstdint>
#define REP_PROJ 1
#define REP_PREP 1
#define REP_SCAN 1
#define REP_ZB 1
#define REP_BR 1
#define REP_XN 1
#define REP_PRO 1
#define REP_MINI 1
#define REP_OUT 1
namespace pg8 {
#define PG8_LAS __attribute__((address_space(3)))
typedef unsigned short bf16_t;
typedef short bf16x8 __attribute__((ext_vector_type(8)));
typedef float f32x4 __attribute__((ext_vector_type(4)));
typedef unsigned u32x4 __attribute__((ext_vector_type(4)));
constexpr int BM = 256, BK = 64, HALF = 128, HTB = HALF * BK * 2  , STAGE_BYTES = 8 * HTB, NXCD = 8, WGM = 8;

__host__ __device__ __forceinline__ int lds_byte(int r, int c) { const int st = (r >> 4) * 2 + (c >> 5), rr = r & 15, cc = c & 31, ob = rr * 64 + cc * 2; return st * 1024 + (ob ^ (((ob >> 9) & 1) << 5)); }
__host__ __device__ __forceinline__ void stage_rc(int b, int& R, int& C) { const int st = b / 1024, sb = b % 1024, swz = sb ^ (((sb >> 9) & 1) << 5); R = (st >> 1) * 16 + swz / 64; C = (st & 1) * 32 + (swz % 64) / 2; }
__host__ __device__ __forceinline__ int perm32(int rho) { const int n = rho >> 4, i = rho & 15; return 8 * (i >> 2) + 4 * n + (i & 3); }

struct Unit { int pm, pn, sel; };
struct Gemm { const bf16_t* A; const bf16_t* Bt; int M, N, K; const bf16_t* A2; const bf16_t* Bt2; };

struct StaticOrder {
    int nM, nN, nwg, G, c;
    __host__ __device__ void init(int M, int N, int G_, int c_) { nM = M / BM; nN = N / BM; nwg = nM * nN; G = G_; c = c_; }
    __host__ __device__ bool next(int i, Unit& u) const {
        const long L = (long)i * G + c; if (L >= nwg) return false;
        int wgid = (int)L; { const int q = nwg / NXCD, r = nwg % NXCD, xcd = wgid % NXCD, off = wgid / NXCD; wgid = (xcd < r ? xcd * (q + 1) : r * (q + 1) + (xcd - r) * q) + off; }
        const int nig = WGM * nN, gid = wgid / nig, fm = gid * WGM, gsz = (nM - fm) < WGM ? (nM - fm) : WGM;
        u.pm = fm + ((wgid % nig) % gsz); u.pn = (wgid % nig) / gsz; u.sel = 0; return true;
    }
    __device__ __forceinline__ void a_ready(const Unit&) const {}
    __device__ __forceinline__ void done(const Unit&) const {}
};
__device__ __forceinline__ unsigned cvt_pk_bf16(float lo, float hi) { unsigned r; asm volatile("v_cvt_pk_bf16_f32 %0, %1, %2" : "=v"(r) : "v"(lo), "v"(hi)); return r; }
constexpr int PW = 18432;
__device__ __forceinline__ float sigm(float x) { return __builtin_amdgcn_rcpf(1.0f + __builtin_amdgcn_exp2f(-1.44269504f * x)); }
__device__ __forceinline__ float bflo(unsigned w) { return __uint_as_float(w << 16); }
__device__ __forceinline__ float bfhi(unsigned w) { return __uint_as_float(w & 0xffff0000u); }
__device__ __forceinline__ u32x4 pack8(const f32x4 v0, const f32x4 v1) { u32x4 w; w.x = cvt_pk_bf16(v0[0], v0[1]); w.y = cvt_pk_bf16(v0[2], v0[3]); w.z = cvt_pk_bf16(v1[0], v1[1]); w.w = cvt_pk_bf16(v1[2], v1[3]); return w; }
constexpr int PG8_RTAB_OFF = 150528;
struct EpiProj {
    static constexpr int DEPTH = 4; static constexpr bool MIDK = false, CONV = true, INPLACE = false, PAIR = false, RSTAB = true;
    bf16_t* P; float* LR; const unsigned long long* rsq;
    bf16_t* ZA; float* FIX; const float* convw; const float* sconv; float* ocp; float* ocs; mutable const PG8_LAS unsigned char* tab = nullptr;
    static __device__ __forceinline__ f32x4 ror(const f32x4 x, int n) { f32x4 y;
#pragma unroll
        for (int j = 0; j < 4; ++j) y[j] = __int_as_float(n == 1 ? __builtin_amdgcn_update_dpp(0, __float_as_int(x[j]), 0x121, 0xf, 0xf, false) : __builtin_amdgcn_update_dpp(0, __float_as_int(x[j]), 0x122, 0xf, 0xf, false)); return y; }
    __device__ __forceinline__ void conv_unit(const f32x4 (&acc)[2][2][4][2], const Unit& u, int wr, int wc, int fr, int fq) const {
        const int ch0 = 64 * (u.pn - 16) + 16 * wc + 4 * fq; const bool sample = u.pm >= 32;
        const PG8_LAS float* wt = (const PG8_LAS float*)(tab + 2048) + 16 * wc + 4 * fq;
        const f32x4 w0 = *(const PG8_LAS f32x4*)wt, w1 = *(const PG8_LAS f32x4*)(wt + 64), w2 = *(const PG8_LAS f32x4*)(wt + 128);
        unsigned long long rq[2][4];
#pragma unroll
        for (int ai = 0; ai < 2; ++ai)
#pragma unroll
            for (int m = 0; m < 4; ++m) rq[ai][m] = *(const PG8_LAS unsigned long long*)(tab + (ai * HALF + wr * 64 + m * 16 + fr) * 8);
#pragma unroll
        for (int ai = 0; ai < 2; ++ai) { const int br0 = u.pm * BM + ai * HALF + wr * 64, blk = br0 >> 6; const bool seqstart = (br0 & 2047) == 0, seqend = ((br0 + 64) & 2047) == 0;
            f32x4 uprev = {0.f, 0.f, 0.f, 0.f};
#pragma unroll
            for (int m = 0; m < 4; ++m) { const int r = br0 + m * 16 + fr;
                const float rstd = __builtin_amdgcn_rsqf((float)rq[ai][m] * (1.0f / 16777216.0f) * (1.0f / 2048.0f) + 1e-6f);
                const f32x4 cB = acc[ai][0][m][0] * rstd, cC = acc[ai][0][m][1] * rstd, cx = acc[ai][1][m][0] * rstd; f32x4 cg = acc[ai][1][m][1] * rstd;
#pragma unroll
                for (int j = 0; j < 4; ++j) cg[j] = cg[j] * sigm(cg[j]);
                const f32x4 uu = cC * cx, cbg = cB * cg, t1 = ror(uu, 1), t2 = ror(uu, 2);
                f32x4 u1, u2;
                if (!sample) { const f32x4 p1 = ror(uprev, 1), p2 = ror(uprev, 2);
#pragma unroll
                    for (int j = 0; j < 4; ++j) { u1[j] = fr >= 1 ? t1[j] : p1[j]; u2[j] = fr >= 2 ? t2[j] : p2[j]; }
                } else { const int t = fr & 7, sb = (r - 8192) >> 3; const f32x4 b0 = *(const f32x4*)(sconv + (size_t)sb * 4096 + ch0), b1 = *(const f32x4*)(sconv + (size_t)sb * 4096 + 2048 + ch0);
#pragma unroll
                    for (int j = 0; j < 4; ++j) { u1[j] = t >= 1 ? t1[j] : b1[j]; u2[j] = t >= 2 ? t2[j] : (t == 1 ? b1[j] : b0[j]); }
                    if (t >= 6) *(f32x4*)(ocs + (size_t)sb * 4096 + (t - 6) * 2048 + ch0) = uu; }
                const f32x4 z = cbg * (w0 * u2 + w1 * u1 + w2 * uu);
                if (!sample && m == 0 && fr < 2 && !seqstart) {
                    *(f32x4*)(FIX + ((size_t)(blk * 2 + fr)) * 2048 + ch0) = cbg; *(f32x4*)(FIX + (size_t)524288 + ((size_t)(blk * 2 + fr)) * 2048 + ch0) = uu;
                } else { typedef unsigned u32x2 __attribute__((ext_vector_type(2))); u32x2 w; w.x = cvt_pk_bf16(z[0], z[1]); w.y = cvt_pk_bf16(z[2], z[3]); *(u32x2*)(ZA + (size_t)r * 2048 + ch0) = w; }
                if (!sample && m == 3 && fr >= 14) { *(f32x4*)(FIX + (size_t)1048576 + ((size_t)(blk * 2 + fr - 14)) * 2048 + ch0) = uu;
                    if (seqend) *(f32x4*)(ocp + ((size_t)(br0 >> 11) * 2 + (fr - 14)) * 2048 + ch0) = uu; }
                uprev = uu; } }
    }
    struct Pre { float rs; };
    __device__ __forceinline__ Pre pre(int r, int) const { Pre p; p.rs = (float)rsq[r] * (1.0f / 16777216.0f); return p; }
    __device__ __forceinline__ Pre pre_t(int r) const { Pre p; p.rs = (float)(*(const PG8_LAS unsigned long long*)(tab + (r & 255) * 8)) * (1.0f / 16777216.0f); return p; }
    __device__ __forceinline__ void tab_stage(PG8_LAS unsigned char* lds, const Unit& u, int slot, int wid, int lane) const {
        PG8_LAS unsigned char* t = lds + PG8_RTAB_OFF + slot * 3072;
        if (wid < 2) __builtin_amdgcn_global_load_lds((const unsigned*)((const char*)rsq + ((size_t)u.pm * 256 + wid * 128) * 8 + lane * 16), (PG8_LAS unsigned*)(t + wid * 1024), 16, 0, 0);
        else if (wid == 2) { const int pc = (u.pn >= 16 && u.pn < 48) ? u.pn - 16 : 0, L = lane < 48 ? lane : 47;
            __builtin_amdgcn_global_load_lds((const unsigned*)((const char*)convw + ((size_t)(L >> 4) * 2048 + 64 * pc + 4 * (L & 15)) * 4), (PG8_LAS unsigned*)(t + 2048), 16, 0, 0); }
    }
    __device__ __forceinline__ void tab_set(PG8_LAS unsigned char* lds, int slot) const { tab = lds + PG8_RTAB_OFF + slot * 3072; }
    __device__ __forceinline__ void fin(int r, int c, f32x4 v0, f32x4 v1, const Pre& p) const {
        const int t = c >> 8; const float rstd = __builtin_amdgcn_rsqf(p.rs * (1.0f / 2048.0f) + 1e-6f); v0 = v0 * rstd; v1 = v1 * rstd;
        if (t >= 72) { const int cc = c - 72 * 256; if (cc < 16) { *(f32x4*)(LR + (size_t)r * 16 + cc) = v0; *(f32x4*)(LR + (size_t)r * 16 + cc + 4) = v1; } return; }
        const int mode = (t < 16) ? 1 : (((t >= 40 && t < 48) || t >= 64) ? 2 : 0);
        if (mode == 1) {
#pragma unroll
            for (int j = 0; j < 4; ++j) { v0[j] = sigm(v0[j]); v1[j] = sigm(v1[j]); } }
        if (mode == 2) {
#pragma unroll
            for (int j = 0; j < 4; ++j) { v0[j] = v0[j] * sigm(v0[j]); v1[j] = v1[j] * sigm(v1[j]); } }
        *(u32x4*)(P + (size_t)r * PW + c) = pack8(v0, v1);
    }
};
struct EpiBrA2 {
    static constexpr int DEPTH = 4; static constexpr bool MIDK = false, CONV = false, INPLACE = true, PAIR = false, RSTAB = false;
    const bf16_t* GA; const bf16_t* GB; const PG8_LAS float* RT;
    struct Pre { u32x4 a, b; };
    __device__ __forceinline__ Pre pre(int r, int c) const { Pre p; p.a = *(const u32x4*)(GA + (size_t)r * PW + c); p.b = *(const u32x4*)(GB + (size_t)r * PW + c); return p; }
    static __device__ __forceinline__ float fac(float ga, float gb, float i0) { return ga * __builtin_amdgcn_rcpf(fmaxf(gb, 1e-30f)) * i0; }
    __device__ __forceinline__ void fin_ip(int r, int, f32x4& v0, f32x4& v1, const Pre& p) const {
        const float i0 = RT[(r & 255) * 8 + 4];
        v0[0] *= fac(bflo(p.a.x), bflo(p.b.x), i0); v0[1] *= fac(bfhi(p.a.x), bfhi(p.b.x), i0); v0[2] *= fac(bflo(p.a.y), bflo(p.b.y), i0); v0[3] *= fac(bfhi(p.a.y), bfhi(p.b.y), i0);
        v1[0] *= fac(bflo(p.a.z), bflo(p.b.z), i0); v1[1] *= fac(bfhi(p.a.z), bfhi(p.b.z), i0); v1[2] *= fac(bflo(p.a.w), bflo(p.b.w), i0); v1[3] *= fac(bfhi(p.a.w), bfhi(p.b.w), i0);
    }
};
struct EpiBrB2 {
    static constexpr int DEPTH = 8; static constexpr bool MIDK = true, CONV = false, INPLACE = false, PAIR = false, RSTAB = false;
    const bf16_t* GB; bf16_t* MG; const PG8_LAS float* RT;
    struct Pre { u32x4 g; };
    __device__ __forceinline__ Pre pre(int r, int c) const { Pre p; p.g = *(const u32x4*)(GB + (size_t)r * PW + c); return p; }
    __device__ __forceinline__ void fin(int r, int c, f32x4 v0, f32x4 v1, const Pre& p) const {
        const float s3 = RT[(r & 255) * 8 + 3];
        v0[0] *= s3 * fmaxf(bflo(p.g.x), 1e-30f); v0[1] *= s3 * fmaxf(bfhi(p.g.x), 1e-30f); v0[2] *= s3 * fmaxf(bflo(p.g.y), 1e-30f); v0[3] *= s3 * fmaxf(bfhi(p.g.y), 1e-30f);
        v1[0] *= s3 * fmaxf(bflo(p.g.z), 1e-30f); v1[1] *= s3 * fmaxf(bfhi(p.g.z), 1e-30f); v1[2] *= s3 * fmaxf(bflo(p.g.w), 1e-30f); v1[3] *= s3 * fmaxf(bfhi(p.g.w), 1e-30f);
        *(u32x4*)(MG + (size_t)r * 2048 + c) = pack8(v0, v1);
    }
    __device__ __forceinline__ float ratio(int r, int seg) const { return RT[(r & 255) * 8 + seg]; }
};
struct EpiBr {
    static constexpr int DEPTH = 8; static constexpr bool MIDK = true, CONV = false, INPLACE = false, PAIR = true, RSTAB = false;
    EpiBrA2 a; EpiBrB2 b;
    __device__ __forceinline__ float ratio(int r, int seg) const { return b.ratio(r, seg); }
};
struct PairOrder {
    StaticOrder so;
    __device__ void init(int M, int N, int G_, int c_) { so.init(M, N, G_, c_); }
    __device__ bool next(int i, Unit& u) const { if (!so.next(i >> 1, u)) return false; u.sel = i & 1; return true; }
    __device__ __forceinline__ void a_ready(const Unit&) const {}
    __device__ __forceinline__ void done(const Unit&) const {}
};
struct EpiOut {
    static constexpr int DEPTH = 8; static constexpr bool MIDK = false, CONV = false, INPLACE = false, PAIR = false, RSTAB = false;
    bf16_t* XB; PG8_LAS unsigned long long* rowsum;
    struct Pre { u32x4 x; };
    __device__ __forceinline__ Pre pre(int r, int c) const { Pre p; p.x = *(const u32x4*)(XB + (size_t)r * 2048 + c); return p; }
    __device__ __forceinline__ void fin(int r, int c, f32x4 v0, f32x4 v1, const Pre& p) const {
        v0[0] += bflo(p.x.x); v0[1] += bfhi(p.x.x); v0[2] += bflo(p.x.y); v0[3] += bfhi(p.x.y); v1[0] += bflo(p.x.z); v1[1] += bfhi(p.x.z); v1[2] += bflo(p.x.w); v1[3] += bfhi(p.x.w);
        *(u32x4*)(XB + (size_t)r * 2048 + c) = pack8(v0, v1);
        const float ss = (v0[0] * v0[0] + v0[1] * v0[1]) + (v0[2] * v0[2] + v0[3] * v0[3]) + (v1[0] * v1[0] + v1[1] * v1[1]) + (v1[2] * v1[2] + v1[3] * v1[3]);
        (void)__hip_atomic_fetch_add(rowsum + (r & 255), (unsigned long long)(ss * 16777216.0f), __ATOMIC_RELAXED, __HIP_MEMORY_SCOPE_WORKGROUP);
    }
};
template <class Epi> __device__ __forceinline__ void epi_big(const Epi& E, f32x4 (&acc)[2][2][4][2], const Unit& u, int wr, int wc, int fr, int fq) {
    if constexpr (Epi::PAIR) { if (u.sel == 0) epi_big(E.a, acc, u, wr, wc, fr, fq); else epi_big(E.b, acc, u, wr, wc, fr, fq); return; } else {
    if constexpr (Epi::CONV) { if (u.pn >= 16 && u.pn < 48) { E.conv_unit(acc, u, wr, wc, fr, fq); return; } }
    const int row0 = u.pm * BM + wr * 64 + fr, col0 = u.pn * BM + wc * 32 + 8 * fq;
    constexpr int DP = Epi::DEPTH;
    typename Epi::Pre pq[DP];
#define EPI_R(i) (row0 + ((i) >> 3) * HALF + (((i) >> 1) & 3) * 16)
#define EPI_C(i) (col0 + ((i) & 1) * HALF)
#pragma unroll
    for (int i = 0; i < DP; ++i) { if constexpr (Epi::RSTAB) pq[i] = E.pre_t(EPI_R(i)); else pq[i] = E.pre(EPI_R(i), EPI_C(i)); }
#pragma unroll
    for (int idx = 0; idx < 16; ++idx) { const int ai = idx >> 3, m = (idx >> 1) & 3, bj = idx & 1;
        if constexpr (Epi::INPLACE) E.fin_ip(EPI_R(idx), EPI_C(idx), acc[ai][bj][m][0], acc[ai][bj][m][1], pq[idx % DP]); else E.fin(EPI_R(idx), EPI_C(idx), acc[ai][bj][m][0], acc[ai][bj][m][1], pq[idx % DP]);
        asm volatile("" ::: "memory");
        if (idx + DP < 16) { if constexpr (Epi::RSTAB) pq[idx % DP] = E.pre_t(EPI_R(idx + DP)); else pq[idx % DP] = E.pre(EPI_R(idx + DP), EPI_C(idx + DP)); } }
#undef EPI_R
#undef EPI_C
    }
}
#define PG8_GAS __attribute__((address_space(1)))
constexpr int MINI_SLOT = 24576;
template <class Epi, bool ZERO0> __device__ __forceinline__ void mini_gemm_acc(PG8_LAS unsigned char* lds, const bf16_t* A, const bf16_t* Bt, int K, int row0, int col0, const Epi& E, f32x4 (&acc)[2][2]) {
    int tid_ = threadIdx.x; asm volatile("" : "+v"(tid_));
    const int tid = tid_, wid = __builtin_amdgcn_readfirstlane(tid >> 6), lane = tid & 63, r16 = lane & 15, quad = lane >> 4, wrow = wid >> 1, wcol = wid & 1;
    const PG8_GAS char* src[3];
#pragma unroll
    for (int i = 0; i < 2; ++i) { const int q = 64 * (wid + 8 * i) + lane, row = q >> 3, p = (q & 7) ^ ((row >> 1) & 7); src[i] = (const PG8_GAS char*)(A + (size_t)(row0 + row) * K + 8 * p); }
    { const int q = 64 * wid + lane, row = q >> 3, p = (q & 7) ^ ((row >> 1) & 7); src[2] = (const PG8_GAS char*)(Bt + (size_t)(col0 + (row & ~31) + perm32(row & 31)) * K + 8 * p); }
    const int nkt = K / 64;
    const int dst0 = wid * 1024 + lane * 16, dst1 = (wid + 8) * 1024 + lane * 16, dst2 = (16 + wid) * 1024 + lane * 16;
    if constexpr (ZERO0) {
#pragma unroll
    for (int i = 0; i < 2; ++i)
#pragma unroll
        for (int j = 0; j < 2; ++j) acc[i][j] = (f32x4){0.f, 0.f, 0.f, 0.f};
    }
    int aoff[2], boff[2];
#pragma unroll
    for (int t = 0; t < 2; ++t) { const int ra = 32 * wrow + 16 * t + r16, rb = 32 * wcol + 16 * t + r16; aoff[t] = ra * 128; boff[t] = 16384 + rb * 128; }
    const int sw = (r16 >> 1) & 7;
    constexpr int PD = 4;
    u32x4 q[PD][3];
#pragma unroll
    for (int p = 0; p < PD; ++p)
#pragma unroll
        for (int i = 0; i < 3; ++i) q[p][i] = *(const PG8_GAS u32x4*)(src[i] + (size_t)p * 128);
#pragma unroll 1
    for (int kt0 = 0; kt0 < nkt; kt0 += PD) {
#pragma unroll
        for (int p = 0; p < PD; ++p) { const int kt = kt0 + p;
            PG8_LAS unsigned char* sl = lds + (p & 1) * MINI_SLOT;
            *(PG8_LAS u32x4*)(sl + dst0) = q[p][0]; *(PG8_LAS u32x4*)(sl + dst1) = q[p][1]; *(PG8_LAS u32x4*)(sl + dst2) = q[p][2];
            { const int kk = kt + PD < nkt ? kt + PD : nkt - 1;
#pragma unroll
              for (int i = 0; i < 3; ++i) q[p][i] = *(const PG8_GAS u32x4*)(src[i] + (size_t)kk * 128); }
            asm volatile("s_waitcnt lgkmcnt(0)" ::: "memory"); __builtin_amdgcn_s_barrier(); asm volatile("" ::: "memory");
            if constexpr (Epi::MIDK) { if (p == 0 && (kt0 == 8 || kt0 == 16 || kt0 == 24)) { const int seg = (kt0 >> 3) - 1;
#pragma unroll
                for (int mt = 0; mt < 2; ++mt) { const float rho = E.ratio(row0 + 32 * wrow + 16 * mt + r16, seg); acc[mt][0] = acc[mt][0] * rho; acc[mt][1] = acc[mt][1] * rho; } } }
#pragma unroll
            for (int ks = 0; ks < 2; ++ks) { bf16x8 af[2], bfr[2];
#pragma unroll
                for (int t = 0; t < 2; ++t) { af[t] = *(const PG8_LAS bf16x8*)(sl + aoff[t] + (((4 * ks + quad) ^ sw) << 4)); bfr[t] = *(const PG8_LAS bf16x8*)(sl + boff[t] + (((4 * ks + quad) ^ sw) << 4)); }
#pragma unroll
                for (int mt = 0; mt < 2; ++mt)
#pragma unroll
                    for (int nt = 0; nt < 2; ++nt) acc[mt][nt] = __builtin_amdgcn_mfma_f32_16x16x32_bf16(bfr[nt], af[mt], acc[mt][nt], 0, 0, 0); }
        }
    }
    asm volatile("s_waitcnt lgkmcnt(0)" ::: "memory"); __builtin_amdgcn_s_barrier(); asm volatile("" ::: "memory");
    const int r = row0 + 32 * wrow + r16, c = col0 + 32 * wcol + 8 * quad;
    typename Epi::Pre p0 = E.pre(r, c), p1 = E.pre(r + 16, c);
    if constexpr (Epi::INPLACE) { E.fin_ip(r, c, acc[0][0], acc[0][1], p0); E.fin_ip(r + 16, c, acc[1][0], acc[1][1], p1); }
    else { E.fin(r, c, acc[0][0], acc[0][1], p0); E.fin(r + 16, c, acc[1][0], acc[1][1], p1); }
}
template <class Epi> __device__ __forceinline__ void mini_gemm(PG8_LAS unsigned char* lds, const bf16_t* A, const bf16_t* Bt, int K, int row0, int col0, const Epi& E) { f32x4 acc[2][2]; mini_gemm_acc<Epi, true>(lds, A, Bt, K, row0, col0, E, acc); }
struct ProjOrder {
    StaticOrder so; int G, c;
    __device__ void init(int G_, int c_) { so.init(8192, 18432, G_, c_); G = G_; c = c_; }
    __device__ bool next(int i, Unit& u) const {
        const long L = (long)i * G + c;
        if (L < 2304) return so.next(i, u);
        if (L < 2560) { const int j = (int)L - 2304; u.pm = 32 + (j & 3); u.pn = j >> 2; u.sel = 0; return true; }
        return false;
    }
    __device__ __forceinline__ void a_ready(const Unit&) const {}
    __device__ __forceinline__ void done(const Unit&) const {}
};
template <class Epi, class Sched, bool ALIGN_EPI, bool SP2, bool ZERO0>
__device__ __forceinline__ void gemm_phase_acc(PG8_LAS unsigned char* lds, const Gemm g, const Sched& S, const Epi& E, f32x4 (&acc)[2][2][4][2]) {
    int tid_ = threadIdx.x; asm volatile("" : "+v"(tid_));
    const int tid = tid_, wid = __builtin_amdgcn_readfirstlane(tid >> 6), lane = tid & 63, wr = wid >> 2, wc = wid & 3, fr = lane & 15, fq = lane >> 4;
    const int K = g.K, nt = K / BK;
    unsigned voffA[2], voffB[2];
#pragma unroll
    for (int i = 0; i < 2; ++i) { int R, C; stage_rc(tid * 16 + i * 8192, R, C); const int Rb = (R & ~31) + perm32(R & 31);
        voffA[i] = (unsigned)(R * K + C) * 2u; voffB[i] = (unsigned)(Rb * K + C) * 2u; }
    const size_t kstep = (size_t)(BK * 2);
    const size_t hstep = (size_t)HALF * K * 2;
    const size_t tstep = 2 * hstep;
    const unsigned ldsw = (unsigned)wid * 1024u;
    const int aoff = lds_byte(wr * 64 + fr, fq * 8), boff = lds_byte(wc * 32 + fr, fq * 8);
#define PG8_SA(b, h) (((b) * 2 + (h)) * HTB)
#define PG8_SB(b, h) ((4 + (b) * 2 + (h)) * HTB)
#define PG8_STAGE(bufoff, gbase, voff) do { _Pragma("unroll") for (int _i = 0; _i < 2; ++_i) \
        __builtin_amdgcn_global_load_lds((const unsigned*)((const char*)(gbase) + (voff)[_i]), (PG8_LAS unsigned*)(lds + (bufoff) + ldsw + _i * 8192), 16, 0, 0); } while (0)
#define PG8_LDA(dst, b, h) do { _Pragma("unroll") for (int m = 0; m < 4; ++m) _Pragma("unroll") for (int k = 0; k < 2; ++k) dst[m][k] = *(const PG8_LAS bf16x8*)(lds + PG8_SA(b, h) + aoff + m * 2048 + k * 1024); } while (0)
#define PG8_LDB(dst, b, h) do { _Pragma("unroll") for (int n = 0; n < 2; ++n) _Pragma("unroll") for (int k = 0; k < 2; ++k) dst[n][k] = *(const PG8_LAS bf16x8*)(lds + PG8_SB(b, h) + boff + n * 2048 + k * 1024); } while (0)
#define PG8_MMA(ai, bj, At, Bt) do { __builtin_amdgcn_s_setprio(1); _Pragma("unroll") for (int m = 0; m < 4; ++m) _Pragma("unroll") for (int n = 0; n < 2; ++n) _Pragma("unroll") for (int k = 0; k < 2; ++k) \
        acc[ai][bj][m][n] = __builtin_amdgcn_mfma_f32_16x16x32_bf16(Bt[n][k], At[m][k], acc[ai][bj][m][n], 0, 0, 0); __builtin_amdgcn_s_setprio(0); } while (0)
#define PG8_WAIT_V(n) asm volatile("s_waitcnt vmcnt(" #n ")" ::: "memory")
#define PG8_WAIT_L(n) asm volatile("s_waitcnt lgkmcnt(" #n ")" ::: "memory")
#define PG8_BAR __builtin_amdgcn_s_barrier()
#define PG8_SCHED __builtin_amdgcn_sched_barrier(0)
    Unit cur, nxt; int ui = 0;
    if (!S.next(0, cur)) return;
    if constexpr (ZERO0) {
#pragma unroll
    for (int a = 0; a < 2; ++a)
#pragma unroll
        for (int b = 0; b < 2; ++b)
#pragma unroll
            for (int m = 0; m < 4; ++m)
#pragma unroll
                for (int n = 0; n < 2; ++n) acc[a][b][m][n] = (f32x4){0.f, 0.f, 0.f, 0.f};
    }
    bf16x8 At[4][2], B0[2][2], B1[2][2];
    const char* cA = (const char*)(cur.sel ? g.A2 : g.A) + (size_t)cur.pm * tstep; const char* cB = (const char*)(cur.sel ? g.Bt2 : g.Bt) + (size_t)cur.pn * tstep;
    S.a_ready(cur);
    if constexpr (Epi::RSTAB) E.tab_stage(lds, cur, 0, wid, lane);
    if constexpr (SP2) {
        PG8_STAGE(PG8_SB(0, 0), cB, voffB); PG8_STAGE(PG8_SB(0, 1), cB + hstep, voffB); PG8_STAGE(PG8_SA(0, 0), cA, voffA); PG8_STAGE(PG8_SA(0, 1), cA + hstep, voffA);
        if (wr == 1) PG8_BAR;
        PG8_WAIT_V(2); PG8_BAR;
        PG8_STAGE(PG8_SB(1, 0), cB + kstep, voffB); PG8_STAGE(PG8_SA(1, 0), cA + kstep, voffA); PG8_STAGE(PG8_SB(1, 1), cB + hstep + kstep, voffB);
        PG8_WAIT_V(6); PG8_BAR;
    } else {
        PG8_STAGE(PG8_SB(0, 0), cB, voffB); PG8_STAGE(PG8_SA(0, 0), cA, voffA); PG8_STAGE(PG8_SB(0, 1), cB + hstep, voffB); PG8_STAGE(PG8_SA(0, 1), cA + hstep, voffA);
        if (wr == 1) PG8_BAR;
        PG8_WAIT_V(4); PG8_BAR;
        PG8_STAGE(PG8_SB(1, 0), cB + kstep, voffB); PG8_STAGE(PG8_SA(1, 0), cA + kstep, voffA); PG8_STAGE(PG8_SB(1, 1), cB + hstep + kstep, voffB);
        PG8_WAIT_V(6); PG8_BAR;
    }
    for (;;) {
        const bool has_next = S.next(ui + 1, nxt);
        const char* nA = has_next ? (const char*)(nxt.sel ? g.A2 : g.A) + (size_t)nxt.pm * tstep : cA; const char* nB = has_next ? (const char*)(nxt.sel ? g.Bt2 : g.Bt) + (size_t)nxt.pn * tstep : cB;
        for (int t = 0; t < nt; t += 2) {
            if constexpr (Epi::MIDK) { if (cur.sel == 1 && (t == 8 || t == 16 || t == 24)) {
                const int seg = (t >> 3) - 1;
#pragma unroll
                for (int ai = 0; ai < 2; ++ai)
#pragma unroll
                    for (int m = 0; m < 4; ++m) { const float rho = E.ratio(ai * HALF + wr * 64 + m * 16 + fr, seg);
#pragma unroll
                        for (int bj = 0; bj < 2; ++bj)
#pragma unroll
                            for (int n = 0; n < 2; ++n) acc[ai][bj][m][n] = acc[ai][bj][m][n] * rho; } } }
            const bool last = (t == nt - 2);
            const char* a1 = cA + (size_t)(t + 1) * kstep;
            const char* a2 = last ? nA : cA + (size_t)(t + 2) * kstep; const char* b2 = last ? nB : cB + (size_t)(t + 2) * kstep;
            const char* a3 = a2 + kstep; const char* b3 = b2 + kstep;
            if (last && has_next) S.a_ready(nxt);
            if constexpr (SP2) {
            PG8_LDB(B0, 0, 0); PG8_LDB(B1, 0, 1); PG8_SCHED; PG8_LDA(At, 0, 0); PG8_STAGE(PG8_SA(1, 1), a1 + hstep, voffA);
            PG8_WAIT_V(8); PG8_WAIT_L(0); PG8_BAR; PG8_MMA(0, 0, At, B0); PG8_MMA(0, 1, At, B1); PG8_BAR; PG8_SCHED;
            PG8_LDA(At, 0, 1); if constexpr (Epi::RSTAB) { if (last && has_next) E.tab_stage(lds, nxt, (ui + 1) & 1, wid, lane); }
            PG8_STAGE(PG8_SB(0, 0), b2, voffB); PG8_STAGE(PG8_SB(0, 1), b2 + hstep, voffB); PG8_STAGE(PG8_SA(0, 0), a2, voffA);
            PG8_WAIT_V(8); PG8_WAIT_L(0); PG8_BAR; PG8_MMA(1, 0, At, B0); PG8_MMA(1, 1, At, B1); PG8_BAR; PG8_SCHED;
            PG8_LDB(B0, 1, 0); PG8_LDB(B1, 1, 1); PG8_SCHED; PG8_LDA(At, 1, 0); PG8_STAGE(PG8_SA(0, 1), a2 + hstep, voffA);
            PG8_WAIT_V(8); PG8_WAIT_L(0); PG8_BAR; PG8_MMA(0, 0, At, B0); PG8_MMA(0, 1, At, B1); PG8_BAR; PG8_SCHED;
            PG8_LDA(At, 1, 1); PG8_STAGE(PG8_SB(1, 0), b3, voffB); PG8_STAGE(PG8_SB(1, 1), b3 + hstep, voffB); PG8_STAGE(PG8_SA(1, 0), a3, voffA);
            PG8_WAIT_V(8); PG8_WAIT_L(0); PG8_BAR; PG8_MMA(1, 0, At, B0); PG8_MMA(1, 1, At, B1); PG8_BAR; PG8_SCHED;
            } else {
            PG8_LDB(B0, 0, 0); PG8_SCHED; PG8_LDA(At, 0, 0); PG8_STAGE(PG8_SA(1, 1), a1 + hstep, voffA);
            PG8_WAIT_L(8); PG8_BAR; PG8_WAIT_L(0); PG8_MMA(0, 0, At, B0); PG8_BAR; PG8_SCHED;
            PG8_LDB(B1, 0, 1); PG8_STAGE(PG8_SB(0, 0), b2, voffB);
            PG8_BAR; PG8_WAIT_L(0); PG8_MMA(0, 1, At, B1); PG8_BAR;
            PG8_LDA(At, 0, 1); PG8_STAGE(PG8_SA(0, 0), a2, voffA);
            PG8_BAR; PG8_WAIT_L(0); PG8_MMA(1, 0, At, B0); PG8_BAR; PG8_SCHED;
            PG8_STAGE(PG8_SB(0, 1), b2 + hstep, voffB);
            PG8_WAIT_V(6); PG8_BAR; PG8_MMA(1, 1, At, B1); PG8_BAR;
            PG8_LDB(B0, 1, 0); PG8_SCHED; PG8_LDA(At, 1, 0); PG8_STAGE(PG8_SA(0, 1), a2 + hstep, voffA);
            PG8_WAIT_L(8); PG8_BAR; PG8_WAIT_L(0); PG8_MMA(0, 0, At, B0); PG8_BAR; PG8_SCHED;
            PG8_LDB(B1, 1, 1); PG8_STAGE(PG8_SB(1, 0), b3, voffB);
            PG8_BAR; PG8_WAIT_L(0); PG8_MMA(0, 1, At, B1); PG8_BAR;
            PG8_LDA(At, 1, 1); PG8_STAGE(PG8_SA(1, 0), a3, voffA);
            PG8_BAR; PG8_WAIT_L(0); PG8_MMA(1, 0, At, B0); PG8_BAR; PG8_SCHED;
            PG8_STAGE(PG8_SB(1, 1), b3 + hstep, voffB);
            PG8_WAIT_V(6); PG8_BAR; PG8_MMA(1, 1, At, B1); PG8_BAR;
            }
        }
        if constexpr (ALIGN_EPI) { if (wr == 0) PG8_BAR; }
        if constexpr (Epi::RSTAB) E.tab_set(lds, ui & 1);
        epi_big(E, acc, cur, wr, wc, fr, fq); S.done(cur);
        if (!has_next) break;
        if (nxt.sel == 0) {
#pragma unroll
        for (int a = 0; a < 2; ++a)
#pragma unroll
            for (int b = 0; b < 2; ++b)
#pragma unroll
                for (int m = 0; m < 4; ++m)
#pragma unroll
                    for (int n = 0; n < 2; ++n) acc[a][b][m][n] = (f32x4){0.f, 0.f, 0.f, 0.f};
        }
        cur = nxt; cA = nA; cB = nB; ++ui;
        if constexpr (ALIGN_EPI) { if (wr == 1) PG8_BAR; }
    }
    PG8_WAIT_V(0);
    if constexpr (!ALIGN_EPI) { if (wr == 0) PG8_BAR; }
    PG8_BAR;
#undef PG8_SA
#undef PG8_SB
#undef PG8_STAGE
#undef PG8_LDA
#undef PG8_LDB
#undef PG8_MMA
#undef PG8_WAIT_V
#undef PG8_WAIT_L
#undef PG8_BAR
#undef PG8_SCHED
}
template <class Epi, class Sched, bool ALIGN_EPI = false, bool SP2 = false>
__device__ __forceinline__ void gemm_phase(PG8_LAS unsigned char* lds, const Gemm g, const Sched& S, const Epi& E) { f32x4 acc[2][2][4][2]; gemm_phase_acc<Epi, Sched, ALIGN_EPI, SP2, true>(lds, g, S, E, acc); }
}

constexpr int D = 2048, M = 9216, MP = 8192, DEPTH = 4, NWAVES = 8;
constexpr int INW = 18448, NPAD = 18496, PW = pg8::PW;
constexpr int C_GA = 0, C_GB = 2048, C_CB = 4096, C_CC = 6144, C_CX = 8192, C_CG = 10240, C_Q = 12288, C_K = 13312, C_V = 14336, C_GG = 16384;
constexpr float EPS = 1e-6f;
constexpr size_t O_Y = 0, O_CONVP = 18874368, O_GLAP = 18939904, O_CONVS = 27328512, O_GLAS = 29425664, O_END = 297861120;
constexpr size_t MiB = 1u << 20;
constexpr size_t WS_CTL = 0, CTL_ZERO_BYTES = 2 * MiB;
constexpr size_t WS_WIN = 2 * MiB, WIN_L = (size_t)NPAD * D * 2;
constexpr size_t WS_WA = 296 * MiB, WS_WB = 328 * MiB, WS_WO = 360 * MiB, W_L = (size_t)D * D * 2;
constexpr size_t WS_XF = 392 * MiB, WS_XB = 464 * MiB, WS_P = 500 * MiB, WS_ZA = 824 * MiB, WS_ZB = 860 * MiB, WS_MG = 896 * MiB;
constexpr size_t WS_O = 932 * MiB, WS_T = 1004 * MiB, WS_LR = 1076 * MiB, WS_RSTD = 1077 * MiB, WS_END = 1078 * MiB;
static_assert(WS_WIN + 4 * WIN_L <= WS_WA, "ws map");
constexpr int CW_BAR = 4096;
constexpr size_t WS_RSO = 524288;
constexpr size_t WS_RSQ = 65536;
constexpr int RING_OFF = 0, RING_BYTES = 131072, ROWSUM_OFF = 147456, LDSCTL_OFF = 149504, MISC_OFF = LDSCTL_OFF + 320, RT_OFF = 150528, LDS_BYTES = 158720;

#define GAS __attribute__((address_space(1)))
#define LAS __attribute__((address_space(3)))
typedef unsigned short bf16;
typedef unsigned v4u __attribute__((ext_vector_type(4)));
typedef unsigned v2u __attribute__((ext_vector_type(2)));
typedef float f32x4 __attribute__((ext_vector_type(4)));
typedef GAS unsigned gu32;
#define RLX_AGENT __ATOMIC_RELAXED, __HIP_MEMORY_SCOPE_AGENT
#define LDS_WAIT() asm volatile("s_waitcnt lgkmcnt(0)" ::: "memory")
#define VM_WAIT() asm volatile("s_waitcnt vmcnt(0)" ::: "memory")
__device__ __forceinline__ unsigned f2bf(float f) { unsigned u = __builtin_bit_cast(unsigned, f); return (u + 0x7fffu + ((u >> 16) & 1u)) >> 16; }
__device__ __forceinline__ unsigned pk2(float lo, float hi) { return f2bf(lo) | (f2bf(hi) << 16); }
__device__ __forceinline__ float bflo(unsigned w) { return __uint_as_float(w << 16); }
__device__ __forceinline__ float bfhi(unsigned w) { return __uint_as_float(w & 0xffff0000u); }
__device__ __forceinline__ float bf1(bf16 b) { return __uint_as_float(((unsigned)b) << 16); }

typedef short bf16x8 __attribute__((ext_vector_type(8)));
typedef float f32x2 __attribute__((ext_vector_type(2)));
typedef __bf16 bf16x2_t __attribute__((ext_vector_type(2)));
__device__ __forceinline__ unsigned pkbf(float a, float b) { f32x2 v = {a, b}; bf16x2_t r = __builtin_convertvector(v, bf16x2_t); return __builtin_bit_cast(unsigned, r); }
#define XB_TMO      128
#define XB_XCNT(j)  (256  + 64 * (j))
#define XB_XSUB(j)  (1280 + 64 * (j))
#define XB_XGEN(j)  (2304 + 64 * (j))
#define XB_TOP      3328
#define XB_TOPGEN   3392
#define XCD_BAR_WORDS 3456
#define XB_SPIN_CAP (1u << 18)
__device__ __forceinline__ unsigned xb_ld(unsigned* p)              { return __hip_atomic_load(p, __ATOMIC_RELAXED, __HIP_MEMORY_SCOPE_AGENT); }
__device__ __forceinline__ unsigned xb_add(unsigned* p, unsigned v) { return __hip_atomic_fetch_add(p, v, __ATOMIC_RELAXED, __HIP_MEMORY_SCOPE_AGENT); }
__device__ __forceinline__ unsigned xb_xcc_id() { return (unsigned)__builtin_amdgcn_s_getreg((3 << 11) | 20) & 0xFu; }
#define XB_SPIN(cond, bar) do { unsigned _sp = 0; while (cond) { __builtin_amdgcn_s_sleep(1); \
    if ((++_sp & 255u) == 0u) { if (xb_ld(&(bar)[XB_TMO])) break; if (_sp > XB_SPIN_CAP) { atomicAdd(&(bar)[XB_TMO], 1u); break; } } } } while (0)
struct XcdBarrier { unsigned* bar; unsigned x; volatile LAS unsigned* st; };
__device__ __forceinline__ XcdBarrier xcd_barrier_post(unsigned* bar, volatile LAS unsigned* st) {
    XcdBarrier b; b.bar = bar; b.x = xb_xcc_id(); b.st = st;
    if (threadIdx.x == 0) (void)xb_add(&bar[XB_XCNT(b.x)], 1u);
    return b;
}
__device__ __forceinline__ void xcd_barrier_complete(unsigned* bar, unsigned x, unsigned& nloc, unsigned& nx) {
    const unsigned G = gridDim.x * gridDim.y * gridDim.z;
    unsigned sum, cnt, mine, sp = 0u;
    for (;;) {
        sum = 0u; cnt = 0u; mine = 0u;
#pragma unroll
        for (unsigned j = 0; j < 16; ++j) { const unsigned c = xb_ld(&bar[XB_XCNT(j)]); sum += c; cnt += (c > 0u) ? 1u : 0u; mine = (j == x) ? c : mine; }
        if (sum == G) break;
        __builtin_amdgcn_s_sleep(1);
        if ((++sp & 255u) == 0u) { if (xb_ld(&bar[XB_TMO])) break; if (sp > XB_SPIN_CAP) { atomicAdd(&bar[XB_TMO], 1u); break; } }
    }
    nloc = mine > 0u ? mine : 1u; nx = cnt > 0u ? cnt : 1u;
}
__device__ __forceinline__ void xcd_barrier(const XcdBarrier& b) {
    asm volatile("s_waitcnt vmcnt(0)" ::: "memory");
    __syncthreads();
    if (threadIdx.x == 0) {
        unsigned* bar = b.bar;
        __builtin_amdgcn_s_waitcnt(0);
        unsigned nloc = b.st[0], nx = b.st[1];
        if (nloc == 0u) { xcd_barrier_complete(bar, b.x, nloc, nx); b.st[0] = nloc; b.st[1] = nx; }
        const unsigned old = xb_add(&bar[XB_XSUB(b.x)], 1u);
        const unsigned gen = old / nloc;
        if (old + 1u == (gen + 1u) * nloc) {
            __builtin_amdgcn_fence(__ATOMIC_RELEASE, "agent");
            asm volatile("s_waitcnt vmcnt(0)" ::: "memory");
            const unsigned og = xb_add(&bar[XB_TOP], 1u);
            const unsigned tg = og / nx;
            if (og + 1u == (tg + 1u) * nx) xb_add(&bar[XB_TOPGEN], 1u);
            else XB_SPIN(xb_ld(&bar[XB_TOPGEN]) == tg, bar);
            __builtin_amdgcn_fence(__ATOMIC_ACQUIRE, "agent");
            xb_add(&bar[XB_XGEN(b.x)], 1u);
            asm volatile("s_waitcnt vmcnt(0)" ::: "memory");
        } else {
            XB_SPIN(xb_ld(&bar[XB_XGEN(b.x)]) == gen, bar);
            __builtin_amdgcn_fence(__ATOMIC_ACQUIRE, "agent");
            asm volatile("s_waitcnt vmcnt(0)" ::: "memory");
        }
    }
    __syncthreads();
}

struct Frame {
    LAS unsigned char* lds;
    int tid, lane, wave, vcu, G;
};
__device__ __forceinline__ const float* inp(int k) { asm volatile("" : "+s"(k)); const unsigned long long* ka = (const unsigned long long*)__builtin_amdgcn_kernarg_segment_ptr(); return (const float*)(const GAS float*)ka[k]; }
__device__ __forceinline__ unsigned char* wsp() { return (unsigned char*)inp(15); }
__device__ __forceinline__ float* outp() { return (float*)inp(14); }
enum { I_XP = 0, I_XS, I_SCONV, I_SGLA, I_NORMG, I_WIN, I_CONVW, I_WA2, I_BA, I_GNORMG, I_WBA, I_WBB, I_WO, I_FING };
__device__ __forceinline__ float wave_sum(float v) {
#pragma unroll
    for (int o = 1; o < 64; o <<= 1) v += __shfl_xor(v, o);
    return v;
}
__device__ __forceinline__ void tr_item(const float* W, int ldw, int nvalid, int K, bf16* WT, int nblk, const float* s, int smask, int item, int lane, bool perm) {
    const int kb = item / nblk, nb = item % nblk, k0 = 64 * kb, n = 64 * nb + lane;
    int nd = n;
    if (perm && n >= 4096 && n < 12288) { const int sct = (n - 4096) >> 11, ch = (n - 4096) & 2047, c64 = ch & 63; nd = 4096 + (ch >> 6) * 256 + 128 * (sct >> 1) + 32 * (c64 >> 4) + 8 * ((c64 >> 2) & 3) + 4 * (sct & 1) + (c64 & 3); }
    float v[64];
    if (n < nvalid) { const float* p = W + (size_t)k0 * ldw + n;
#pragma unroll
        for (int i = 0; i < 64; ++i) v[i] = p[(size_t)i * ldw]; }
    else {
#pragma unroll
        for (int i = 0; i < 64; ++i) v[i] = 0.f; }
    if (s) {
#pragma unroll
        for (int i = 0; i < 64; ++i) v[i] *= s[(k0 + i) & smask]; }
    GAS v4u* d = (GAS v4u*)(WT + (size_t)nd * K + k0);
#pragma unroll
    for (int c = 0; c < 8; ++c) { v4u o; o.x = pkbf(v[8 * c], v[8 * c + 1]); o.y = pkbf(v[8 * c + 2], v[8 * c + 3]); o.z = pkbf(v[8 * c + 4], v[8 * c + 5]); o.w = pkbf(v[8 * c + 6], v[8 * c + 7]); d[c] = o; }
}
__device__ __forceinline__ void p_prologue(Frame& F0) {
    Frame F = F0; asm volatile("" : "+v"(F.tid), "+v"(F.lane));
    const int gw = F.vcu * NWAVES + F.wave, NGW = F.G * NWAVES;
    constexpr int I_IN = (D / 64) * (NPAD / 64), I_SQ = (D / 64) * (D / 64), I_L = I_IN + 3 * I_SQ;
    for (int it = gw; it < DEPTH * I_L; it += NGW) {
        const int l = it / I_L; int r = it % I_L;
        if (r < I_IN) { tr_item(inp(I_WIN) + (size_t)l * D * INW, INW, INW, D, (bf16*)(wsp() + WS_WIN + l * WIN_L), NPAD / 64, inp(I_NORMG) + l * D, 0xffff, r, F.lane, true); continue; } r -= I_IN;
        if (r < I_SQ) { tr_item(inp(I_WBA) + (size_t)l * D * D, D, D, D, (bf16*)(wsp() + WS_WA + l * W_L), D / 64, nullptr, 0, r, F.lane, false); continue; } r -= I_SQ;
        if (r < I_SQ) { tr_item(inp(I_WBB) + (size_t)l * D * D, D, D, D, (bf16*)(wsp() + WS_WB + l * W_L), D / 64, inp(I_GNORMG) + l * 512, 511, r, F.lane, false); continue; } r -= I_SQ;
        tr_item(inp(I_WO) + (size_t)l * D * D, D, D, D, (bf16*)(wsp() + WS_WO + l * W_L), D / 64, nullptr, 0, r, F.lane, false);
    }
}
__device__ __forceinline__ void p_xprep(Frame& F0, int l) {
    Frame F = F0; asm volatile("" : "+v"(F.tid), "+v"(F.lane));
    const int gw = F.vcu * NWAVES + F.wave, NGW = F.G * NWAVES;
    bf16* XB = (bf16*)(wsp() + WS_XB); unsigned long long* RS = (unsigned long long*)(wsp() + WS_RSQ);
    for (int r = gw; r < M; r += NGW) {
        const float* src = r < MP ? inp(I_XP) + (size_t)r * D : inp(I_XS) + (size_t)(r - MP) * D;
        const GAS f32x4* s4 = (const GAS f32x4*)src + F.lane;
        f32x4 v[8]; float ss = 0.f;
#pragma unroll
        for (int j = 0; j < 8; ++j) { v[j] = s4[64 * j]; ss += (v[j].x * v[j].x + v[j].y * v[j].y) + (v[j].z * v[j].z + v[j].w * v[j].w); }
        const float tot = wave_sum(ss);
        if (F.lane == 0) RS[r] = (unsigned long long)(tot * 16777216.0f);
        GAS unsigned long long* o8 = (GAS unsigned long long*)(XB + (size_t)r * D) + F.lane;
#pragma unroll
        for (int j = 0; j < 8; ++j) o8[64 * j] = (unsigned long long)pk2(v[j].x, v[j].y) | ((unsigned long long)pk2(v[j].z, v[j].w) << 32);
    }
}
__device__ __forceinline__ void p_final(Frame& F0) {
    Frame F = F0; asm volatile("" : "+v"(F.tid), "+v"(F.lane));
    const int gw = F.vcu * NWAVES + F.wave, NGW = F.G * NWAVES;
    const bf16* XB = (const bf16*)(wsp() + WS_XB);
    for (int r = gw; r < M; r += NGW) {
        const GAS v2u* s2 = (const GAS v2u*)(XB + (size_t)r * D) + F.lane; const GAS f32x4* g4 = (const GAS f32x4*)inp(I_FING) + F.lane;
        f32x4 v[8];
#pragma unroll
        for (int j = 0; j < 8; ++j) { const v2u w = s2[64 * j]; v[j] = (f32x4){bflo(w.x), bfhi(w.x), bflo(w.y), bfhi(w.y)}; }
        const float rstd = 1.f / sqrtf((float)((const unsigned long long*)(wsp() + WS_RSQ))[DEPTH * M + r] * (1.0f / 16777216.0f) * (1.f / D) + EPS);
        GAS f32x4* d4 = (GAS f32x4*)(outp() + O_Y + (size_t)r * D) + F.lane;
#pragma unroll
        for (int j = 0; j < 8; ++j) d4[64 * j] = v[j] * rstd * g4[64 * j];
    }
}
__device__ __forceinline__ unsigned short bf1r(float a) { return (unsigned short)(pkbf(a, 0.f) & 0xffffu); }
__device__ __forceinline__ float logsig16(float a) { return (fminf(a, 0.f) - 0.69314718f * __builtin_amdgcn_logf(1.0f + __builtin_amdgcn_exp2f(-1.44269504f * fabsf(a)))) * 0.0625f; }
__device__ __forceinline__ float fexp(float x) { return __builtin_amdgcn_exp2f(1.44269504f * x); }
__device__ __forceinline__ int qt_off(int t, int p) { return t * 512 + (((p & 16) | ((p ^ t) & 15)) << 4); }
__device__ __forceinline__ int r8_off(int r, int p) { return r * 128 + ((p ^ ((r >> 1) & 7)) << 4); }
__device__ __forceinline__ int qt_pos(int k) { const int k32 = k & 31; return (k & ~31) + 8 * ((k32 & 15) >> 2) + 4 * (k32 >> 4) + (k32 & 3); }
constexpr size_t WS_QT = 1078 * MiB, WS_KD = 1094 * MiB, WS_AI = 1110 * MiB, WS_GM = 1114 * MiB, WS_VT = 1115 * MiB, WS_END2 = 1147 * MiB;
constexpr int QT_B = 32768, KD_B = 32768, AI_B = 8192, GM_B = 1024, VT_B = 65536, SCAN_BUF = QT_B + KD_B + AI_B + GM_B;

__device__ __forceinline__ void p_gla_prep(Frame& F0, int l) {
    Frame F = F0; asm volatile("" : "+v"(F.tid), "+v"(F.lane));
    const bf16* P = (const bf16*)(wsp() + WS_P); const float* LR = (const float*)(wsp() + WS_LR);
    LAS unsigned char* Qs = F.lds; LAS unsigned char* Ks = F.lds + 32768; LAS unsigned char* VTs = F.lds;
    LAS unsigned char* Qraw = F.lds + 65536; LAS unsigned char* Kraw = F.lds + 98304;
    LAS float* LRs = (LAS float*)(F.lds + 131072); LAS float* TOT = (LAS float*)(F.lds + 135168);
    const int k = F.tid & 255, half = F.tid >> 8;
    for (int item = F.vcu; item < 512; item += F.G) {
        const int b = item >> 7, c = (item >> 2) & 31, h = item & 3, r0 = b * 2048 + c * 64;
        v4u va[4], vb[4], qv[4], kv[4]; f32x4 lrv = {0.f, 0.f, 0.f, 0.f};
#pragma unroll
        for (int i = 0; i < 4; ++i) { const int id = i * 512 + F.tid, tp = id & 31, pc = id >> 5;
            va[i] = *(const GAS v4u*)(P + (size_t)(r0 + 2 * tp) * PW + C_V + h * 512 + 8 * pc); vb[i] = *(const GAS v4u*)(P + (size_t)(r0 + 2 * tp + 1) * PW + C_V + h * 512 + 8 * pc);
            const int t = id >> 5, p = id & 31;
            qv[i] = *(const GAS v4u*)(P + (size_t)(r0 + t) * PW + C_Q + h * 256 + 8 * p); kv[i] = *(const GAS v4u*)(P + (size_t)(r0 + t) * PW + C_K + h * 256 + 8 * p); }
        if (F.tid < 256) lrv = *(const GAS f32x4*)(LR + (size_t)r0 * 16 + 4 * F.tid);
        float w2[16]; const float bias = inp(I_BA)[l * 1024 + h * 256 + k];
        { const float* w2p = inp(I_WA2) + (size_t)l * 16 * 1024 + h * 256 + k;
#pragma unroll
          for (int j = 0; j < 16; ++j) w2[j] = w2p[j * 1024]; }
#pragma unroll
        for (int i = 0; i < 4; ++i) { const int id = i * 512 + F.tid, tp = id & 31, pc = id >> 5; const v4u a = va[i], bb = vb[i];
            LAS unsigned* d = (LAS unsigned*)(VTs + (8 * pc) * 128 + 4 * tp);
            d[0 * 32] = (a.x & 0xffffu) | (bb.x << 16); d[1 * 32] = (a.x >> 16) | (bb.x & 0xffff0000u); d[2 * 32] = (a.y & 0xffffu) | (bb.y << 16); d[3 * 32] = (a.y >> 16) | (bb.y & 0xffff0000u);
            d[4 * 32] = (a.z & 0xffffu) | (bb.z << 16); d[5 * 32] = (a.z >> 16) | (bb.z & 0xffff0000u); d[6 * 32] = (a.w & 0xffffu) | (bb.w << 16); d[7 * 32] = (a.w >> 16) | (bb.w & 0xffff0000u);
            *(LAS v4u*)(Qraw + id * 16) = qv[i]; *(LAS v4u*)(Kraw + id * 16) = kv[i]; }
        if (F.tid < 256) *(LAS f32x4*)(LRs + 4 * F.tid) = lrv;
        __syncthreads();
        { GAS v4u* dst = (GAS v4u*)(wsp() + WS_VT + (size_t)item * VT_B);
#pragma unroll
          for (int i = 0; i < 8; ++i) dst[i * 512 + F.tid] = *(const LAS v4u*)(VTs + (i * 512 + F.tid) * 16); }
        float bc[32]; float run = 0.f;
#pragma unroll
        for (int i = 0; i < 32; ++i) { const LAS f32x4* lr4 = (const LAS f32x4*)(LRs + (half * 32 + i) * 16); float a = bias;
#pragma unroll
            for (int j4 = 0; j4 < 4; ++j4) { const f32x4 x = lr4[j4]; a += x[0] * w2[4 * j4] + x[1] * w2[4 * j4 + 1] + x[2] * w2[4 * j4 + 2] + x[3] * w2[4 * j4 + 3]; }
            run += logsig16(a); bc[i] = run; }
        TOT[half * 256 + k] = run;
        __syncthreads();
        const float lo_tot = TOT[k], blast = lo_tot + TOT[256 + k], boff = half ? lo_tot : 0.f;
        if (half == 0) ((float*)(wsp() + WS_GM))[(size_t)item * 256 + k] = fexp(blast);
        const int pos = qt_pos(k), pp = pos >> 3, pe = (pos & 7) * 2;
        unsigned char* kdg = wsp() + WS_KD + (size_t)item * KD_B;
#pragma unroll
        for (int g = 0; g < 4; ++g) { unsigned kdw[4];
#pragma unroll
            for (int e = 0; e < 8; ++e) { const int i = g * 8 + e, t = half * 32 + i; const float bt = bc[i] + boff;
                const float qf = bf1(*(const LAS unsigned short*)(Qraw + t * 512 + k * 2)) * 0.0625f * fexp(bt), kf = bf1(*(const LAS unsigned short*)(Kraw + t * 512 + k * 2));
                const float kh = kf * fexp(-bt), kd = kf * fexp(blast - bt);
                *(LAS unsigned short*)(Qs + qt_off(t, pp) + pe) = bf1r(qf); *(LAS unsigned short*)(Ks + qt_off(t, pp) + pe) = bf1r(kh);
                if (e & 1) kdw[e >> 1] = (kdw[e >> 1] & 0xffffu) | ((unsigned)bf1r(kd) << 16); else kdw[e >> 1] = bf1r(kd); }
            v4u w; w.x = kdw[0]; w.y = kdw[1]; w.z = kdw[2]; w.w = kdw[3];
            *(GAS v4u*)(kdg + r8_off(k, half * 4 + g)) = w; }
        __syncthreads();
        { GAS v4u* dq = (GAS v4u*)(wsp() + WS_QT + (size_t)item * QT_B);
#pragma unroll
          for (int i = 0; i < 4; ++i) dq[i * 512 + F.tid] = *(const LAS v4u*)(Qs + (i * 512 + F.tid) * 16); }
        { const int r16 = F.lane & 15, quad = F.lane >> 4;
#pragma unroll
          for (int u = 0; u < 2; ++u) { const int id = F.wave * 2 + u, si = id >> 2, ti = id & 3;
              f32x4 acc = {0.f, 0.f, 0.f, 0.f};
              if (ti >= si) {
#pragma unroll
                  for (int ks = 0; ks < 8; ++ks) { const bf16x8 ka = *(const LAS bf16x8*)(Ks + qt_off(16 * si + r16, 4 * ks + quad)), qb = *(const LAS bf16x8*)(Qs + qt_off(16 * ti + r16, 4 * ks + quad));
                      acc = __builtin_amdgcn_mfma_f32_16x16x32_bf16(ka, qb, acc, 0, 0, 0); } }
              const int t = 16 * ti + r16, s0 = 16 * si + 4 * quad;
              v2u w; w.x = pkbf(s0 + 0 <= t ? acc[0] : 0.f, s0 + 1 <= t ? acc[1] : 0.f); w.y = pkbf(s0 + 2 <= t ? acc[2] : 0.f, s0 + 3 <= t ? acc[3] : 0.f);
              *(GAS v2u*)(wsp() + WS_AI + (size_t)item * AI_B + r8_off(t, 2 * si + (quad >> 1)) + (quad & 1) * 8) = w; } }
        __syncthreads();
    }
}
__device__ __forceinline__ void scan_stage(unsigned char* ws, LAS unsigned char* lds, int item, int c, int lw, int lane) {
    LAS unsigned char* buf = lds + (c & 1) * SCAN_BUF;
    const unsigned char* gq = ws + WS_QT + (size_t)item * QT_B; const unsigned char* gk = ws + WS_KD + (size_t)item * KD_B;
    const unsigned char* ga = ws + WS_AI + (size_t)item * AI_B; const unsigned char* gg = ws + WS_GM + (size_t)item * GM_B;
#pragma unroll
    for (int i = 0; i < 8; ++i) { const int wp = lw + 4 * i;
        __builtin_amdgcn_global_load_lds((const unsigned*)(gq + wp * 1024 + lane * 16), (LAS unsigned*)(buf + wp * 1024), 16, 0, 0);
        __builtin_amdgcn_global_load_lds((const unsigned*)(gk + wp * 1024 + lane * 16), (LAS unsigned*)(buf + QT_B + wp * 1024), 16, 0, 0); }
#pragma unroll
    for (int i = 0; i < 2; ++i) { const int wp = lw + 4 * i;
        __builtin_amdgcn_global_load_lds((const unsigned*)(ga + wp * 1024 + lane * 16), (LAS unsigned*)(buf + QT_B + KD_B + wp * 1024), 16, 0, 0); }
    if (lw == 0) __builtin_amdgcn_global_load_lds((const unsigned*)(gg + lane * 16), (LAS unsigned*)(buf + QT_B + KD_B + AI_B), 16, 0, 0);
}
__device__ __forceinline__ void p_gla_scan(Frame& F0, int l) {
    Frame F = F0; asm volatile("" : "+v"(F.tid), "+v"(F.lane));
    if (F.vcu >= 128) return;
    const int b = F.vcu >> 5, h = (F.vcu >> 3) & 3, vq = F.vcu & 7;
    bf16* ZBp = (bf16*)(wsp() + WS_ZB); const bf16* Pp = (const bf16*)(wsp() + WS_P); unsigned long long* RSO = (unsigned long long*)(wsp() + WS_RSO) + (size_t)l * M * 4;
    const int r16 = F.lane & 15, quad = F.lane >> 4, w = F.wave;
    const int vcol0 = vq * 64 + (w & 3) * 16;
    f32x4 S[16];
#pragma unroll
    for (int i = 0; i < 16; ++i) S[i] = (f32x4){0.f, 0.f, 0.f, 0.f};
    if (w >= 4) {
        scan_stage(wsp(), F.lds, (b * 32 + 0) * 4 + h, 0, w - 4, F.lane);
#pragma unroll 1
        for (int c = 0; c < 32; ++c) {
            asm volatile("s_waitcnt vmcnt(0)" ::: "memory");
            asm volatile("" ::: "memory"); __builtin_amdgcn_s_barrier(); asm volatile("" ::: "memory");
            if (c + 1 < 32) scan_stage(wsp(), F.lds, (b * 32 + c + 1) * 4 + h, c + 1, w - 4, F.lane);
        }
        asm volatile("s_waitcnt vmcnt(0)" ::: "memory");
        __syncthreads();
        return;
    }
    bf16x8 vf[2], vn[2];
    { const unsigned char* gv = wsp() + WS_VT + (size_t)((b * 32 + 0) * 4 + h) * VT_B + (vcol0 + r16) * 128 + quad * 16; vf[0] = *(const GAS bf16x8*)gv; vf[1] = *(const GAS bf16x8*)(gv + 64); }
    v4u gq[2], gqn[2];
    { const int r0 = b * 2048;
#pragma unroll
      for (int m = 0; m < 2; ++m) gq[m] = *(const GAS v4u*)(Pp + (size_t)(r0 + 16 * (2 * m + (quad & 1)) + r16) * PW + C_GG + h * 512 + vcol0 + 4 * (quad & 2)); }
    __builtin_amdgcn_s_setprio(3);
    auto chunk = [&](const int c, bf16x8 (&vcur)[2], bf16x8 (&vnxt)[2], v4u (&gcur)[2], v4u (&gnxt)[2]) __attribute__((always_inline)) {
        asm volatile("" ::: "memory"); __builtin_amdgcn_s_barrier(); asm volatile("" ::: "memory");
        const LAS unsigned char* buf = F.lds + (c & 1) * SCAN_BUF;
        const LAS unsigned char* Qb = buf; const LAS unsigned char* Kb = buf + QT_B; const LAS unsigned char* Ab = buf + QT_B + KD_B; const LAS unsigned char* Gb = buf + QT_B + KD_B + AI_B;
        f32x4 acc[4];
#pragma unroll
        for (int ti = 0; ti < 4; ++ti) acc[ti] = (f32x4){0.f, 0.f, 0.f, 0.f};
        bf16x8 rb[3][4];
#define SCAN_LDG(g, d) { _Pragma("unroll") for (int ti = 0; ti < 4; ++ti) d[ti] = (g) < 8 ? *(const LAS bf16x8*)(Qb + qt_off(16 * ti + r16, 4 * (g) + quad)) : *(const LAS bf16x8*)(Ab + r8_off(16 * ti + r16, 4 * ((g) - 8) + quad)); }
        SCAN_LDG(0, rb[0]) SCAN_LDG(1, rb[1])
#pragma unroll
        for (int g = 0; g < 10; ++g) {
            if (g + 2 < 10) SCAN_LDG(g + 2, rb[(g + 2) % 3])
            bf16x8 sa;
            if (g < 8) { v4u sp; sp.x = pkbf(S[2 * g][0], S[2 * g][1]); sp.y = pkbf(S[2 * g][2], S[2 * g][3]); sp.z = pkbf(S[2 * g + 1][0], S[2 * g + 1][1]); sp.w = pkbf(S[2 * g + 1][2], S[2 * g + 1][3]); sa = __builtin_bit_cast(bf16x8, sp); }
            else sa = vcur[g - 8];
            __builtin_amdgcn_sched_barrier(0);
#pragma unroll
            for (int ti = 0; ti < 4; ++ti) acc[ti] = __builtin_amdgcn_mfma_f32_16x16x32_bf16(sa, rb[g % 3][ti], acc[ti], 0, 0, 0);
            __builtin_amdgcn_sched_barrier(0);
        }
#undef SCAN_LDG
        { const int cn = c + 1 < 32 ? c + 1 : c, r0 = b * 2048 + cn * 64;
#pragma unroll
          for (int m = 0; m < 2; ++m) gnxt[m] = *(const GAS v4u*)(Pp + (size_t)(r0 + 16 * (2 * m + (quad & 1)) + r16) * PW + C_GG + h * 512 + vcol0 + 4 * (quad & 2));
          const unsigned char* gv = wsp() + WS_VT + (size_t)((b * 32 + cn) * 4 + h) * VT_B + (vcol0 + r16) * 128 + quad * 16; vnxt[0] = *(const GAS bf16x8*)gv; vnxt[1] = *(const GAS bf16x8*)(gv + 64); }
        f32x4 gb[2][2]; bf16x8 kb[2][2][2];
#define SCAN_LD3(p, s) { _Pragma("unroll") for (int e = 0; e < 2; ++e) { gb[s][e] = *(const LAS f32x4*)(Gb + (16 * (2 * (p) + e) + 4 * quad) * 4); \
            _Pragma("unroll") for (int ks = 0; ks < 2; ++ks) kb[s][e][ks] = *(const LAS bf16x8*)(Kb + r8_off(16 * (2 * (p) + e) + r16, 4 * ks + quad)); } }
        SCAN_LD3(0, 0)
        __builtin_amdgcn_sched_barrier(0);
        { const int r0 = b * 2048 + c * 64;
          const bool odd = quad & 1; float ss[4]; v2u wv[4];
#pragma unroll
          for (int m = 0; m < 2; ++m) { const v4u ld = gcur[m]; v2u own, snd, rcv;
              own.x = odd ? ld.z : ld.x; own.y = odd ? ld.w : ld.y; snd.x = odd ? ld.x : ld.z; snd.y = odd ? ld.y : ld.w;
              rcv.x = (unsigned)__shfl_xor((int)snd.x, 16); rcv.y = (unsigned)__shfl_xor((int)snd.y, 16);
              const v2u ga = odd ? rcv : own, gb2 = odd ? own : rcv;
              { const f32x4 a = acc[2 * m];     wv[2 * m].x     = pkbf(a[0] * bflo(ga.x),  a[1] * bfhi(ga.x));  wv[2 * m].y     = pkbf(a[2] * bflo(ga.y),  a[3] * bfhi(ga.y));  ss[2 * m]     = (a[0] * a[0] + a[1] * a[1]) + (a[2] * a[2] + a[3] * a[3]); }
              { const f32x4 a = acc[2 * m + 1]; wv[2 * m + 1].x = pkbf(a[0] * bflo(gb2.x), a[1] * bfhi(gb2.x)); wv[2 * m + 1].y = pkbf(a[2] * bflo(gb2.y), a[3] * bfhi(gb2.y)); ss[2 * m + 1] = (a[0] * a[0] + a[1] * a[1]) + (a[2] * a[2] + a[3] * a[3]); } }
#pragma unroll
          for (int m = 0; m < 2; ++m) { const v2u mine = odd ? wv[2 * m + 1] : wv[2 * m], snd = odd ? wv[2 * m] : wv[2 * m + 1]; v2u rcv;
              rcv.x = (unsigned)__shfl_xor((int)snd.x, 16); rcv.y = (unsigned)__shfl_xor((int)snd.y, 16);
              v4u o4; o4.x = odd ? rcv.x : mine.x; o4.y = odd ? rcv.y : mine.y; o4.z = odd ? mine.x : rcv.x; o4.w = odd ? mine.y : rcv.y;
              *(GAS v4u*)(ZBp + (size_t)(r0 + 16 * (2 * m + (quad & 1)) + r16) * D + h * 512 + vcol0 + 4 * (quad & 2)) = o4; }
#pragma unroll
          for (int ti = 0; ti < 4; ++ti) ss[ti] += __shfl_xor(ss[ti], 16);
#pragma unroll
          for (int ti = 0; ti < 4; ++ti) ss[ti] += __shfl_xor(ss[ti], 32);
          { const float sq = quad == 0 ? ss[0] : quad == 1 ? ss[1] : quad == 2 ? ss[2] : ss[3];
            atomicAdd(RSO + (size_t)h * M + r0 + 16 * quad + r16, (unsigned long long)(sq * 16777216.0f)); } }
        __builtin_amdgcn_sched_barrier(0);
#pragma unroll
        for (int p = 0; p < 8; ++p) {
            if (p + 1 < 8) SCAN_LD3(p + 1, (p + 1) & 1)
            __builtin_amdgcn_sched_barrier(0);
            S[2 * p] = S[2 * p] * gb[p & 1][0]; S[2 * p + 1] = S[2 * p + 1] * gb[p & 1][1];
#pragma unroll
            for (int ks = 0; ks < 2; ++ks)
#pragma unroll
                for (int e = 0; e < 2; ++e) S[2 * p + e] = __builtin_amdgcn_mfma_f32_16x16x32_bf16(kb[p & 1][e][ks], vcur[ks], S[2 * p + e], 0, 0, 0);
            __builtin_amdgcn_sched_barrier(0);
        }
#undef SCAN_LD3
    };
#pragma unroll 1
    for (int c2 = 0; c2 < 32; c2 += 2) { chunk(c2, vf, vn, gq, gqn); chunk(c2 + 1, vn, vf, gqn, gq); }
    __builtin_amdgcn_s_setprio(0);
    { float* dst = outp() + O_GLAP + ((size_t)((l * 4 + b) * 4 + h) * 256) * 512 + vcol0 + r16;
#pragma unroll
        for (int i = 0; i < 16; ++i)
#pragma unroll
            for (int j = 0; j < 4; ++j) dst[(size_t)(16 * i + 4 * quad + j) * 512] = S[i][j]; }
    __syncthreads();
}
constexpr int CW_Q0 = 8192;
__device__ __forceinline__ void p_gla_sample(Frame& F0, int l, int rep) {
    Frame F = F0; asm volatile("" : "+v"(F.tid), "+v"(F.lane));
    const bf16* P = (const bf16*)(wsp() + WS_P); const float* LR = (const float*)(wsp() + WS_LR);
    LAS float* QK = (LAS float*)F.lds;
    LAS float* QH = (LAS float*)(F.lds + 20480);
    LAS float* KH = (LAS float*)(F.lds + 28672);
    LAS float* VS = (LAS float*)(F.lds + 36864);
    LAS float* AS = (LAS float*)(F.lds + 53248);
    LAS float* LRs = (LAS float*)(F.lds + 53504);
    LAS float* TOT = (LAS float*)(F.lds + 54016);
    LAS int* QW = (LAS int*)(F.lds + 56064);
    LAS float* OR = (LAS float*)(F.lds + 57344);
    unsigned* qhead = (unsigned*)(wsp() + WS_CTL) + CW_Q0 + 64 * (l + 4 * rep);
    const int k = F.tid & 255, half = F.tid >> 8;
    for (;;) {
        if (F.tid == 0) QW[0] = (int)__hip_atomic_fetch_add(qhead, 1u, __ATOMIC_RELAXED, __HIP_MEMORY_SCOPE_AGENT);
        __syncthreads();
        const int unit = QW[0];
        if (unit >= 1024) break;
        const int sb = unit >> 3, h = (unit >> 1) & 3, vh = unit & 1, r0 = MP + sb * 8;
        f32x4 lrv = {0.f, 0.f, 0.f, 0.f}; if (F.tid < 32) lrv = *(const GAS f32x4*)(LR + (size_t)r0 * 16 + 4 * F.tid);
        bf16 vraw[4], qraw[4], kraw[4];
#pragma unroll
        for (int i = 0; i < 4; ++i) { const int e = i * 512 + F.tid; vraw[i] = P[(size_t)(r0 + (e >> 8)) * PW + C_V + h * 512 + vh * 256 + (e & 255)];
            qraw[i] = P[(size_t)(r0 + half * 4 + i) * PW + C_Q + h * 256 + k]; kraw[i] = P[(size_t)(r0 + half * 4 + i) * PW + C_K + h * 256 + k]; }
        float w2[16]; const float bias = inp(I_BA)[l * 1024 + h * 256 + k];
        { const float* w2p = inp(I_WA2) + (size_t)l * 16 * 1024 + h * 256 + k;
#pragma unroll
          for (int j = 0; j < 16; ++j) w2[j] = w2p[j * 1024]; }
        if (F.tid < 32) *(LAS f32x4*)(LRs + 4 * F.tid) = lrv;
#pragma unroll
        for (int i = 0; i < 4; ++i) VS[i * 512 + F.tid] = bf1(vraw[i]);
        __syncthreads();
        float bc[4]; float run = 0.f;
#pragma unroll
        for (int i = 0; i < 4; ++i) { const LAS f32x4* lr4 = (const LAS f32x4*)(LRs + (half * 4 + i) * 16); float a = bias;
#pragma unroll
            for (int j4 = 0; j4 < 4; ++j4) { const f32x4 x = lr4[j4]; a += x[0] * w2[4 * j4] + x[1] * w2[4 * j4 + 1] + x[2] * w2[4 * j4 + 2] + x[3] * w2[4 * j4 + 3]; }
            run += logsig16(a); bc[i] = run; }
        TOT[half * 256 + k] = run;
        __syncthreads();
        const float lo_tot = TOT[k], blast = lo_tot + TOT[256 + k], boff = half ? lo_tot : 0.f;
        if (half == 0) QK[k * 20 + 16] = fexp(blast);
#pragma unroll
        for (int i = 0; i < 4; ++i) { const int t = half * 4 + i; const float bt = bc[i] + boff;
            const float qv = bf1(qraw[i]) * 0.0625f * fexp(bt), kv = bf1(kraw[i]);
            QK[k * 20 + t] = qv; QK[k * 20 + 8 + t] = kv * fexp(blast - bt); QH[t * 256 + k] = qv; KH[t * 256 + k] = kv * fexp(-bt); }
        __syncthreads();
        { const int e = F.tid >> 3, part = F.tid & 7, t = e >> 3, sq = e & 7; float a = 0.f;
#pragma unroll
          for (int i = 0; i < 32; ++i) a += QH[t * 256 + part * 32 + i] * KH[sq * 256 + part * 32 + i];
          a += __shfl_xor(a, 1); a += __shfl_xor(a, 2); a += __shfl_xor(a, 4);
          if (part == 0) AS[e] = (sq <= t) ? a : 0.f; }
        const int vq4 = F.tid & 63, kr = F.tid >> 6;
        f32x4 vv[8], oa[8];
#pragma unroll
        for (int t = 0; t < 8; ++t) { vv[t] = *(const LAS f32x4*)(VS + t * 256 + 4 * vq4); oa[t] = (f32x4){0.f, 0.f, 0.f, 0.f}; }
        const float* s0p = inp(I_SGLA) + ((size_t)((l * 128 + sb) * 4 + h) * 256 + kr) * 512 + vh * 256 + 4 * vq4;
        float* s1p = outp() + O_GLAS + ((size_t)((l * 128 + sb) * 4 + h) * 256 + kr) * 512 + vh * 256 + 4 * vq4;
        f32x4 cur[8], nxt[8];
#pragma unroll
        for (int u = 0; u < 8; ++u) cur[u] = __builtin_nontemporal_load((const f32x4*)(s0p + (size_t)(8 * u) * 512));
        for (int g = 0; g < 4; ++g) {
            if (g < 3) {
#pragma unroll
                for (int u = 0; u < 8; ++u) nxt[u] = __builtin_nontemporal_load((const f32x4*)(s0p + (size_t)(8 * (8 * (g + 1) + u)) * 512)); }
#pragma unroll
            for (int u = 0; u < 8; ++u) { const int kk = 8 * (8 * g + u) + kr; const f32x4 s0 = cur[u];
                const LAS f32x4* q4 = (const LAS f32x4*)(QK + kk * 20); const f32x4 qa = q4[0], qb = q4[1], ka = q4[2], kb = q4[3]; const float gm = QK[kk * 20 + 16];
                f32x4 sn = s0 * gm;
#pragma unroll
                for (int t = 0; t < 4; ++t) { oa[t] += s0 * qa[t]; oa[4 + t] += s0 * qb[t]; sn += vv[t] * ka[t]; sn += vv[4 + t] * kb[t]; }
                __builtin_nontemporal_store(sn, (f32x4*)(s1p + (size_t)(8 * (8 * g + u)) * 512)); }
#pragma unroll
            for (int u = 0; u < 8; ++u) cur[u] = nxt[u];
        }
#pragma unroll
        for (int t = 0; t < 8; ++t) *(LAS f32x4*)(OR + (kr * 8 + t) * 256 + 4 * vq4) = oa[t];
        __syncthreads();
        float ssv[4];
#pragma unroll
        for (int i = 0; i < 4; ++i) { const int e = i * 512 + F.tid, t = e >> 8, vc = e & 255; float o = 0.f;
#pragma unroll
            for (int q = 0; q < 8; ++q) o += OR[(q * 8 + t) * 256 + vc];
#pragma unroll
            for (int sq = 0; sq < 8; ++sq) o += AS[t * 8 + sq] * VS[sq * 256 + vc];
            const float sg = bf1(P[(size_t)(r0 + t) * PW + C_GG + h * 512 + vh * 256 + vc]);
            ((bf16*)(wsp() + WS_ZB))[(size_t)(r0 + t) * D + h * 512 + vh * 256 + vc] = bf1r(o * sg);
            ssv[i] = wave_sum(o * o); }
        { const float sv = F.lane == 0 ? ssv[0] : F.lane == 1 ? ssv[1] : F.lane == 2 ? ssv[2] : ssv[3];
          if (F.lane < 4) atomicAdd((unsigned long long*)(wsp() + WS_RSO) + ((size_t)l * 4 + h) * M + r0 + 2 * F.lane + (F.tid >> 8), (unsigned long long)(sv * 16777216.0f)); }
        __syncthreads();
    }
}
constexpr size_t WS_FIX = 1147 * MiB;
__device__ __forceinline__ void p_convfix(Frame& F0, int l) {
    Frame F = F0; asm volatile("" : "+v"(F.tid), "+v"(F.lane));
    const float* FX = (const float*)(wsp() + WS_FIX); bf16* ZA = (bf16*)(wsp() + WS_ZA); const float* cw = inp(I_CONVW) + (size_t)l * 3 * D;
    for (int it = F.vcu * 512 + F.tid; it < 128 * 2048; it += F.G * 512) { const int blk = it >> 11, ch = it & 2047;
        if ((blk & 31) == 0) continue;
        const float c0 = FX[(size_t)(blk * 2) * 2048 + ch], c1 = FX[(size_t)(blk * 2 + 1) * 2048 + ch];
        const float h0 = FX[524288 + (size_t)(blk * 2) * 2048 + ch], h1 = FX[524288 + (size_t)(blk * 2 + 1) * 2048 + ch];
        const float t0 = FX[1048576 + (size_t)((blk - 1) * 2) * 2048 + ch], t1 = FX[1048576 + (size_t)((blk - 1) * 2 + 1) * 2048 + ch];
        const float w0 = cw[ch], w1 = cw[D + ch], w2 = cw[2 * D + ch];
        ZA[(size_t)(blk * 64) * D + ch] = bf1r(c0 * (w0 * t0 + w1 * t1 + w2 * h0));
        ZA[(size_t)(blk * 64 + 1) * D + ch] = bf1r(c1 * (w0 * t1 + w1 * h0 + w2 * h1)); }
}
__device__ __forceinline__ void rt_row(LAS float* RT, const unsigned long long* RSO, int row) {
    const GAS unsigned long long* p = (const GAS unsigned long long*)(RSO + row);
    const float q0 = (float)p[0] * (1.f / 16777216.f), q1 = (float)p[M] * (1.f / 16777216.f), q2 = (float)p[2 * M] * (1.f / 16777216.f), q3 = (float)p[3 * M] * (1.f / 16777216.f);
    const float s0 = 1.f / sqrtf(q0 * (1.f / 512.f) + EPS), s1 = 1.f / sqrtf(q1 * (1.f / 512.f) + EPS), s2 = 1.f / sqrtf(q2 * (1.f / 512.f) + EPS), s3 = 1.f / sqrtf(q3 * (1.f / 512.f) + EPS);
    *(LAS f32x4*)(RT + (row & 255) * 8) = (f32x4){s0 / s1, s1 / s2, s2 / s3, s3}; *(LAS f32x4*)(RT + (row & 255) * 8 + 4) = (f32x4){1.f / s0, 0.f, 0.f, 0.f};
}
struct Args { const float* in[14]; float* out; unsigned char* ws; int ph_lo, ph_hi; };
constexpr int N_PHASES = 2 + 5 * DEPTH;
__global__ void __launch_bounds__(NWAVES * 64, 2) fwd(Args args) {
    extern __shared__ __attribute__((aligned(16))) unsigned char lds[];
    Frame F;
    F.lds = (LAS unsigned char*)lds;
    F.tid = threadIdx.x; F.lane = F.tid & 63; F.wave = __builtin_amdgcn_readfirstlane(F.tid >> 6);
    F.G = gridDim.x; { const int bx = blockIdx.x; F.vcu = (F.G % 8 == 0) ? (bx % 8) * (F.G / 8) + bx / 8 : bx; }
    volatile LAS unsigned* MISC = (volatile LAS unsigned*)(F.lds + MISC_OFF);
    for (int u = F.tid; u < (LDS_BYTES - LDSCTL_OFF) / 4; u += NWAVES * 64) ((LAS unsigned*)(F.lds + LDSCTL_OFF))[u] = 0u;
    __syncthreads();
    const int lo = args.ph_lo, hi = args.ph_hi;
    XcdBarrier bar; bar.bar = (unsigned*)(wsp() + WS_CTL) + CW_BAR; bar.x = 0; bar.st = nullptr;
    if (hi - lo > 1) bar = xcd_barrier_post((unsigned*)(wsp() + WS_CTL) + CW_BAR, MISC + 8);
#define IN(k) (lo <= (k) && (k) < hi)
#define SEAM(k) do { if (IN(k) && IN((k) + 1)) xcd_barrier(bar); } while (0)

    #ifndef NO_P0
    if (IN(0)) { for (int rep = 0; rep < REP_PRO; ++rep) p_prologue(F); p_xprep(F, 0); }
#endif
    SEAM(0);
#pragma unroll 1
    for (int l = 0; l < DEPTH; ++l) {
        const int pb = 1 + 5 * l;
#ifndef NO_PROJ
        if (IN(pb)) {
            unsigned char* const ws = wsp(); bf16* XB = (bf16*)(ws + WS_XB); bf16* P = (bf16*)(ws + WS_P); float* LR = (float*)(ws + WS_LR); const unsigned long long* RS = (const unsigned long long*)(ws + WS_RSQ) + (size_t)l * M;
            const bf16* Wt = (const bf16*)(ws + WS_WIN + l * WIN_L);
            pg8::Gemm g{XB, Wt, M, PW, D}; pg8::ProjOrder S; S.init(F.G, (int)blockIdx.x);
            pg8::EpiProj E{P, LR, RS, (bf16*)(ws + WS_ZA), (float*)(ws + WS_FIX), inp(I_CONVW) + (size_t)l * 3 * D, inp(I_SCONV) + (size_t)l * 128 * 2 * D, outp() + O_CONVP + (size_t)l * 4 * 2 * D, outp() + O_CONVS + (size_t)l * 128 * 2 * D};
            for (int rep = 0; rep < REP_PROJ; ++rep) {
            pg8::gemm_phase<pg8::EpiProj, pg8::ProjOrder, true, true>(F.lds + RING_OFF, g, S, E);
            for (int su = (int)blockIdx.x; su < 256 + M / 128; su += F.G) {
                if (su < 256) pg8::mini_gemm(F.lds + RING_OFF, XB, Wt, D, MP + (su >> 5) * 128, C_GG + (su & 31) * 64, E); else pg8::mini_gemm(F.lds + RING_OFF, XB, Wt, D, (su - 256) * 128, PW, E); }
            }
        }
#endif
        SEAM(pb);
        if (IN(pb + 1)) {
#ifndef NO_CONV
            for (int rep = 0; rep < REP_PREP; ++rep) p_convfix(F, l);
#endif
#ifndef NO_GLA
            for (int rep = 0; rep < REP_PREP; ++rep) p_gla_prep(F, l);
#endif
        } SEAM(pb + 1);
        if (IN(pb + 2)) {
#ifndef NO_GLA
            for (int rep = 0; rep < REP_SCAN; ++rep) { p_gla_scan(F, l); p_gla_sample(F, l, rep); }
#endif
        } SEAM(pb + 2);
#ifndef NO_BR
        if (IN(pb + 3)) {
            unsigned char* const ws = wsp(); bf16* P = (bf16*)(ws + WS_P); bf16* ZA = (bf16*)(ws + WS_ZA); bf16* ZB = (bf16*)(ws + WS_ZB); bf16* MG = (bf16*)(ws + WS_MG);
            const bf16* WtA = (const bf16*)(ws + WS_WA + l * W_L); const bf16* WtB = (const bf16*)(ws + WS_WB + l * W_L);
            LAS float* RT = (LAS float*)(F.lds + RT_OFF); const unsigned long long* RSO = (const unsigned long long*)(ws + WS_RSO) + (size_t)l * M * 4;
            pg8::StaticOrder S; S.init(MP, D, F.G, (int)blockIdx.x);
            pg8::EpiBrA2 EA{P + C_GA, P + C_GB, RT}; pg8::EpiBrB2 EB{P + C_GB, MG, RT};
            { pg8::Unit u0; if (S.next(0, u0) && F.tid < 256) rt_row(RT, RSO, u0.pm * 256 + F.tid); __syncthreads(); }
            { pg8::Gemm g{ZA, WtA, MP, D, D, ZB, WtB}; pg8::PairOrder S2; S2.init(MP, D, F.G, (int)blockIdx.x); pg8::EpiBr EE{EA, EB};
              pg8::gemm_phase<pg8::EpiBr, pg8::PairOrder, true, true>(F.lds + RING_OFF, g, S2, EE); }
            for (int su = (int)blockIdx.x; su < 256; su += F.G) { __syncthreads(); if (F.tid < 128) rt_row(RT, RSO, MP + (su >> 5) * 128 + F.tid); __syncthreads();
                f32x4 a2[2][2];
                pg8::mini_gemm_acc<pg8::EpiBrA2, true>(F.lds + RING_OFF, ZA, WtA, D, MP + (su >> 5) * 128, (su & 31) * 64, EA, a2);
                pg8::mini_gemm_acc<pg8::EpiBrB2, false>(F.lds + RING_OFF, ZB, WtB, D, MP + (su >> 5) * 128, (su & 31) * 64, EB, a2); }
        }
#endif
        SEAM(pb + 3);
#ifndef NO_OUT
        if (IN(pb + 4)) {
            unsigned char* const ws = wsp(); bf16* MG = (bf16*)(ws + WS_MG);
            const bf16* Wt = (const bf16*)(ws + WS_WO + l * W_L); pg8::Gemm g{MG, Wt, MP, D, D}; pg8::StaticOrder S; S.init(MP, D, F.G, (int)blockIdx.x);
            for (int rep = 0; rep < REP_OUT; ++rep) {
            LAS unsigned long long* rowsum = (LAS unsigned long long*)(F.lds + ROWSUM_OFF); unsigned long long* RSQn = (unsigned long long*)(ws + WS_RSQ) + (size_t)(rep > 0 ? DEPTH + 1 : l + 1) * M;
            if (F.tid < 256) rowsum[F.tid] = 0ull;
            __syncthreads();
            pg8::EpiOut E{(bf16*)(ws + (rep > 0 ? WS_ZA : WS_XB)), rowsum};
            pg8::gemm_phase<pg8::EpiOut, pg8::StaticOrder, true, true>(F.lds + RING_OFF, g, S, E);
            { pg8::Unit u0; const bool has = S.next(0, u0); asm volatile("s_waitcnt lgkmcnt(0)" ::: "memory"); __syncthreads();
              if (has && F.tid < 256) { atomicAdd(RSQn + u0.pm * 256 + F.tid, rowsum[F.tid]); rowsum[F.tid] = 0ull; } __syncthreads(); }
            for (int su = (int)blockIdx.x; su < 256; su += F.G) { pg8::mini_gemm(F.lds + RING_OFF, MG, Wt, D, MP + (su >> 5) * 128, (su & 31) * 64, E);
                asm volatile("s_waitcnt lgkmcnt(0)" ::: "memory"); __syncthreads();
                if (F.tid < 128) { const int row = MP + (su >> 5) * 128 + F.tid; atomicAdd(RSQn + row, rowsum[row & 255]); rowsum[row & 255] = 0ull; } __syncthreads(); }
            }
        }
#endif
        SEAM(pb + 4);
    }
    if (IN(1 + 5 * DEPTH)) p_final(F);
#undef IN
#undef SEAM
}

#ifndef MK_SINGLE
#define MK_SINGLE 1
#endif
extern "C" void kernel_launch(void* const* d_in, const int* in_sizes, int n_in, void* d_out, int out_size, void* d_ws, size_t ws_size, hipStream_t stream) {
    static int grid = 0;
    if (grid == 0) {
        if (n_in != 14 || (size_t)out_size != O_END || ws_size < WS_FIX + 6 * MiB) { fprintf(stderr, "kernel_launch: unexpected shapes (n_in %d out %d ws %zu)\n", n_in, out_size, ws_size); grid = -1; return; }
        int dev = 0, cus = 0, per_cu = 0;
        if (hipGetDevice(&dev) != hipSuccess || hipDeviceGetAttribute(&cus, hipDeviceAttributeMultiprocessorCount, dev) != hipSuccess) { grid = -1; return; }
        if (hipFuncSetAttribute((const void*)fwd, hipFuncAttributeMaxDynamicSharedMemorySize, LDS_BYTES) != hipSuccess) { fprintf(stderr, "kernel_launch: hipFuncSetAttribute failed\n"); grid = -1; return; }
        if (hipOccupancyMaxActiveBlocksPerMultiprocessor(&per_cu, (const void*)fwd, NWAVES * 64, LDS_BYTES) != hipSuccess || per_cu < 1) fprintf(stderr, "kernel_launch: occupancy query reports %d\n", per_cu);
        (void)hipGetLastError();
        grid = cus;
    }
    if (grid < 0) return;
    if (hipMemsetAsync((char*)d_ws + WS_CTL, 0, CTL_ZERO_BYTES, stream) != hipSuccess) return;
    Args a{};
    for (int i = 0; i < 14; ++i) a.in[i] = (const float*)d_in[i];
    a.out = (float*)d_out; a.ws = (unsigned char*)d_ws;
#if MK_SINGLE
    a.ph_lo = 0; a.ph_hi = N_PHASES;
    hipLaunchKernelGGL(fwd, dim3(grid), dim3(NWAVES * 64), LDS_BYTES, stream, a);
#else
    for (int p = 0; p < N_PHASES; ++p) { a.ph_lo = p; a.ph_hi = p + 1; hipLaunchKernelGGL(fwd, dim3(grid), dim3(NWAVES * 64), LDS_BYTES, stream, a); }
#endif
}
```

```cpp
#include <hip/hip_runtime.h>
#include <cstdio>
#include <cstdint>
#define REP_PROJ 1
#define REP_PREP 1
#define REP_SCAN 1
#define REP_ZB 1
#define REP_BR 1
#define REP_XN 1
#define REP_PRO 1
#define REP_MINI 1
#define REP_OUT 1
namespace pg8 {
#define PG8_LAS __attribute__((address_space(3)))
typedef unsigned short bf16_t;
typedef short bf16x8 __attribute__((ext_vector_type(8)));
typedef float f32x4 __attribute__((ext_vector_type(4)));
typedef unsigned u32x4 __attribute__((ext_vector_type(4)));
constexpr int BM = 256, BK = 64, HALF = 128, HTB = HALF * BK * 2  , STAGE_BYTES = 8 * HTB, NXCD = 8, WGM = 8;

__host__ __device__ __forceinline__ int lds_byte(int r, int c) { const int st = (r >> 4) * 2 + (c >> 5), rr = r & 15, cc = c & 31, ob = rr * 64 + cc * 2; return st * 1024 + (ob ^ (((ob >> 9) & 1) << 5)); }
__host__ __device__ __forceinline__ void stage_rc(int b, int& R, int& C) { const int st = b / 1024, sb = b % 1024, swz = sb ^ (((sb >> 9) & 1) << 5); R = (st >> 1) * 16 + swz / 64; C = (st & 1) * 32 + (swz % 64) / 2; }
__host__ __device__ __forceinline__ int perm32(int rho) { const int n = rho >> 4, i = rho & 15; return 8 * (i >> 2) + 4 * n + (i & 3); }

struct Unit { int pm, pn, sel; };
struct Gemm { const bf16_t* A; const bf16_t* Bt; int M, N, K; const bf16_t* A2; const bf16_t* Bt2; };

struct StaticOrder {
    int nM, nN, nwg, G, c;
    __host__ __device__ void init(int M, int N, int G_, int c_) { nM = M / BM; nN = N / BM; nwg = nM * nN; G = G_; c = c_; }
    __host__ __device__ bool next(int i, Unit& u) const {
        const long L = (long)i * G + c; if (L >= nwg) return false;
        int wgid = (int)L; { const int q = nwg / NXCD, r = nwg % NXCD, xcd = wgid % NXCD, off = wgid / NXCD; wgid = (xcd < r ? xcd * (q + 1) : r * (q + 1) + (xcd - r) * q) + off; }
        const int nig = WGM * nN, gid = wgid / nig, fm = gid * WGM, gsz = (nM - fm) < WGM ? (nM - fm) : WGM;
        u.pm = fm + ((wgid % nig) % gsz); u.pn = (wgid % nig) / gsz; u.sel = 0; return true;
    }
    __device__ __forceinline__ void a_ready(const Unit&) const {}
    __device__ __forceinline__ void done(const Unit&) const {}
};
__device__ __forceinline__ unsigned cvt_pk_bf16(float lo, float hi) { unsigned r; asm volatile("v_cvt_pk_bf16_f32 %0, %1, %2" : "=v"(r) : "v"(lo), "v"(hi)); return r; }
constexpr int PW = 18432;
__device__ __forceinline__ float sigm(float x) { return __builtin_amdgcn_rcpf(1.0f + __builtin_amdgcn_exp2f(-1.44269504f * x)); }
__device__ __forceinline__ float bflo(unsigned w) { return __uint_as_float(w << 16); }
__device__ __forceinline__ float bfhi(unsigned w) { return __uint_as_float(w & 0xffff0000u); }
__device__ __forceinline__ u32x4 pack8(const f32x4 v0, const f32x4 v1) { u32x4 w; w.x = cvt_pk_bf16(v0[0], v0[1]); w.y = cvt_pk_bf16(v0[2], v0[3]); w.z = cvt_pk_bf16(v1[0], v1[1]); w.w = cvt_pk_bf16(v1[2], v1[3]); return w; }
constexpr int PG8_RTAB_OFF = 150528;
struct EpiProj {
    static constexpr int DEPTH = 4; static constexpr bool MIDK = false, CONV = true, INPLACE = false, PAIR = false, RSTAB = true;
    bf16_t* P; float* LR; const unsigned long long* rsq;
    bf16_t* ZA; float* FIX; const float* convw; const float* sconv; float* ocp; float* ocs; mutable const PG8_LAS unsigned char* tab = nullptr;
    static __device__ __forceinline__ f32x4 ror(const f32x4 x, int n) { f32x4 y;
#pragma unroll
        for (int j = 0; j < 4; ++j) y[j] = __int_as_float(n == 1 ? __builtin_amdgcn_update_dpp(0, __float_as_int(x[j]), 0x121, 0xf, 0xf, false) : __builtin_amdgcn_update_dpp(0, __float_as_int(x[j]), 0x122, 0xf, 0xf, false)); return y; }
    __device__ __forceinline__ void conv_unit(const f32x4 (&acc)[2][2][4][2], const Unit& u, int wr, int wc, int fr, int fq) const {
        const int ch0 = 64 * (u.pn - 16) + 16 * wc + 4 * fq; const bool sample = u.pm >= 32;
        const PG8_LAS float* wt = (const PG8_LAS float*)(tab + 2048) + 16 * wc + 4 * fq;
        const f32x4 w0 = *(const PG8_LAS f32x4*)wt, w1 = *(const PG8_LAS f32x4*)(wt + 64), w2 = *(const PG8_LAS f32x4*)(wt + 128);
        unsigned long long rq[2][4];
#pragma unroll
        for (int ai = 0; ai < 2; ++ai)
#pragma unroll
            for (int m = 0; m < 4; ++m) rq[ai][m] = *(const PG8_LAS unsigned long long*)(tab + (ai * HALF + wr * 64 + m * 16 + fr) * 8);
#pragma unroll
        for (int ai = 0; ai < 2; ++ai) { const int br0 = u.pm * BM + ai * HALF + wr * 64, blk = br0 >> 6; const bool seqstart = (br0 & 2047) == 0, seqend = ((br0 + 64) & 2047) == 0;
            f32x4 uprev = {0.f, 0.f, 0.f, 0.f};
#pragma unroll
            for (int m = 0; m < 4; ++m) { const int r = br0 + m * 16 + fr;
                const float rstd = __builtin_amdgcn_rsqf((float)rq[ai][m] * (1.0f / 16777216.0f) * (1.0f / 2048.0f) + 1e-6f);
                const f32x4 cB = acc[ai][0][m][0] * rstd, cC = acc[ai][0][m][1] * rstd, cx = acc[ai][1][m][0] * rstd; f32x4 cg = acc[ai][1][m][1] * rstd;
#pragma unroll
                for (int j = 0; j < 4; ++j) cg[j] = cg[j] * sigm(cg[j]);
                const f32x4 uu = cC * cx, cbg = cB * cg, t1 = ror(uu, 1), t2 = ror(uu, 2);
                f32x4 u1, u2;
                if (!sample) { const f32x4 p1 = ror(uprev, 1), p2 = ror(uprev, 2);
#pragma unroll
                    for (int j = 0; j < 4; ++j) { u1[j] = fr >= 1 ? t1[j] : p1[j]; u2[j] = fr >= 2 ? t2[j] : p2[j]; }
                } else { const int t = fr & 7, sb = (r - 8192) >> 3; const f32x4 b0 = *(const f32x4*)(sconv + (size_t)sb * 4096 + ch0), b1 = *(const f32x4*)(sconv + (size_t)sb * 4096 + 2048 + ch0);
#pragma unroll
                    for (int j = 0; j < 4; ++j) { u1[j] = t >= 1 ? t1[j] : b1[j]; u2[j] = t >= 2 ? t2[j] : (t == 1 ? b1[j] : b0[j]); }
                    if (t >= 6) *(f32x4*)(ocs + (size_t)sb * 4096 + (t - 6) * 2048 + ch0) = uu; }
                const f32x4 z = cbg * (w0 * u2 + w1 * u1 + w2 * uu);
                if (!sample && m == 0 && fr < 2 && !seqstart) {
                    *(f32x4*)(FIX + ((size_t)(blk * 2 + fr)) * 2048 + ch0) = cbg; *(f32x4*)(FIX + (size_t)524288 + ((size_t)(blk * 2 + fr)) * 2048 + ch0) = uu;
                } else { typedef unsigned u32x2 __attribute__((ext_vector_type(2))); u32x2 w; w.x = cvt_pk_bf16(z[0], z[1]); w.y = cvt_pk_bf16(z[2], z[3]); *(u32x2*)(ZA + (size_t)r * 2048 + ch0) = w; }
                if (!sample && m == 3 && fr >= 14) { *(f32x4*)(FIX + (size_t)1048576 + ((size_t)(blk * 2 + fr - 14)) * 2048 + ch0) = uu;
                    if (seqend) *(f32x4*)(ocp + ((size_t)(br0 >> 11) * 2 + (fr - 14)) * 2048 + ch0) = uu; }
                uprev = uu; } }
    }
    struct Pre { float rs; };
    __device__ __forceinline__ Pre pre(int r, int) const { Pre p; p.rs = (float)rsq[r] * (1.0f / 16777216.0f); return p; }
    __device__ __forceinline__ Pre pre_t(int r) const { Pre p; p.rs = (float)(*(const PG8_LAS unsigned long long*)(tab + (r & 255) * 8)) * (1.0f / 16777216.0f); return p; }
    __device__ __forceinline__ void tab_stage(PG8_LAS unsigned char* lds, const Unit& u, int slot, int wid, int lane) const {
        PG8_LAS unsigned char* t = lds + PG8_RTAB_OFF + slot * 3072;
        if (wid < 2) __builtin_amdgcn_global_load_lds((const unsigned*)((const char*)rsq + ((size_t)u.pm * 256 + wid * 128) * 8 + lane * 16), (PG8_LAS unsigned*)(t + wid * 1024), 16, 0, 0);
        else if (wid == 2) { const int pc = (u.pn >= 16 && u.pn < 48) ? u.pn - 16 : 0, L = lane < 48 ? lane : 47;
            __builtin_amdgcn_global_load_lds((const unsigned*)((const char*)convw + ((size_t)(L >> 4) * 2048 + 64 * pc + 4 * (L & 15)) * 4), (PG8_LAS unsigned*)(t + 2048), 16, 0, 0); }
    }
    __device__ __forceinline__ void tab_set(PG8_LAS unsigned char* lds, int slot) const { tab = lds + PG8_RTAB_OFF + slot * 3072; }
    __device__ __forceinline__ void fin(int r, int c, f32x4 v0, f32x4 v1, const Pre& p) const {
        const int t = c >> 8; const float rstd = __builtin_amdgcn_rsqf(p.rs * (1.0f / 2048.0f) + 1e-6f); v0 = v0 * rstd; v1 = v1 * rstd;
        if (t >= 72) { const int cc = c - 72 * 256; if (cc < 16) { *(f32x4*)(LR + (size_t)r * 16 + cc) = v0; *(f32x4*)(LR + (size_t)r * 16 + cc + 4) = v1; } return; }
        const int mode = (t < 16) ? 1 : (((t >= 40 && t < 48) || t >= 64) ? 2 : 0);
        if (mode == 1) {
#pragma unroll
            for (int j = 0; j < 4; ++j) { v0[j] = sigm(v0[j]); v1[j] = sigm(v1[j]); } }
        if (mode == 2) {
#pragma unroll
            for (int j = 0; j < 4; ++j) { v0[j] = v0[j] * sigm(v0[j]); v1[j] = v1[j] * sigm(v1[j]); } }
        *(u32x4*)(P + (size_t)r * PW + c) = pack8(v0, v1);
    }
};
struct EpiBrA2 {
    static constexpr int DEPTH = 4; static constexpr bool MIDK = false, CONV = false, INPLACE = true, PAIR = false, RSTAB = false;
    const bf16_t* GA; const bf16_t* GB; const PG8_LAS float* RT;
    struct Pre { u32x4 a, b; };
    __device__ __forceinline__ Pre pre(int r, int c) const { Pre p; p.a = *(const u32x4*)(GA + (size_t)r * PW + c); p.b = *(const u32x4*)(GB + (size_t)r * PW + c); return p; }
    static __device__ __forceinline__ float fac(float ga, float gb, float i0) { return ga * __builtin_amdgcn_rcpf(fmaxf(gb, 1e-30f)) * i0; }
    __device__ __forceinline__ void fin_ip(int r, int, f32x4& v0, f32x4& v1, const Pre& p) const {
        const float i0 = RT[(r & 255) * 8 + 4];
        v0[0] *= fac(bflo(p.a.x), bflo(p.b.x), i0); v0[1] *= fac(bfhi(p.a.x), bfhi(p.b.x), i0); v0[2] *= fac(bflo(p.a.y), bflo(p.b.y), i0); v0[3] *= fac(bfhi(p.a.y), bfhi(p.b.y), i0);
        v1[0] *= fac(bflo(p.a.z), bflo(p.b.z), i0); v1[1] *= fac(bfhi(p.a.z), bfhi(p.b.z), i0); v1[2] *= fac(bflo(p.a.w), bflo(p.b.w), i0); v1[3] *= fac(bfhi(p.a.w), bfhi(p.b.w), i0);
    }
};
struct EpiBrB2 {
    static constexpr int DEPTH = 8; static constexpr bool MIDK = true, CONV = false, INPLACE = false, PAIR = false, RSTAB = false;
    const bf16_t* GB; bf16_t* MG; const PG8_LAS float* RT;
    struct Pre { u32x4 g; };
    __device__ __forceinline__ Pre pre(int r, int c) const { Pre p; p.g = *(const u32x4*)(GB + (size_t)r * PW + c); return p; }
    __device__ __forceinline__ void fin(int r, int c, f32x4 v0, f32x4 v1, const Pre& p) const {
        const float s3 = RT[(r & 255) * 8 + 3];
        v0[0] *= s3 * fmaxf(bflo(p.g.x), 1e-30f); v0[1] *= s3 * fmaxf(bfhi(p.g.x), 1e-30f); v0[2] *= s3 * fmaxf(bflo(p.g.y), 1e-30f); v0[3] *= s3 * fmaxf(bfhi(p.g.y), 1e-30f);
        v1[0] *= s3 * fmaxf(bflo(p.g.z), 1e-30f); v1[1] *= s3 * fmaxf(bfhi(p.g.z), 1e-30f); v1[2] *= s3 * fmaxf(bflo(p.g.w), 1e-30f); v1[3] *= s3 * fmaxf(bfhi(p.g.w), 1e-30f);
        *(u32x4*)(MG + (size_t)r * 2048 + c) = pack8(v0, v1);
    }
    __device__ __forceinline__ float ratio(int r, int seg) const { return RT[(r & 255) * 8 + seg]; }
};
struct EpiBr {
    static constexpr int DEPTH = 8; static constexpr bool MIDK = true, CONV = false, INPLACE = false, PAIR = true, RSTAB = false;
    EpiBrA2 a; EpiBrB2 b;
    __device__ __forceinline__ float ratio(int r, int seg) const { return b.ratio(r, seg); }
};
struct PairOrder {
    StaticOrder so;
    __device__ void init(int M, int N, int G_, int c_) { so.init(M, N, G_, c_); }
    __device__ bool next(int i, Unit& u) const { if (!so.next(i >> 1, u)) return false; u.sel = i & 1; return true; }
    __device__ __forceinline__ void a_ready(const Unit&) const {}
    __device__ __forceinline__ void done(const Unit&) const {}
};
struct EpiOut {
    static constexpr int DEPTH = 8; static constexpr bool MIDK = false, CONV = false, INPLACE = false, PAIR = false, RSTAB = false;
    bf16_t* XB; PG8_LAS unsigned long long* rowsum;
    struct Pre { u32x4 x; };
    __device__ __forceinline__ Pre pre(int r, int c) const { Pre p; p.x = *(const u32x4*)(XB + (size_t)r * 2048 + c); return p; }
    __device__ __forceinline__ void fin(int r, int c, f32x4 v0, f32x4 v1, const Pre& p) const {
        v0[0] += bflo(p.x.x); v0[1] += bfhi(p.x.x); v0[2] += bflo(p.x.y); v0[3] += bfhi(p.x.y); v1[0] += bflo(p.x.z); v1[1] += bfhi(p.x.z); v1[2] += bflo(p.x.w); v1[3] += bfhi(p.x.w);
        *(u32x4*)(XB + (size_t)r * 2048 + c) = pack8(v0, v1);
        const float ss = (v0[0] * v0[0] + v0[1] * v0[1]) + (v0[2] * v0[2] + v0[3] * v0[3]) + (v1[0] * v1[0] + v1[1] * v1[1]) + (v1[2] * v1[2] + v1[3] * v1[3]);
        (void)__hip_atomic_fetch_add(rowsum + (r & 255), (unsigned long long)(ss * 16777216.0f), __ATOMIC_RELAXED, __HIP_MEMORY_SCOPE_WORKGROUP);
    }
};
template <class Epi> __device__ __forceinline__ void epi_big(const Epi& E, f32x4 (&acc)[2][2][4][2], const Unit& u, int wr, int wc, int fr, int fq) {
    if constexpr (Epi::PAIR) { if (u.sel == 0) epi_big(E.a, acc, u, wr, wc, fr, fq); else epi_big(E.b, acc, u, wr, wc, fr, fq); return; } else {
    if constexpr (Epi::CONV) { if (u.pn >= 16 && u.pn < 48) { E.conv_unit(acc, u, wr, wc, fr, fq); return; } }
    const int row0 = u.pm * BM + wr * 64 + fr, col0 = u.pn * BM + wc * 32 + 8 * fq;
    constexpr int DP = Epi::DEPTH;
    typename Epi::Pre pq[DP];
#define EPI_R(i) (row0 + ((i) >> 3) * HALF + (((i) >> 1) & 3) * 16)
#define EPI_C(i) (col0 + ((i) & 1) * HALF)
#pragma unroll
    for (int i = 0; i < DP; ++i) { if constexpr (Epi::RSTAB) pq[i] = E.pre_t(EPI_R(i)); else pq[i] = E.pre(EPI_R(i), EPI_C(i)); }
#pragma unroll
    for (int idx = 0; idx < 16; ++idx) { const int ai = idx >> 3, m = (idx >> 1) & 3, bj = idx & 1;
        if constexpr (Epi::INPLACE) E.fin_ip(EPI_R(idx), EPI_C(idx), acc[ai][bj][m][0], acc[ai][bj][m][1], pq[idx % DP]); else E.fin(EPI_R(idx), EPI_C(idx), acc[ai][bj][m][0], acc[ai][bj][m][1], pq[idx % DP]);
        asm volatile("" ::: "memory");
        if (idx + DP < 16) { if constexpr (Epi::RSTAB) pq[idx % DP] = E.pre_t(EPI_R(idx + DP)); else pq[idx % DP] = E.pre(EPI_R(idx + DP), EPI_C(idx + DP)); } }
#undef EPI_R
#undef EPI_C
    }
}
#define PG8_GAS __attribute__((address_space(1)))
constexpr int MINI_SLOT = 24576;
template <class Epi, bool ZERO0> __device__ __forceinline__ void mini_gemm_acc(PG8_LAS unsigned char* lds, const bf16_t* A, const bf16_t* Bt, int K, int row0, int col0, const Epi& E, f32x4 (&acc)[2][2]) {
    int tid_ = threadIdx.x; asm volatile("" : "+v"(tid_));
    const int tid = tid_, wid = __builtin_amdgcn_readfirstlane(tid >> 6), lane = tid & 63, r16 = lane & 15, quad = lane >> 4, wrow = wid >> 1, wcol = wid & 1;
    const PG8_GAS char* src[3];
#pragma unroll
    for (int i = 0; i < 2; ++i) { const int q = 64 * (wid + 8 * i) + lane, row = q >> 3, p = (q & 7) ^ ((row >> 1) & 7); src[i] = (const PG8_GAS char*)(A + (size_t)(row0 + row) * K + 8 * p); }
    { const int q = 64 * wid + lane, row = q >> 3, p = (q & 7) ^ ((row >> 1) & 7); src[2] = (const PG8_GAS char*)(Bt + (size_t)(col0 + (row & ~31) + perm32(row & 31)) * K + 8 * p); }
    const int nkt = K / 64;
    const int dst0 = wid * 1024 + lane * 16, dst1 = (wid + 8) * 1024 + lane * 16, dst2 = (16 + wid) * 1024 + lane * 16;
    if constexpr (ZERO0) {
#pragma unroll
    for (int i = 0; i < 2; ++i)
#pragma unroll
        for (int j = 0; j < 2; ++j) acc[i][j] = (f32x4){0.f, 0.f, 0.f, 0.f};
    }
    int aoff[2], boff[2];
#pragma unroll
    for (int t = 0; t < 2; ++t) { const int ra = 32 * wrow + 16 * t + r16, rb = 32 * wcol + 16 * t + r16; aoff[t] = ra * 128; boff[t] = 16384 + rb * 128; }
    const int sw = (r16 >> 1) & 7;
    constexpr int PD = 4;
    u32x4 q[PD][3];
#pragma unroll
    for (int p = 0; p < PD; ++p)
#pragma unroll
        for (int i = 0; i < 3; ++i) q[p][i] = *(const PG8_GAS u32x4*)(src[i] + (size_t)p * 128);
#pragma unroll 1
    for (int kt0 = 0; kt0 < nkt; kt0 += PD) {
#pragma unroll
        for (int p = 0; p < PD; ++p) { const int kt = kt0 + p;
            PG8_LAS unsigned char* sl = lds + (p & 1) * MINI_SLOT;
            *(PG8_LAS u32x4*)(sl + dst0) = q[p][0]; *(PG8_LAS u32x4*)(sl + dst1) = q[p][1]; *(PG8_LAS u32x4*)(sl + dst2) = q[p][2];
            { const int kk = kt + PD < nkt ? kt + PD : nkt - 1;
#pragma unroll
              for (int i = 0; i < 3; ++i) q[p][i] = *(const PG8_GAS u32x4*)(src[i] + (size_t)kk * 128); }
            asm volatile("s_waitcnt lgkmcnt(0)" ::: "memory"); __builtin_amdgcn_s_barrier(); asm volatile("" ::: "memory");
            if constexpr (Epi::MIDK) { if (p == 0 && (kt0 == 8 || kt0 == 16 || kt0 == 24)) { const int seg = (kt0 >> 3) - 1;
#pragma unroll
                for (int mt = 0; mt < 2; ++mt) { const float rho = E.ratio(row0 + 32 * wrow + 16 * mt + r16, seg); acc[mt][0] = acc[mt][0] * rho; acc[mt][1] = acc[mt][1] * rho; } } }
#pragma unroll
            for (int ks = 0; ks < 2; ++ks) { bf16x8 af[2], bfr[2];
#pragma unroll
                for (int t = 0; t < 2; ++t) { af[t] = *(const PG8_LAS bf16x8*)(sl + aoff[t] + (((4 * ks + quad) ^ sw) << 4)); bfr[t] = *(const PG8_LAS bf16x8*)(sl + boff[t] + (((4 * ks + quad) ^ sw) << 4)); }
#pragma unroll
                for (int mt = 0; mt < 2; ++mt)
#pragma unroll
                    for (int nt = 0; nt < 2; ++nt) acc[mt][nt] = __builtin_amdgcn_mfma_f32_16x16x32_bf16(bfr[nt], af[mt], acc[mt][nt], 0, 0, 0); }
        }
    }
    asm volatile("s_waitcnt lgkmcnt(0)" ::: "memory"); __builtin_amdgcn_s_barrier(); asm volatile("" ::: "memory");
    const int r = row0 + 32 * wrow + r16, c = col0 + 32 * wcol + 8 * quad;
    typename Epi::Pre p0 = E.pre(r, c), p1 = E.pre(r + 16, c);
    if constexpr (Epi::INPLACE) { E.fin_ip(r, c, acc[0][0], acc[0][1], p0); E.fin_ip(r + 16, c, acc[1][0], acc[1][1], p1); }
    else { E.fin(r, c, acc[0][0], acc[0][1], p0); E.fin(r + 16, c, acc[1][0], acc[1][1], p1); }
}
template <class Epi> __device__ __forceinline__ void mini_gemm(PG8_LAS unsigned char* lds, const bf16_t* A, const bf16_t* Bt, int K, int row0, int col0, const Epi& E) { f32x4 acc[2][2]; mini_gemm_acc<Epi, true>(lds, A, Bt, K, row0, col0, E, acc); }
struct ProjOrder {
    StaticOrder so; int G, c;
    __device__ void init(int G_, int c_) { so.init(8192, 18432, G_, c_); G = G_; c = c_; }
    __device__ bool next(int i, Unit& u) const {
        const long L = (long)i * G + c;
        if (L < 2304) return so.next(i, u);
        if (L < 2560) { const int j = (int)L - 2304; u.pm = 32 + (j & 3); u.pn = j >> 2; u.sel = 0; return true; }
        return false;
    }
    __device__ __forceinline__ void a_ready(const Unit&) const {}
    __device__ __forceinline__ void done(const Unit&) const {}
};
template <class Epi, class Sched, bool ALIGN_EPI, bool SP2, bool ZERO0>
__device__ __forceinline__ void gemm_phase_acc(PG8_LAS unsigned char* lds, const Gemm g, const Sched& S, const Epi& E, f32x4 (&acc)[2][2][4][2]) {
    int tid_ = threadIdx.x; asm volatile("" : "+v"(tid_));
    const int tid = tid_, wid = __builtin_amdgcn_readfirstlane(tid >> 6), lane = tid & 63, wr = wid >> 2, wc = wid & 3, fr = lane & 15, fq = lane >> 4;
    const int K = g.K, nt = K / BK;
    unsigned voffA[2], voffB[2];
#pragma unroll
    for (int i = 0; i < 2; ++i) { int R, C; stage_rc(tid * 16 + i * 8192, R, C); const int Rb = (R & ~31) + perm32(R & 31);
        voffA[i] = (unsigned)(R * K + C) * 2u; voffB[i] = (unsigned)(Rb * K + C) * 2u; }
    const size_t kstep = (size_t)(BK * 2);
    const size_t hstep = (size_t)HALF * K * 2;
    const size_t tstep = 2 * hstep;
    const unsigned ldsw = (unsigned)wid * 1024u;
    const int aoff = lds_byte(wr * 64 + fr, fq * 8), boff = lds_byte(wc * 32 + fr, fq * 8);
#define PG8_SA(b, h) (((b) * 2 + (h)) * HTB)
#define PG8_SB(b, h) ((4 + (b) * 2 + (h)) * HTB)
#define PG8_STAGE(bufoff, gbase, voff) do { _Pragma("unroll") for (int _i = 0; _i < 2; ++_i) \
        __builtin_amdgcn_global_load_lds((const unsigned*)((const char*)(gbase) + (voff)[_i]), (PG8_LAS unsigned*)(lds + (bufoff) + ldsw + _i * 8192), 16, 0, 0); } while (0)
#define PG8_LDA(dst, b, h) do { _Pragma("unroll") for (int m = 0; m < 4; ++m) _Pragma("unroll") for (int k = 0; k < 2; ++k) dst[m][k] = *(const PG8_LAS bf16x8*)(lds + PG8_SA(b, h) + aoff + m * 2048 + k * 1024); } while (0)
#define PG8_LDB(dst, b, h) do { _Pragma("unroll") for (int n = 0; n < 2; ++n) _Pragma("unroll") for (int k = 0; k < 2; ++k) dst[n][k] = *(const PG8_LAS bf16x8*)(lds + PG8_SB(b, h) + boff + n * 2048 + k * 1024); } while (0)
#define PG8_MMA(ai, bj, At, Bt) do { __builtin_amdgcn_s_setprio(1); _Pragma("unroll") for (int m = 0; m < 4; ++m) _Pragma("unroll") for (int n = 0; n < 2; ++n) _Pragma("unroll") for (int k = 0; k < 2; ++k) \
        acc[ai][bj][m][n] = __builtin_amdgcn_mfma_f32_16x16x32_bf16(Bt[n][k], At[m][k], acc[ai][bj][m][n], 0, 0, 0); __builtin_amdgcn_s_setprio(0); } while (0)
#define PG8_WAIT_V(n) asm volatile("s_waitcnt vmcnt(" #n ")" ::: "memory")
#define PG8_WAIT_L(n) asm volatile("s_waitcnt lgkmcnt(" #n ")" ::: "memory")
#define PG8_BAR __builtin_amdgcn_s_barrier()
#define PG8_SCHED __builtin_amdgcn_sched_barrier(0)
    Unit cur, nxt; int ui = 0;
    if (!S.next(0, cur)) return;
    if constexpr (ZERO0) {
#pragma unroll
    for (int a = 0; a < 2; ++a)
#pragma unroll
        for (int b = 0; b < 2; ++b)
#pragma unroll
            for (int m = 0; m < 4; ++m)
#pragma unroll
                for (int n = 0; n < 2; ++n) acc[a][b][m][n] = (f32x4){0.f, 0.f, 0.f, 0.f};
    }
    bf16x8 At[4][2], B0[2][2], B1[2][2];
    const char* cA = (const char*)(cur.sel ? g.A2 : g.A) + (size_t)cur.pm * tstep; const char* cB = (const char*)(cur.sel ? g.Bt2 : g.Bt) + (size_t)cur.pn * tstep;
    S.a_ready(cur);
    if constexpr (Epi::RSTAB) E.tab_stage(lds, cur, 0, wid, lane);
    if constexpr (SP2) {
        PG8_STAGE(PG8_SB(0, 0), cB, voffB); PG8_STAGE(PG8_SB(0, 1), cB + hstep, voffB); PG8_STAGE(PG8_SA(0, 0), cA, voffA); PG8_STAGE(PG8_SA(0, 1), cA + hstep, voffA);
        if (wr == 1) PG8_BAR;
        PG8_WAIT_V(2); PG8_BAR;
        PG8_STAGE(PG8_SB(1, 0), cB + kstep, voffB); PG8_STAGE(PG8_SA(1, 0), cA + kstep, voffA); PG8_STAGE(PG8_SB(1, 1), cB + hstep + kstep, voffB);
        PG8_WAIT_V(6); PG8_BAR;
    } else {
        PG8_STAGE(PG8_SB(0, 0), cB, voffB); PG8_STAGE(PG8_SA(0, 0), cA, voffA); PG8_STAGE(PG8_SB(0, 1), cB + hstep, voffB); PG8_STAGE(PG8_SA(0, 1), cA + hstep, voffA);
        if (wr == 1) PG8_BAR;
        PG8_WAIT_V(4); PG8_BAR;
        PG8_STAGE(PG8_SB(1, 0), cB + kstep, voffB); PG8_STAGE(PG8_SA(1, 0), cA + kstep, voffA); PG8_STAGE(PG8_SB(1, 1), cB + hstep + kstep, voffB);
        PG8_WAIT_V(6); PG8_BAR;
    }
    for (;;) {
        const bool has_next = S.next(ui + 1, nxt);
        const char* nA = has_next ? (const char*)(nxt.sel ? g.A2 : g.A) + (size_t)nxt.pm * tstep : cA; const char* nB = has_next ? (const char*)(nxt.sel ? g.Bt2 : g.Bt) + (size_t)nxt.pn * tstep : cB;
        for (int t = 0; t < nt; t += 2) {
            if constexpr (Epi::MIDK) { if (cur.sel == 1 && (t == 8 || t == 16 || t == 24)) {
                const int seg = (t >> 3) - 1;
#pragma unroll
                for (int ai = 0; ai < 2; ++ai)
#pragma unroll
                    for (int m = 0; m < 4; ++m) { const float rho = E.ratio(ai * HALF + wr * 64 + m * 16 + fr, seg);
#pragma unroll
                        for (int bj = 0; bj < 2; ++bj)
#pragma unroll
                            for (int n = 0; n < 2; ++n) acc[ai][bj][m][n] = acc[ai][bj][m][n] * rho; } } }
            const bool last = (t == nt - 2);
            const char* a1 = cA + (size_t)(t + 1) * kstep;
            const char* a2 = last ? nA : cA + (size_t)(t + 2) * kstep; const char* b2 = last ? nB : cB + (size_t)(t + 2) * kstep;
            const char* a3 = a2 + kstep; const char* b3 = b2 + kstep;
            if (last && has_next) S.a_ready(nxt);
            if constexpr (SP2) {
            PG8_LDB(B0, 0, 0); PG8_LDB(B1, 0, 1); PG8_SCHED; PG8_LDA(At, 0, 0); PG8_STAGE(PG8_SA(1, 1), a1 + hstep, voffA);
            PG8_WAIT_V(8); PG8_WAIT_L(0); PG8_BAR; PG8_MMA(0, 0, At, B0); PG8_MMA(0, 1, At, B1); PG8_BAR; PG8_SCHED;
            PG8_LDA(At, 0, 1); if constexpr (Epi::RSTAB) { if (last && has_next) E.tab_stage(lds, nxt, (ui + 1) & 1, wid, lane); }
            PG8_STAGE(PG8_SB(0, 0), b2, voffB); PG8_STAGE(PG8_SB(0, 1), b2 + hstep, voffB); PG8_STAGE(PG8_SA(0, 0), a2, voffA);
            PG8_WAIT_V(8); PG8_WAIT_L(0); PG8_BAR; PG8_MMA(1, 0, At, B0); PG8_MMA(1, 1, At, B1); PG8_BAR; PG8_SCHED;
            PG8_LDB(B0, 1, 0); PG8_LDB(B1, 1, 1); PG8_SCHED; PG8_LDA(At, 1, 0); PG8_STAGE(PG8_SA(0, 1), a2 + hstep, voffA);
            PG8_WAIT_V(8); PG8_WAIT_L(0); PG8_BAR; PG8_MMA(0, 0, At, B0); PG8_MMA(0, 1, At, B1); PG8_BAR; PG8_SCHED;
            PG8_LDA(At, 1, 1); PG8_STAGE(PG8_SB(1, 0), b3, voffB); PG8_STAGE(PG8_SB(1, 1), b3 + hstep, voffB); PG8_STAGE(PG8_SA(1, 0), a3, voffA);
            PG8_WAIT_V(8); PG8_WAIT_L(0); PG8_BAR; PG8_MMA(1, 0, At, B0); PG8_MMA(1, 1, At, B1); PG8_BAR; PG8_SCHED;
            } else {
            PG8_LDB(B0, 0, 0); PG8_SCHED; PG8_LDA(At, 0, 0); PG8_STAGE(PG8_SA(1, 1), a1 + hstep, voffA);
            PG8_WAIT_L(8); PG8_BAR; PG8_WAIT_L(0); PG8_MMA(0, 0, At, B0); PG8_BAR; PG8_SCHED;
            PG8_LDB(B1, 0, 1); PG8_STAGE(PG8_SB(0, 0), b2, voffB);
            PG8_BAR; PG8_WAIT_L(0); PG8_MMA(0, 1, At, B1); PG8_BAR;
            PG8_LDA(At, 0, 1); PG8_STAGE(PG8_SA(0, 0), a2, voffA);
            PG8_BAR; PG8_WAIT_L(0); PG8_MMA(1, 0, At, B0); PG8_BAR; PG8_SCHED;
            PG8_STAGE(PG8_SB(0, 1), b2 + hstep, voffB);
            PG8_WAIT_V(6); PG8_BAR; PG8_MMA(1, 1, At, B1); PG8_BAR;
            PG8_LDB(B0, 1, 0); PG8_SCHED; PG8_LDA(At, 1, 0); PG8_STAGE(PG8_SA(0, 1), a2 + hstep, voffA);
            PG8_WAIT_L(8); PG8_BAR; PG8_WAIT_L(0); PG8_MMA(0, 0, At, B0); PG8_BAR; PG8_SCHED;
            PG8_LDB(B1, 1, 1); PG8_STAGE(PG8_SB(1, 0), b3, voffB);
            PG8_BAR; PG8_WAIT_L(0); PG8_MMA(0, 1, At, B1); PG8_BAR;
            PG8_LDA(At, 1, 1); PG8_STAGE(PG8_SA(1, 0), a3, voffA);
            PG8_BAR; PG8_WAIT_L(0); PG8_MMA(1, 0, At, B0); PG8_BAR; PG8_SCHED;
            PG8_STAGE(PG8_SB(1, 1), b3 + hstep, voffB);
            PG8_WAIT_V(6); PG8_BAR; PG8_MMA(1, 1, At, B1); PG8_BAR;
            }
        }
        if constexpr (ALIGN_EPI) { if (wr == 0) PG8_BAR; }
        if constexpr (Epi::RSTAB) E.tab_set(lds, ui & 1);
        epi_big(E, acc, cur, wr, wc, fr, fq); S.done(cur);
        if (!has_next) break;
        if (nxt.sel == 0) {
#pragma unroll
        for (int a = 0; a < 2; ++a)
#pragma unroll
            for (int b = 0; b < 2; ++b)
#pragma unroll
                for (int m = 0; m < 4; ++m)
#pragma unroll
                    for (int n = 0; n < 2; ++n) acc[a][b][m][n] = (f32x4){0.f, 0.f, 0.f, 0.f};
        }
        cur = nxt; cA = nA; cB = nB; ++ui;
        if constexpr (ALIGN_EPI) { if (wr == 1) PG8_BAR; }
    }
    PG8_WAIT_V(0);
    if constexpr (!ALIGN_EPI) { if (wr == 0) PG8_BAR; }
    PG8_BAR;
#undef PG8_SA
#undef PG8_SB
#undef PG8_STAGE
#undef PG8_LDA
#undef PG8_LDB
#undef PG8_MMA
#undef PG8_WAIT_V
#undef PG8_WAIT_L
#undef PG8_BAR
#undef PG8_SCHED
}
template <class Epi, class Sched, bool ALIGN_EPI = false, bool SP2 = false>
__device__ __forceinline__ void gemm_phase(PG8_LAS unsigned char* lds, const Gemm g, const Sched& S, const Epi& E) { f32x4 acc[2][2][4][2]; gemm_phase_acc<Epi, Sched, ALIGN_EPI, SP2, true>(lds, g, S, E, acc); }
}

constexpr int D = 2048, M = 9216, MP = 8192, DEPTH = 4, NWAVES = 8;
constexpr int INW = 18448, NPAD = 18496, PW = pg8::PW;
constexpr int C_GA = 0, C_GB = 2048, C_CB = 4096, C_CC = 6144, C_CX = 8192, C_CG = 10240, C_Q = 12288, C_K = 13312, C_V = 14336, C_GG = 16384;
constexpr float EPS = 1e-6f;
constexpr size_t O_Y = 0, O_CONVP = 18874368, O_GLAP = 18939904, O_CONVS = 27328512, O_GLAS = 29425664, O_END = 297861120;
constexpr size_t MiB = 1u << 20;
constexpr size_t WS_CTL = 0, CTL_ZERO_BYTES = 2 * MiB;
constexpr size_t WS_WIN = 2 * MiB, WIN_L = (size_t)NPAD * D * 2;
constexpr size_t WS_WA = 296 * MiB, WS_WB = 328 * MiB, WS_WO = 360 * MiB, W_L = (size_t)D * D * 2;
constexpr size_t WS_XF = 392 * MiB, WS_XB = 464 * MiB, WS_P = 500 * MiB, WS_ZA = 824 * MiB, WS_ZB = 860 * MiB, WS_MG = 896 * MiB;
constexpr size_t WS_O = 932 * MiB, WS_T = 1004 * MiB, WS_LR = 1076 * MiB, WS_RSTD = 1077 * MiB, WS_END = 1078 * MiB;
static_assert(WS_WIN + 4 * WIN_L <= WS_WA, "ws map");
constexpr int CW_BAR = 4096;
constexpr size_t WS_RSO = 524288;
constexpr size_t WS_RSQ = 65536;
constexpr int RING_OFF = 0, RING_BYTES = 131072, ROWSUM_OFF = 147456, LDSCTL_OFF = 149504, MISC_OFF = LDSCTL_OFF + 320, RT_OFF = 150528, LDS_BYTES = 158720;

#define GAS __attribute__((address_space(1)))
#define LAS __attribute__((address_space(3)))
typedef unsigned short bf16;
typedef unsigned v4u __attribute__((ext_vector_type(4)));
typedef unsigned v2u __attribute__((ext_vector_type(2)));
typedef float f32x4 __attribute__((ext_vector_type(4)));
typedef GAS unsigned gu32;
#define RLX_AGENT __ATOMIC_RELAXED, __HIP_MEMORY_SCOPE_AGENT
#define LDS_WAIT() asm volatile("s_waitcnt lgkmcnt(0)" ::: "memory")
#define VM_WAIT() asm volatile("s_waitcnt vmcnt(0)" ::: "memory")
__device__ __forceinline__ unsigned f2bf(float f) { unsigned u = __builtin_bit_cast(unsigned, f); return (u + 0x7fffu + ((u >> 16) & 1u)) >> 16; }
__device__ __forceinline__ unsigned pk2(float lo, float hi) { return f2bf(lo) | (f2bf(hi) << 16); }
__device__ __forceinline__ float bflo(unsigned w) { return __uint_as_float(w << 16); }
__device__ __forceinline__ float bfhi(unsigned w) { return __uint_as_float(w & 0xffff0000u); }
__device__ __forceinline__ float bf1(bf16 b) { return __uint_as_float(((unsigned)b) << 16); }

typedef short bf16x8 __attribute__((ext_vector_type(8)));
typedef float f32x2 __attribute__((ext_vector_type(2)));
typedef __bf16 bf16x2_t __attribute__((ext_vector_type(2)));
__device__ __forceinline__ unsigned pkbf(float a, float b) { f32x2 v = {a, b}; bf16x2_t r = __builtin_convertvector(v, bf16x2_t); return __builtin_bit_cast(unsigned, r); }
#define XB_TMO      128
#define XB_XCNT(j)  (256  + 64 * (j))
#define XB_XSUB(j)  (1280 + 64 * (j))
#define XB_XGEN(j)  (2304 + 64 * (j))
#define XB_TOP      3328
#define XB_TOPGEN   3392
#define XCD_BAR_WORDS 3456
#define XB_SPIN_CAP (1u << 18)
__device__ __forceinline__ unsigned xb_ld(unsigned* p)              { return __hip_atomic_load(p, __ATOMIC_RELAXED, __HIP_MEMORY_SCOPE_AGENT); }
__device__ __forceinline__ unsigned xb_add(unsigned* p, unsigned v) { return __hip_atomic_fetch_add(p, v, __ATOMIC_RELAXED, __HIP_MEMORY_SCOPE_AGENT); }
__device__ __forceinline__ unsigned xb_xcc_id() { return (unsigned)__builtin_amdgcn_s_getreg((3 << 11) | 20) & 0xFu; }
#define XB_SPIN(cond, bar) do { unsigned _sp = 0; while (cond) { __builtin_amdgcn_s_sleep(1); \
    if ((++_sp & 255u) == 0u) { if (xb_ld(&(bar)[XB_TMO])) break; if (_sp > XB_SPIN_CAP) { atomicAdd(&(bar)[XB_TMO], 1u); break; } } } } while (0)
struct XcdBarrier { unsigned* bar; unsigned x; volatile LAS unsigned* st; };
__device__ __forceinline__ XcdBarrier xcd_barrier_post(unsigned* bar, volatile LAS unsigned* st) {
    XcdBarrier b; b.bar = bar; b.x = xb_xcc_id(); b.st = st;
    if (threadIdx.x == 0) (void)xb_add(&bar[XB_XCNT(b.x)], 1u);
    return b;
}
__device__ __forceinline__ void xcd_barrier_complete(unsigned* bar, unsigned x, unsigned& nloc, unsigned& nx) {
    const unsigned G = gridDim.x * gridDim.y * gridDim.z;
    unsigned sum, cnt, mine, sp = 0u;
    for (;;) {
        sum = 0u; cnt = 0u; mine = 0u;
#pragma unroll
        for (unsigned j = 0; j < 16; ++j) { const unsigned c = xb_ld(&bar[XB_XCNT(j)]); sum += c; cnt += (c > 0u) ? 1u : 0u; mine = (j == x) ? c : mine; }
        if (sum == G) break;
        __builtin_amdgcn_s_sleep(1);
        if ((++sp & 255u) == 0u) { if (xb_ld(&bar[XB_TMO])) break; if (sp > XB_SPIN_CAP) { atomicAdd(&bar[XB_TMO], 1u); break; } }
    }
    nloc = mine > 0u ? mine : 1u; nx = cnt > 0u ? cnt : 1u;
}
__device__ __forceinline__ void xcd_barrier(const XcdBarrier& b) {
    asm volatile("s_waitcnt vmcnt(0)" ::: "memory");
    __syncthreads();
    if (threadIdx.x == 0) {
        unsigned* bar = b.bar;
        __builtin_amdgcn_s_waitcnt(0);
        unsigned nloc = b.st[0], nx = b.st[1];
        if (nloc == 0u) { xcd_barrier_complete(bar, b.x, nloc, nx); b.st[0] = nloc; b.st[1] = nx; }
        const unsigned old = xb_add(&bar[XB_XSUB(b.x)], 1u);
        const unsigned gen = old / nloc;
        if (old + 1u == (gen + 1u) * nloc) {
            __builtin_amdgcn_fence(__ATOMIC_RELEASE, "agent");
            asm volatile("s_waitcnt vmcnt(0)" ::: "memory");
            const unsigned og = xb_add(&bar[XB_TOP], 1u);
            const unsigned tg = og / nx;
            if (og + 1u == (tg + 1u) * nx) xb_add(&bar[XB_TOPGEN], 1u);
            else XB_SPIN(xb_ld(&bar[XB_TOPGEN]) == tg, bar);
            __builtin_amdgcn_fence(__ATOMIC_ACQUIRE, "agent");
            xb_add(&bar[XB_XGEN(b.x)], 1u);
            asm volatile("s_waitcnt vmcnt(0)" ::: "memory");
        } else {
            XB_SPIN(xb_ld(&bar[XB_XGEN(b.x)]) == gen, bar);
            __builtin_amdgcn_fence(__ATOMIC_ACQUIRE, "agent");
            asm volatile("s_waitcnt vmcnt(0)" ::: "memory");
        }
    }
    __syncthreads();
}

struct Frame {
    LAS unsigned char* lds;
    int tid, lane, wave, vcu, G;
};
__device__ __forceinline__ const float* inp(int k) { asm volatile("" : "+s"(k)); const unsigned long long* ka = (const unsigned long long*)__builtin_amdgcn_kernarg_segment_ptr(); return (const float*)(const GAS float*)ka[k]; }
__device__ __forceinline__ unsigned char* wsp() { return (unsigned char*)inp(15); }
__device__ __forceinline__ float* outp() { return (float*)inp(14); }
enum { I_XP = 0, I_XS, I_SCONV, I_SGLA, I_NORMG, I_WIN, I_CONVW, I_WA2, I_BA, I_GNORMG, I_WBA, I_WBB, I_WO, I_FING };
__device__ __forceinline__ float wave_sum(float v) {
#pragma unroll
    for (int o = 1; o < 64; o <<= 1) v += __shfl_xor(v, o);
    return v;
}
__device__ __forceinline__ void tr_item(const float* W, int ldw, int nvalid, int K, bf16* WT, int nblk, const float* s, int smask, int item, int lane, bool perm) {
    const int kb = item / nblk, nb = item % nblk, k0 = 64 * kb, n = 64 * nb + lane;
    int nd = n;
    if (perm && n >= 4096 && n < 12288) { const int sct = (n - 4096) >> 11, ch = (n - 4096) & 2047, c64 = ch & 63; nd = 4096 + (ch >> 6) * 256 + 128 * (sct >> 1) + 32 * (c64 >> 4) + 8 * ((c64 >> 2) & 3) + 4 * (sct & 1) + (c64 & 3); }
    float v[64];
    if (n < nvalid) { const float* p = W + (size_t)k0 * ldw + n;
#pragma unroll
        for (int i = 0; i < 64; ++i) v[i] = p[(size_t)i * ldw]; }
    else {
#pragma unroll
        for (int i = 0; i < 64; ++i) v[i] = 0.f; }
    if (s) {
#pragma unroll
        for (int i = 0; i < 64; ++i) v[i] *= s[(k0 + i) & smask]; }
    GAS v4u* d = (GAS v4u*)(WT + (size_t)nd * K + k0);
#pragma unroll
    for (int c = 0; c < 8; ++c) { v4u o; o.x = pkbf(v[8 * c], v[8 * c + 1]); o.y = pkbf(v[8 * c + 2], v[8 * c + 3]); o.z = pkbf(v[8 * c + 4], v[8 * c + 5]); o.w = pkbf(v[8 * c + 6], v[8 * c + 7]); d[c] = o; }
}
__device__ __forceinline__ void p_prologue(Frame& F0) {
    Frame F = F0; asm volatile("" : "+v"(F.tid), "+v"(F.lane));
    const int gw = F.vcu * NWAVES + F.wave, NGW = F.G * NWAVES;
    constexpr int I_IN = (D / 64) * (NPAD / 64), I_SQ = (D / 64) * (D / 64), I_L = I_IN + 3 * I_SQ;
    for (int it = gw; it < DEPTH * I_L; it += NGW) {
        const int l = it / I_L; int r = it % I_L;
        if (r < I_IN) { tr_item(inp(I_WIN) + (size_t)l * D * INW, INW, INW, D, (bf16*)(wsp() + WS_WIN + l * WIN_L), NPAD / 64, inp(I_NORMG) + l * D, 0xffff, r, F.lane, true); continue; } r -= I_IN;
        if (r < I_SQ) { tr_item(inp(I_WBA) + (size_t)l * D * D, D, D, D, (bf16*)(wsp() + WS_WA + l * W_L), D / 64, nullptr, 0, r, F.lane, false); continue; } r -= I_SQ;
        if (r < I_SQ) { tr_item(inp(I_WBB) + (size_t)l * D * D, D, D, D, (bf16*)(wsp() + WS_WB + l * W_L), D / 64, inp(I_GNORMG) + l * 512, 511, r, F.lane, false); continue; } r -= I_SQ;
        tr_item(inp(I_WO) + (size_t)l * D * D, D, D, D, (bf16*)(wsp() + WS_WO + l * W_L), D / 64, nullptr, 0, r, F.lane, false);
    }
}
__device__ __forceinline__ void p_xprep(Frame& F0, int l) {
    Frame F = F0; asm volatile("" : "+v"(F.tid), "+v"(F.lane));
    const int gw = F.vcu * NWAVES + F.wave, NGW = F.G * NWAVES;
    bf16* XB = (bf16*)(wsp() + WS_XB); unsigned long long* RS = (unsigned long long*)(wsp() + WS_RSQ);
    for (int r = gw; r < M; r += NGW) {
        const float* src = r < MP ? inp(I_XP) + (size_t)r * D : inp(I_XS) + (size_t)(r - MP) * D;
        const GAS f32x4* s4 = (const GAS f32x4*)src + F.lane;
        f32x4 v[8]; float ss = 0.f;
#pragma unroll
        for (int j = 0; j < 8; ++j) { v[j] = s4[64 * j]; ss += (v[j].x * v[j].x + v[j].y * v[j].y) + (v[j].z * v[j].z + v[j].w * v[j].w); }
        const float tot = wave_sum(ss);
        if (F.lane == 0) RS[r] = (unsigned long long)(tot * 16777216.0f);
        GAS unsigned long long* o8 = (GAS unsigned long long*)(XB + (size_t)r * D) + F.lane;
#pragma unroll
        for (int j = 0; j < 8; ++j) o8[64 * j] = (unsigned long long)pk2(v[j].x, v[j].y) | ((unsigned long long)pk2(v[j].z, v[j].w) << 32);
    }
}
__device__ __forceinline__ void p_final(Frame& F0) {
    Frame F = F0; asm volatile("" : "+v"(F.tid), "+v"(F.lane));
    const int gw = F.vcu * NWAVES + F.wave, NGW = F.G * NWAVES;
    const bf16* XB = (const bf16*)(wsp() + WS_XB);
    for (int r = gw; r < M; r += NGW) {
        const GAS v2u* s2 = (const GAS v2u*)(XB + (size_t)r * D) + F.lane; const GAS f32x4* g4 = (const GAS f32x4*)inp(I_FING) + F.lane;
        f32x4 v[8];
#pragma unroll
        for (int j = 0; j < 8; ++j) { const v2u w = s2[64 * j]; v[j] = (f32x4){bflo(w.x), bfhi(w.x), bflo(w.y), bfhi(w.y)}; }
        const float rstd = 1.f / sqrtf((float)((const unsigned long long*)(wsp() + WS_RSQ))[DEPTH * M + r] * (1.0f / 16777216.0f) * (1.f / D) + EPS);
        GAS f32x4* d4 = (GAS f32x4*)(outp() + O_Y + (size_t)r * D) + F.lane;
#pragma unroll
        for (int j = 0; j < 8; ++j) d4[64 * j] = v[j] * rstd * g4[64 * j];
    }
}
__device__ __forceinline__ unsigned short bf1r(float a) { return (unsigned short)(pkbf(a, 0.f) & 0xffffu); }
__device__ __forceinline__ float logsig16(float a) { return (fminf(a, 0.f) - 0.69314718f * __builtin_amdgcn_logf(1.0f + __builtin_amdgcn_exp2f(-1.44269504f * fabsf(a)))) * 0.0625f; }
__device__ __forceinline__ float fexp(float x) { return __builtin_amdgcn_exp2f(1.44269504f * x); }
__device__ __forceinline__ int qt_off(int t, int p) { return t * 512 + (((p & 16) | ((p ^ t) & 15)) << 4); }
__device__ __forceinline__ int r8_off(int r, int p) { return r * 128 + ((p ^ ((r >> 1) & 7)) << 4); }
__device__ __forceinline__ int qt_pos(int k) { const int k32 = k & 31; return (k & ~31) + 8 * ((k32 & 15) >> 2) + 4 * (k32 >> 4) + (k32 & 3); }
constexpr size_t WS_QT = 1078 * MiB, WS_KD = 1094 * MiB, WS_AI = 1110 * MiB, WS_GM = 1114 * MiB, WS_VT = 1115 * MiB, WS_END2 = 1147 * MiB;
constexpr int QT_B = 32768, KD_B = 32768, AI_B = 8192, GM_B = 1024, VT_B = 65536, SCAN_BUF = QT_B + KD_B + AI_B + GM_B;

__device__ __forceinline__ void p_gla_prep(Frame& F0, int l) {
    Frame F = F0; asm volatile("" : "+v"(F.tid), "+v"(F.lane));
    const bf16* P = (const bf16*)(wsp() + WS_P); const float* LR = (const float*)(wsp() + WS_LR);
    LAS unsigned char* Qs = F.lds; LAS unsigned char* Ks = F.lds + 32768; LAS unsigned char* VTs = F.lds;
    LAS unsigned char* Qraw = F.lds + 65536; LAS unsigned char* Kraw = F.lds + 98304;
    LAS float* LRs = (LAS float*)(F.lds + 131072); LAS float* TOT = (LAS float*)(F.lds + 135168);
    const int k = F.tid & 255, half = F.tid >> 8;
    for (int item = F.vcu; item < 512; item += F.G) {
        const int b = item >> 7, c = (item >> 2) & 31, h = item & 3, r0 = b * 2048 + c * 64;
        v4u va[4], vb[4], qv[4], kv[4]; f32x4 lrv = {0.f, 0.f, 0.f, 0.f};
#pragma unroll
        for (int i = 0; i < 4; ++i) { const int id = i * 512 + F.tid, tp = id & 31, pc = id >> 5;
            va[i] = *(const GAS v4u*)(P + (size_t)(r0 + 2 * tp) * PW + C_V + h * 512 + 8 * pc); vb[i] = *(const GAS v4u*)(P + (size_t)(r0 + 2 * tp + 1) * PW + C_V + h * 512 + 8 * pc);
            const int t = id >> 5, p = id & 31;
            qv[i] = *(const GAS v4u*)(P + (size_t)(r0 + t) * PW + C_Q + h * 256 + 8 * p); kv[i] = *(const GAS v4u*)(P + (size_t)(r0 + t) * PW + C_K + h * 256 + 8 * p); }
        if (F.tid < 256) lrv = *(const GAS f32x4*)(LR + (size_t)r0 * 16 + 4 * F.tid);
        float w2[16]; const float bias = inp(I_BA)[l * 1024 + h * 256 + k];
        { const float* w2p = inp(I_WA2) + (size_t)l * 16 * 1024 + h * 256 + k;
#pragma unroll
          for (int j = 0; j < 16; ++j) w2[j] = w2p[j * 1024]; }
#pragma unroll
        for (int i = 0; i < 4; ++i) { const int id = i * 512 + F.tid, tp = id & 31, pc = id >> 5; const v4u a = va[i], bb = vb[i];
            LAS unsigned* d = (LAS unsigned*)(VTs + (8 * pc) * 128 + 4 * tp);
            d[0 * 32] = (a.x & 0xffffu) | (bb.x << 16); d[1 * 32] = (a.x >> 16) | (bb.x & 0xffff0000u); d[2 * 32] = (a.y & 0xffffu) | (bb.y << 16); d[3 * 32] = (a.y >> 16) | (bb.y & 0xffff0000u);
            d[4 * 32] = (a.z & 0xffffu) | (bb.z << 16); d[5 * 32] = (a.z >> 16) | (bb.z & 0xffff0000u); d[6 * 32] = (a.w & 0xffffu) | (bb.w << 16); d[7 * 32] = (a.w >> 16) | (bb.w & 0xffff0000u);
            *(LAS v4u*)(Qraw + id * 16) = qv[i]; *(LAS v4u*)(Kraw + id * 16) = kv[i]; }
        if (F.tid < 256) *(LAS f32x4*)(LRs + 4 * F.tid) = lrv;
        __syncthreads();
        { GAS v4u* dst = (GAS v4u*)(wsp() + WS_VT + (size_t)item * VT_B);
#pragma unroll
          for (int i = 0; i < 8; ++i) dst[i * 512 + F.tid] = *(const LAS v4u*)(VTs + (i * 512 + F.tid) * 16); }
        float bc[32]; float run = 0.f;
#pragma unroll
        for (int i = 0; i < 32; ++i) { const LAS f32x4* lr4 = (const LAS f32x4*)(LRs + (half * 32 + i) * 16); float a = bias;
#pragma unroll
            for (int j4 = 0; j4 < 4; ++j4) { const f32x4 x = lr4[j4]; a += x[0] * w2[4 * j4] + x[1] * w2[4 * j4 + 1] + x[2] * w2[4 * j4 + 2] + x[3] * w2[4 * j4 + 3]; }
            run += logsig16(a); bc[i] = run; }
        TOT[half * 256 + k] = run;
        __syncthreads();
        const float lo_tot = TOT[k], blast = lo_tot + TOT[256 + k], boff = half ? lo_tot : 0.f;
        if (half == 0) ((float*)(wsp() + WS_GM))[(size_t)item * 256 + k] = fexp(blast);
        const int pos = qt_pos(k), pp = pos >> 3, pe = (pos & 7) * 2;
        unsigned char* kdg = wsp() + WS_KD + (size_t)item * KD_B;
#pragma unroll
        for (int g = 0; g < 4; ++g) { unsigned kdw[4];
#pragma unroll
            for (int e = 0; e < 8; ++e) { const int i = g * 8 + e, t = half * 32 + i; const float bt = bc[i] + boff;
                const float qf = bf1(*(const LAS unsigned short*)(Qraw + t * 512 + k * 2)) * 0.0625f * fexp(bt), kf = bf1(*(const LAS unsigned short*)(Kraw + t * 512 + k * 2));
                const float kh = kf * fexp(-bt), kd = kf * fexp(blast - bt);
                *(LAS unsigned short*)(Qs + qt_off(t, pp) + pe) = bf1r(qf); *(LAS unsigned short*)(Ks + qt_off(t, pp) + pe) = bf1r(kh);
                if (e & 1) kdw[e >> 1] = (kdw[e >> 1] & 0xffffu) | ((unsigned)bf1r(kd) << 16); else kdw[e >> 1] = bf1r(kd); }
            v4u w; w.x = kdw[0]; w.y = kdw[1]; w.z = kdw[2]; w.w = kdw[3];
            *(GAS v4u*)(kdg + r8_off(k, half * 4 + g)) = w; }
        __syncthreads();
        { GAS v4u* dq = (GAS v4u*)(wsp() + WS_QT + (size_t)item * QT_B);
#pragma unroll
          for (int i = 0; i < 4; ++i) dq[i * 512 + F.tid] = *(const LAS v4u*)(Qs + (i * 512 + F.tid) * 16); }
        { const int r16 = F.lane & 15, quad = F.lane >> 4;
#pragma unroll
          for (int u = 0; u < 2; ++u) { const int id = F.wave * 2 + u, si = id >> 2, ti = id & 3;
              f32x4 acc = {0.f, 0.f, 0.f, 0.f};
              if (ti >= si) {
#pragma unroll
                  for (int ks = 0; ks < 8; ++ks) { const bf16x8 ka = *(const LAS bf16x8*)(Ks + qt_off(16 * si + r16, 4 * ks + quad)), qb = *(const LAS bf16x8*)(Qs + qt_off(16 * ti + r16, 4 * ks + quad));
                      acc = __builtin_amdgcn_mfma_f32_16x16x32_bf16(ka, qb, acc, 0, 0, 0); } }
              const int t = 16 * ti + r16, s0 = 16 * si + 4 * quad;
              v2u w; w.x = pkbf(s0 + 0 <= t ? acc[0] : 0.f, s0 + 1 <= t ? acc[1] : 0.f); w.y = pkbf(s0 + 2 <= t ? acc[2] : 0.f, s0 + 3 <= t ? acc[3] : 0.f);
              *(GAS v2u*)(wsp() + WS_AI + (size_t)item * AI_B + r8_off(t, 2 * si + (quad >> 1)) + (quad & 1) * 8) = w; } }
        __syncthreads();
    }
}
__device__ __forceinline__ void scan_stage(unsigned char* ws, LAS unsigned char* lds, int item, int c, int lw, int lane) {
    LAS unsigned char* buf = lds + (c & 1) * SCAN_BUF;
    const unsigned char* gq = ws + WS_QT + (size_t)item * QT_B; const unsigned char* gk = ws + WS_KD + (size_t)item * KD_B;
    const unsigned char* ga = ws + WS_AI + (size_t)item * AI_B; const unsigned char* gg = ws + WS_GM + (size_t)item * GM_B;
#pragma unroll
    for (int i = 0; i < 8; ++i) { const int wp = lw + 4 * i;
        __builtin_amdgcn_global_load_lds((const unsigned*)(gq + wp * 1024 + lane * 16), (LAS unsigned*)(buf + wp * 1024), 16, 0, 0);
        __builtin_amdgcn_global_load_lds((const unsigned*)(gk + wp * 1024 + lane * 16), (LAS unsigned*)(buf + QT_B + wp * 1024), 16, 0, 0); }
#pragma unroll
    for (int i = 0; i < 2; ++i) { const int wp = lw + 4 * i;
        __builtin_amdgcn_global_load_lds((const unsigned*)(ga + wp * 1024 + lane * 16), (LAS unsigned*)(buf + QT_B + KD_B + wp * 1024), 16, 0, 0); }
    if (lw == 0) __builtin_amdgcn_global_load_lds((const unsigned*)(gg + lane * 16), (LAS unsigned*)(buf + QT_B + KD_B + AI_B), 16, 0, 0);
}
__device__ __forceinline__ void p_gla_scan(Frame& F0, int l) {
    Frame F = F0; asm volatile("" : "+v"(F.tid), "+v"(F.lane));
    if (F.vcu >= 128) return;
    const int b = F.vcu >> 5, h = (F.vcu >> 3) & 3, vq = F.vcu & 7;
    bf16* ZBp = (bf16*)(wsp() + WS_ZB); const bf16* Pp = (const bf16*)(wsp() + WS_P); unsigned long long* RSO = (unsigned long long*)(wsp() + WS_RSO) + (size_t)l * M * 4;
    const int r16 = F.lane & 15, quad = F.lane >> 4, w = F.wave;
    const int vcol0 = vq * 64 + (w & 3) * 16;
    f32x4 S[16];
#pragma unroll
    for (int i = 0; i < 16; ++i) S[i] = (f32x4){0.f, 0.f, 0.f, 0.f};
    if (w >= 4) {
        scan_stage(wsp(), F.lds, (b * 32 + 0) * 4 + h, 0, w - 4, F.lane);
#pragma unroll 1
        for (int c = 0; c < 32; ++c) {
            asm volatile("s_waitcnt vmcnt(0)" ::: "memory");
            asm volatile("" ::: "memory"); __builtin_amdgcn_s_barrier(); asm volatile("" ::: "memory");
            if (c + 1 < 32) scan_stage(wsp(), F.lds, (b * 32 + c + 1) * 4 + h, c + 1, w - 4, F.lane);
        }
        asm volatile("s_waitcnt vmcnt(0)" ::: "memory");
        __syncthreads();
        return;
    }
    bf16x8 vf[2], vn[2];
    { const unsigned char* gv = wsp() + WS_VT + (size_t)((b * 32 + 0) * 4 + h) * VT_B + (vcol0 + r16) * 128 + quad * 16; vf[0] = *(const GAS bf16x8*)gv; vf[1] = *(const GAS bf16x8*)(gv + 64); }
    v4u gq[2], gqn[2];
    { const int r0 = b * 2048;
#pragma unroll
      for (int m = 0; m < 2; ++m) gq[m] = *(const GAS v4u*)(Pp + (size_t)(r0 + 16 * (2 * m + (quad & 1)) + r16) * PW + C_GG + h * 512 + vcol0 + 4 * (quad & 2)); }
    __builtin_amdgcn_s_setprio(3);
    auto chunk = [&](const int c, bf16x8 (&vcur)[2], bf16x8 (&vnxt)[2], v4u (&gcur)[2], v4u (&gnxt)[2]) __attribute__((always_inline)) {
        asm volatile("" ::: "memory"); __builtin_amdgcn_s_barrier(); asm volatile("" ::: "memory");
        const LAS unsigned char* buf = F.lds + (c & 1) * SCAN_BUF;
        const LAS unsigned char* Qb = buf; const LAS unsigned char* Kb = buf + QT_B; const LAS unsigned char* Ab = buf + QT_B + KD_B; const LAS unsigned char* Gb = buf + QT_B + KD_B + AI_B;
        f32x4 acc[4];
#pragma unroll
        for (int ti = 0; ti < 4; ++ti) acc[ti] = (f32x4){0.f, 0.f, 0.f, 0.f};
        bf16x8 rb[3][4];
#define SCAN_LDG(g, d) { _Pragma("unroll") for (int ti = 0; ti < 4; ++ti) d[ti] = (g) < 8 ? *(const LAS bf16x8*)(Qb + qt_off(16 * ti + r16, 4 * (g) + quad)) : *(const LAS bf16x8*)(Ab + r8_off(16 * ti + r16, 4 * ((g) - 8) + quad)); }
        SCAN_LDG(0, rb[0]) SCAN_LDG(1, rb[1])
#pragma unroll
        for (int g = 0; g < 10; ++g) {
            if (g + 2 < 10) SCAN_LDG(g + 2, rb[(g + 2) % 3])
            bf16x8 sa;
            if (g < 8) { v4u sp; sp.x = pkbf(S[2 * g][0], S[2 * g][1]); sp.y = pkbf(S[2 * g][2], S[2 * g][3]); sp.z = pkbf(S[2 * g + 1][0], S[2 * g + 1][1]); sp.w = pkbf(S[2 * g + 1][2], S[2 * g + 1][3]); sa = __builtin_bit_cast(bf16x8, sp); }
            else sa = vcur[g - 8];
            __builtin_amdgcn_sched_barrier(0);
#pragma unroll
            for (int ti = 0; ti < 4; ++ti) acc[ti] = __builtin_amdgcn_mfma_f32_16x16x32_bf16(sa, rb[g % 3][ti], acc[ti], 0, 0, 0);
            __builtin_amdgcn_sched_barrier(0);
        }
#undef SCAN_LDG
        { const int cn = c + 1 < 32 ? c + 1 : c, r0 = b * 2048 + cn * 64;
#pragma unroll
          for (int m = 0; m < 2; ++m) gnxt[m] = *(const GAS v4u*)(Pp + (size_t)(r0 + 16 * (2 * m + (quad & 1)) + r16) * PW + C_GG + h * 512 + vcol0 + 4 * (quad & 2));
          const unsigned char* gv = wsp() + WS_VT + (size_t)((b * 32 + cn) * 4 + h) * VT_B + (vcol0 + r16) * 128 + quad * 16; vnxt[0] = *(const GAS bf16x8*)gv; vnxt[1] = *(const GAS bf16x8*)(gv + 64); }
        f32x4 gb[2][2]; bf16x8 kb[2][2][2];
#define SCAN_LD3(p, s) { _Pragma("unroll") for (int e = 0; e < 2; ++e) { gb[s][e] = *(const LAS f32x4*)(Gb + (16 * (2 * (p) + e) + 4 * quad) * 4); \
            _Pragma("unroll") for (int ks = 0; ks < 2; ++ks) kb[s][e][ks] = *(const LAS bf16x8*)(Kb + r8_off(16 * (2 * (p) + e) + r16, 4 * ks + quad)); } }
        SCAN_LD3(0, 0)
        __builtin_amdgcn_sched_barrier(0);
        { const int r0 = b * 2048 + c * 64;
          const bool odd = quad & 1; float ss[4]; v2u wv[4];
#pragma unroll
          for (int m = 0; m < 2; ++m) { const v4u ld = gcur[m]; v2u own, snd, rcv;
              own.x = odd ? ld.z : ld.x; own.y = odd ? ld.w : ld.y; snd.x = odd ? ld.x : ld.z; snd.y = odd ? ld.y : ld.w;
              rcv.x = (unsigned)__shfl_xor((int)snd.x, 16); rcv.y = (unsigned)__shfl_xor((int)snd.y, 16);
              const v2u ga = odd ? rcv : own, gb2 = odd ? own : rcv;
              { const f32x4 a = acc[2 * m];     wv[2 * m].x     = pkbf(a[0] * bflo(ga.x),  a[1] * bfhi(ga.x));  wv[2 * m].y     = pkbf(a[2] * bflo(ga.y),  a[3] * bfhi(ga.y));  ss[2 * m]     = (a[0] * a[0] + a[1] * a[1]) + (a[2] * a[2] + a[3] * a[3]); }
              { const f32x4 a = acc[2 * m + 1]; wv[2 * m + 1].x = pkbf(a[0] * bflo(gb2.x), a[1] * bfhi(gb2.x)); wv[2 * m + 1].y = pkbf(a[2] * bflo(gb2.y), a[3] * bfhi(gb2.y)); ss[2 * m + 1] = (a[0] * a[0] + a[1] * a[1]) + (a[2] * a[2] + a[3] * a[3]); } }
#pragma unroll
          for (int m = 0; m < 2; ++m) { const v2u mine = odd ? wv[2 * m + 1] : wv[2 * m], snd = odd ? wv[2 * m] : wv[2 * m + 1]; v2u rcv;
              rcv.x = (unsigned)__shfl_xor((int)snd.x, 16); rcv.y = (unsigned)__shfl_xor((int)snd.y, 16);
              v4u o4; o4.x = odd ? rcv.x : mine.x; o4.y = odd ? rcv.y : mine.y; o4.z = odd ? mine.x : rcv.x; o4.w = odd ? mine.y : rcv.y;
              *(GAS v4u*)(ZBp + (size_t)(r0 + 16 * (2 * m + (quad & 1)) + r16) * D + h * 512 + vcol0 + 4 * (quad & 2)) = o4; }
#pragma unroll
          for (int ti = 0; ti < 4; ++ti) ss[ti] += __shfl_xor(ss[ti], 16);
#pragma unroll
          for (int ti = 0; ti < 4; ++ti) ss[ti] += __shfl_xor(ss[ti], 32);
          { const float sq = quad == 0 ? ss[0] : quad == 1 ? ss[1] : quad == 2 ? ss[2] : ss[3];
            atomicAdd(RSO + (size_t)h * M + r0 + 16 * quad + r16, (unsigned long long)(sq * 16777216.0f)); } }
        __builtin_amdgcn_sched_barrier(0);
#pragma unroll
        for (int p = 0; p < 8; ++p) {
            if (p + 1 < 8) SCAN_LD3(p + 1, (p + 1) & 1)
            __builtin_amdgcn_sched_barrier(0);
            S[2 * p] = S[2 * p] * gb[p & 1][0]; S[2 * p + 1] = S[2 * p + 1] * gb[p & 1][1];
#pragma unroll
            for (int ks = 0; ks < 2; ++ks)
#pragma unroll
                for (int e = 0; e < 2; ++e) S[2 * p + e] = __builtin_amdgcn_mfma_f32_16x16x32_bf16(kb[p & 1][e][ks], vcur[ks], S[2 * p + e], 0, 0, 0);
            __builtin_amdgcn_sched_barrier(0);
        }
#undef SCAN_LD3
    };
#pragma unroll 1
    for (int c2 = 0; c2 < 32; c2 += 2) { chunk(c2, vf, vn, gq, gqn); chunk(c2 + 1, vn, vf, gqn, gq); }
    __builtin_amdgcn_s_setprio(0);
    { float* dst = outp() + O_GLAP + ((size_t)((l * 4 + b) * 4 + h) * 256) * 512 + vcol0 + r16;
#pragma unroll
        for (int i = 0; i < 16; ++i)
#pragma unroll
            for (int j = 0; j < 4; ++j) dst[(size_t)(16 * i + 4 * quad + j) * 512] = S[i][j]; }
    __syncthreads();
}
constexpr int CW_Q0 = 8192;
__device__ __forceinline__ void p_gla_sample(Frame& F0, int l, int rep) {
    Frame F = F0; asm volatile("" : "+v"(F.tid), "+v"(F.lane));
    const bf16* P = (const bf16*)(wsp() + WS_P); const float* LR = (const float*)(wsp() + WS_LR);
    LAS float* QK = (LAS float*)F.lds;
    LAS float* QH = (LAS float*)(F.lds + 20480);
    LAS float* KH = (LAS float*)(F.lds + 28672);
    LAS float* VS = (LAS float*)(F.lds + 36864);
    LAS float* AS = (LAS float*)(F.lds + 53248);
    LAS float* LRs = (LAS float*)(F.lds + 53504);
    LAS float* TOT = (LAS float*)(F.lds + 54016);
    LAS int* QW = (LAS int*)(F.lds + 56064);
    LAS float* OR = (LAS float*)(F.lds + 57344);
    unsigned* qhead = (unsigned*)(wsp() + WS_CTL) + CW_Q0 + 64 * (l + 4 * rep);
    const int k = F.tid & 255, half = F.tid >> 8;
    for (;;) {
        if (F.tid == 0) QW[0] = (int)__hip_atomic_fetch_add(qhead, 1u, __ATOMIC_RELAXED, __HIP_MEMORY_SCOPE_AGENT);
        __syncthreads();
        const int unit = QW[0];
        if (unit >= 1024) break;
        const int sb = unit >> 3, h = (unit >> 1) & 3, vh = unit & 1, r0 = MP + sb * 8;
        f32x4 lrv = {0.f, 0.f, 0.f, 0.f}; if (F.tid < 32) lrv = *(const GAS f32x4*)(LR + (size_t)r0 * 16 + 4 * F.tid);
        bf16 vraw[4], qraw[4], kraw[4];
#pragma unroll
        for (int i = 0; i < 4; ++i) { const int e = i * 512 + F.tid; vraw[i] = P[(size_t)(r0 + (e >> 8)) * PW + C_V + h * 512 + vh * 256 + (e & 255)];
            qraw[i] = P[(size_t)(r0 + half * 4 + i) * PW + C_Q + h * 256 + k]; kraw[i] = P[(size_t)(r0 + half * 4 + i) * PW + C_K + h * 256 + k]; }
        float w2[16]; const float bias = inp(I_BA)[l * 1024 + h * 256 + k];
        { const float* w2p = inp(I_WA2) + (size_t)l * 16 * 1024 + h * 256 + k;
#pragma unroll
          for (int j = 0; j < 16; ++j) w2[j] = w2p[j * 1024]; }
        if (F.tid < 32) *(LAS f32x4*)(LRs + 4 * F.tid) = lrv;
#pragma unroll
        for (int i = 0; i < 4; ++i) VS[i * 512 + F.tid] = bf1(vraw[i]);
        __syncthreads();
        float bc[4]; float run = 0.f;
#pragma unroll
        for (int i = 0; i < 4; ++i) { const LAS f32x4* lr4 = (const LAS f32x4*)(LRs + (half * 4 + i) * 16); float a = bias;
#pragma unroll
            for (int j4 = 0; j4 < 4; ++j4) { const f32x4 x = lr4[j4]; a += x[0] * w2[4 * j4] + x[1] * w2[4 * j4 + 1] + x[2] * w2[4 * j4 + 2] + x[3] * w2[4 * j4 + 3]; }
            run += logsig16(a); bc[i] = run; }
        TOT[half * 256 + k] = run;
        __syncthreads();
        const float lo_tot = TOT[k], blast = lo_tot + TOT[256 + k], boff = half ? lo_tot : 0.f;
        if (half == 0) QK[k * 20 + 16] = fexp(blast);
#pragma unroll
        for (int i = 0; i < 4; ++i) { const int t = half * 4 + i; const float bt = bc[i] + boff;
            const float qv = bf1(qraw[i]) * 0.0625f * fexp(bt), kv = bf1(kraw[i]);
            QK[k * 20 + t] = qv; QK[k * 20 + 8 + t] = kv * fexp(blast - bt); QH[t * 256 + k] = qv; KH[t * 256 + k] = kv * fexp(-bt); }
        __syncthreads();
        { const int e = F.tid >> 3, part = F.tid & 7, t = e >> 3, sq = e & 7; float a = 0.f;
#pragma unroll
          for (int i = 0; i < 32; ++i) a += QH[t * 256 + part * 32 + i] * KH[sq * 256 + part * 32 + i];
          a += __shfl_xor(a, 1); a += __shfl_xor(a, 2); a += __shfl_xor(a, 4);
          if (part == 0) AS[e] = (sq <= t) ? a : 0.f; }
        const int vq4 = F.tid & 63, kr = F.tid >> 6;
        f32x4 vv[8], oa[8];
#pragma unroll
        for (int t = 0; t < 8; ++t) { vv[t] = *(const LAS f32x4*)(VS + t * 256 + 4 * vq4); oa[t] = (f32x4){0.f, 0.f, 0.f, 0.f}; }
        const float* s0p = inp(I_SGLA) + ((size_t)((l * 128 + sb) * 4 + h) * 256 + kr) * 512 + vh * 256 + 4 * vq4;
        float* s1p = outp() + O_GLAS + ((size_t)((l * 128 + sb) * 4 + h) * 256 + kr) * 512 + vh * 256 + 4 * vq4;
        f32x4 cur[8], nxt[8];
#pragma unroll
        for (int u = 0; u < 8; ++u) cur[u] = __builtin_nontemporal_load((const f32x4*)(s0p + (size_t)(8 * u) * 512));
        for (int g = 0; g < 4; ++g) {
            if (g < 3) {
#pragma unroll
                for (int u = 0; u < 8; ++u) nxt[u] = __builtin_nontemporal_load((const f32x4*)(s0p + (size_t)(8 * (8 * (g + 1) + u)) * 512)); }
#pragma unroll
            for (int u = 0; u < 8; ++u) { const int kk = 8 * (8 * g + u) + kr; const f32x4 s0 = cur[u];
                const LAS f32x4* q4 = (const LAS f32x4*)(QK + kk * 20); const f32x4 qa = q4[0], qb = q4[1], ka = q4[2], kb = q4[3]; const float gm = QK[kk * 20 + 16];
                f32x4 sn = s0 * gm;
#pragma unroll
                for (int t = 0; t < 4; ++t) { oa[t] += s0 * qa[t]; oa[4 + t] += s0 * qb[t]; sn += vv[t] * ka[t]; sn += vv[4 + t] * kb[t]; }
                __builtin_nontemporal_store(sn, (f32x4*)(s1p + (size_t)(8 * (8 * g + u)) * 512)); }
#pragma unroll
            for (int u = 0; u < 8; ++u) cur[u] = nxt[u];
        }
#pragma unroll
        for (int t = 0; t < 8; ++t) *(LAS f32x4*)(OR + (kr * 8 + t) * 256 + 4 * vq4) = oa[t];
        __syncthreads();
        { const int t = F.tid >> 6, vc = 4 * F.lane;
          f32x4 o = {0.f, 0.f, 0.f, 0.f};
#pragma unroll
          for (int q = 0; q < 8; ++q) o += *(const LAS f32x4*)(OR + (q * 8 + t) * 256 + vc);
#pragma unroll
          for (int sq = 0; sq < 8; ++sq) o += *(const LAS f32x4*)(VS + sq * 256 + vc) * AS[t * 8 + sq];
          const v2u g = *(const v2u*)(P + (size_t)(r0 + t) * PW + C_GG + h * 512 + vh * 256 + vc);
          v2u wv; wv.x = pkbf(o[0] * bflo(g.x), o[1] * bfhi(g.x)); wv.y = pkbf(o[2] * bflo(g.y), o[3] * bfhi(g.y));
          *(v2u*)((bf16*)(wsp() + WS_ZB) + (size_t)(r0 + t) * D + h * 512 + vh * 256 + vc) = wv;
          const float ss = wave_sum((o[0] * o[0] + o[1] * o[1]) + (o[2] * o[2] + o[3] * o[3]));
          if (F.lane == 0) atomicAdd((unsigned long long*)(wsp() + WS_RSO) + ((size_t)l * 4 + h) * M + r0 + t, (unsigned long long)(ss * 16777216.0f)); }
        __syncthreads();
    }
}
constexpr size_t WS_FIX = 1147 * MiB;
__device__ __forceinline__ void p_convfix(Frame& F0, int l) {
    Frame F = F0; asm volatile("" : "+v"(F.tid), "+v"(F.lane));
    const float* FX = (const float*)(wsp() + WS_FIX); bf16* ZA = (bf16*)(wsp() + WS_ZA); const float* cw = inp(I_CONVW) + (size_t)l * 3 * D;
    for (int it = F.vcu * 512 + F.tid; it < 128 * 2048; it += F.G * 512) { const int blk = it >> 11, ch = it & 2047;
        if ((blk & 31) == 0) continue;
        const float c0 = FX[(size_t)(blk * 2) * 2048 + ch], c1 = FX[(size_t)(blk * 2 + 1) * 2048 + ch];
        const float h0 = FX[524288 + (size_t)(blk * 2) * 2048 + ch], h1 = FX[524288 + (size_t)(blk * 2 + 1) * 2048 + ch];
        const float t0 = FX[1048576 + (size_t)((blk - 1) * 2) * 2048 + ch], t1 = FX[1048576 + (size_t)((blk - 1) * 2 + 1) * 2048 + ch];
        const float w0 = cw[ch], w1 = cw[D + ch], w2 = cw[2 * D + ch];
        ZA[(size_t)(blk * 64) * D + ch] = bf1r(c0 * (w0 * t0 + w1 * t1 + w2 * h0));
        ZA[(size_t)(blk * 64 + 1) * D + ch] = bf1r(c1 * (w0 * t1 + w1 * h0 + w2 * h1)); }
}
__device__ __forceinline__ void rt_row(LAS float* RT, const unsigned long long* RSO, int row) {
    const GAS unsigned long long* p = (const GAS unsigned long long*)(RSO + row);
    const float q0 = (float)p[0] * (1.f / 16777216.f), q1 = (float)p[M] * (1.f / 16777216.f), q2 = (float)p[2 * M] * (1.f / 16777216.f), q3 = (float)p[3 * M] * (1.f / 16777216.f);
    const float s0 = 1.f / sqrtf(q0 * (1.f / 512.f) + EPS), s1 = 1.f / sqrtf(q1 * (1.f / 512.f) + EPS), s2 = 1.f / sqrtf(q2 * (1.f / 512.f) + EPS), s3 = 1.f / sqrtf(q3 * (1.f / 512.f) + EPS);
    *(LAS f32x4*)(RT + (row & 255) * 8) = (f32x4){s0 / s1, s1 / s2, s2 / s3, s3}; *(LAS f32x4*)(RT + (row & 255) * 8 + 4) = (f32x4){1.f / s0, 0.f, 0.f, 0.f};
}
struct Args { const float* in[14]; float* out; unsigned char* ws; int ph_lo, ph_hi; };
constexpr int N_PHASES = 2 + 5 * DEPTH;
__global__ void __launch_bounds__(NWAVES * 64, 2) fwd(Args args) {
    extern __shared__ __attribute__((aligned(16))) unsigned char lds[];
    Frame F;
    F.lds = (LAS unsigned char*)lds;
    F.tid = threadIdx.x; F.lane = F.tid & 63; F.wave = __builtin_amdgcn_readfirstlane(F.tid >> 6);
    F.G = gridDim.x; { const int bx = blockIdx.x; F.vcu = (F.G % 8 == 0) ? (bx % 8) * (F.G / 8) + bx / 8 : bx; }
    volatile LAS unsigned* MISC = (volatile LAS unsigned*)(F.lds + MISC_OFF);
    for (int u = F.tid; u < (LDS_BYTES - LDSCTL_OFF) / 4; u += NWAVES * 64) ((LAS unsigned*)(F.lds + LDSCTL_OFF))[u] = 0u;
    __syncthreads();
    const int lo = args.ph_lo, hi = args.ph_hi;
    XcdBarrier bar; bar.bar = (unsigned*)(wsp() + WS_CTL) + CW_BAR; bar.x = 0; bar.st = nullptr;
    if (hi - lo > 1) bar = xcd_barrier_post((unsigned*)(wsp() + WS_CTL) + CW_BAR, MISC + 8);
#define IN(k) (lo <= (k) && (k) < hi)
#define SEAM(k) do { if (IN(k) && IN((k) + 1)) xcd_barrier(bar); } while (0)

    #ifndef NO_P0
    if (IN(0)) { for (int rep = 0; rep < REP_PRO; ++rep) p_prologue(F); p_xprep(F, 0); }
#endif
    SEAM(0);
#pragma unroll 1
    for (int l = 0; l < DEPTH; ++l) {
        const int pb = 1 + 5 * l;
#ifndef NO_PROJ
        if (IN(pb)) {
            unsigned char* const ws = wsp(); bf16* XB = (bf16*)(ws + WS_XB); bf16* P = (bf16*)(ws + WS_P); float* LR = (float*)(ws + WS_LR); const unsigned long long* RS = (const unsigned long long*)(ws + WS_RSQ) + (size_t)l * M;
            const bf16* Wt = (const bf16*)(ws + WS_WIN + l * WIN_L);
            pg8::Gemm g{XB, Wt, M, PW, D}; pg8::ProjOrder S; S.init(F.G, (int)blockIdx.x);
            pg8::EpiProj E{P, LR, RS, (bf16*)(ws + WS_ZA), (float*)(ws + WS_FIX), inp(I_CONVW) + (size_t)l * 3 * D, inp(I_SCONV) + (size_t)l * 128 * 2 * D, outp() + O_CONVP + (size_t)l * 4 * 2 * D, outp() + O_CONVS + (size_t)l * 128 * 2 * D};
            for (int rep = 0; rep < REP_PROJ; ++rep) {
            pg8::gemm_phase<pg8::EpiProj, pg8::ProjOrder, true, true>(F.lds + RING_OFF, g, S, E);
            for (int su = (int)blockIdx.x; su < 256 + M / 128; su += F.G) {
                if (su < 256) pg8::mini_gemm(F.lds + RING_OFF, XB, Wt, D, MP + (su >> 5) * 128, C_GG + (su & 31) * 64, E); else pg8::mini_gemm(F.lds + RING_OFF, XB, Wt, D, (su - 256) * 128, PW, E); }
            }
        }
#endif
        SEAM(pb);
        if (IN(pb + 1)) {
#ifndef NO_CONV
            for (int rep = 0; rep < REP_PREP; ++rep) p_convfix(F, l);
#endif
#ifndef NO_GLA
            for (int rep = 0; rep < REP_PREP; ++rep) p_gla_prep(F, l);
#endif
        } SEAM(pb + 1);
        if (IN(pb + 2)) {
#ifndef NO_GLA
            for (int rep = 0; rep < REP_SCAN; ++rep) { p_gla_scan(F, l); p_gla_sample(F, l, rep); }
#endif
        } SEAM(pb + 2);
#ifndef NO_BR
        if (IN(pb + 3)) {
            unsigned char* const ws = wsp(); bf16* P = (bf16*)(ws + WS_P); bf16* ZA = (bf16*)(ws + WS_ZA); bf16* ZB = (bf16*)(ws + WS_ZB); bf16* MG = (bf16*)(ws + WS_MG);
            const bf16* WtA = (const bf16*)(ws + WS_WA + l * W_L); const bf16* WtB = (const bf16*)(ws + WS_WB + l * W_L);
            LAS float* RT = (LAS float*)(F.lds + RT_OFF); const unsigned long long* RSO = (const unsigned long long*)(ws + WS_RSO) + (size_t)l * M * 4;
            pg8::StaticOrder S; S.init(MP, D, F.G, (int)blockIdx.x);
            pg8::EpiBrA2 EA{P + C_GA, P + C_GB, RT}; pg8::EpiBrB2 EB{P + C_GB, MG, RT};
            { pg8::Unit u0; if (S.next(0, u0) && F.tid < 256) rt_row(RT, RSO, u0.pm * 256 + F.tid); __syncthreads(); }
            { pg8::Gemm g{ZA, WtA, MP, D, D, ZB, WtB}; pg8::PairOrder S2; S2.init(MP, D, F.G, (int)blockIdx.x); pg8::EpiBr EE{EA, EB};
              pg8::gemm_phase<pg8::EpiBr, pg8::PairOrder, true, true>(F.lds + RING_OFF, g, S2, EE); }
            for (int su = (int)blockIdx.x; su < 256; su += F.G) { __syncthreads(); if (F.tid < 128) rt_row(RT, RSO, MP + (su >> 5) * 128 + F.tid); __syncthreads();
                f32x4 a2[2][2];
                pg8::mini_gemm_acc<pg8::EpiBrA2, true>(F.lds + RING_OFF, ZA, WtA, D, MP + (su >> 5) * 128, (su & 31) * 64, EA, a2);
                pg8::mini_gemm_acc<pg8::EpiBrB2, false>(F.lds + RING_OFF, ZB, WtB, D, MP + (su >> 5) * 128, (su & 31) * 64, EB, a2); }
        }
#endif
        SEAM(pb + 3);
#ifndef NO_OUT
        if (IN(pb + 4)) {
            unsigned char* const ws = wsp(); bf16* MG = (bf16*)(ws + WS_MG);
            const bf16* Wt = (const bf16*)(ws + WS_WO + l * W_L); pg8::Gemm g{MG, Wt, MP, D, D}; pg8::StaticOrder S; S.init(MP, D, F.G, (int)blockIdx.x);
            for (int rep = 0; rep < REP_OUT; ++rep) {
            LAS unsigned long long* rowsum = (LAS unsigned long long*)(F.lds + ROWSUM_OFF); unsigned long long* RSQn = (unsigned long long*)(ws + WS_RSQ) + (size_t)(rep > 0 ? DEPTH + 1 : l + 1) * M;
            if (F.tid < 256) rowsum[F.tid] = 0ull;
            __syncthreads();
            pg8::EpiOut E{(bf16*)(ws + (rep > 0 ? WS_ZA : WS_XB)), rowsum};
            pg8::gemm_phase<pg8::EpiOut, pg8::StaticOrder, true, true>(F.lds + RING_OFF, g, S, E);
            { pg8::Unit u0; const bool has = S.next(0, u0); asm volatile("s_waitcnt lgkmcnt(0)" ::: "memory"); __syncthreads();
              if (has && F.tid < 256) { atomicAdd(RSQn + u0.pm * 256 + F.tid, rowsum[F.tid]); rowsum[F.tid] = 0ull; } __syncthreads(); }
            for (int su = (int)blockIdx.x; su < 256; su += F.G) { pg8::mini_gemm(F.lds + RING_OFF, MG, Wt, D, MP + (su >> 5) * 128, (su & 31) * 64, E);
                asm volatile("s_waitcnt lgkmcnt(0)" ::: "memory"); __syncthreads();
                if (F.tid < 128) { const int row = MP + (su >> 5) * 128 + F.tid; atomicAdd(RSQn + row, rowsum[row & 255]); rowsum[row & 255] = 0ull; } __syncthreads(); }
            }
        }
#endif
        SEAM(pb + 4);
    }
    if (IN(1 + 5 * DEPTH)) p_final(F);
#undef IN
#undef SEAM
}

#ifndef MK_SINGLE
#define MK_SINGLE 1
#endif
extern "C" void kernel_launch(void* const* d_in, const int* in_sizes, int n_in, void* d_out, int out_size, void* d_ws, size_t ws_size, hipStream_t stream) {
    static int grid = 0;
    if (grid == 0) {
        if (n_in != 14 || (size_t)out_size != O_END || ws_size < WS_FIX + 6 * MiB) { fprintf(stderr, "kernel_launch: unexpected shapes (n_in %d out %d ws %zu)\n", n_in, out_size, ws_size); grid = -1; return; }
        int dev = 0, cus = 0, per_cu = 0;
        if (hipGetDevice(&dev) != hipSuccess || hipDeviceGetAttribute(&cus, hipDeviceAttributeMultiprocessorCount, dev) != hipSuccess) { grid = -1; return; }
        if (hipFuncSetAttribute((const void*)fwd, hipFuncAttributeMaxDynamicSharedMemorySize, LDS_BYTES) != hipSuccess) { fprintf(stderr, "kernel_launch: hipFuncSetAttribute failed\n"); grid = -1; return; }
        if (hipOccupancyMaxActiveBlocksPerMultiprocessor(&per_cu, (const void*)fwd, NWAVES * 64, LDS_BYTES) != hipSuccess || per_cu < 1) fprintf(stderr, "kernel_launch: occupancy query reports %d\n", per_cu);
        (void)hipGetLastError();
        grid = cus;
    }
    if (grid < 0) return;
    if (hipMemsetAsync((char*)d_ws + WS_CTL, 0, CTL_ZERO_BYTES, stream) != hipSuccess) return;
    Args a{};
    for (int i = 0; i < 14; ++i) a.in[i] = (const float*)d_in[i];
    a.out = (float*)d_out; a.ws = (unsigned char*)d_ws;
#if MK_SINGLE
    a.ph_lo = 0; a.ph_hi = N_PHASES;
    hipLaunchKernelGGL(fwd, dim3(grid), dim3(NWAVES * 64), LDS_BYTES, stream, a);
#else
    for (int p = 0; p < N_PHASES; ++p) { a.ph_lo = p; a.ph_hi = p + 1; hipLaunchKernelGGL(fwd, dim3(grid), dim3(NWAVES * 64), LDS_BYTES, stream, a); }
#endif
}
```
